# Optimizing an MI355X kernel written in HIP

```python
import math
import jax, jax.numpy as jnp
from jax import lax
import numpy as np

D_MODEL = 1024
BATCH = 16
SEQ = 4096
DEPTH = 1

N_META = 16
RET_HEADS = 4
RET_WIDTH = D_MODEL // 2
RET_DV = RET_WIDTH // RET_HEADS
RET_DK = RET_DV // 2
RET_QK_WIDTH = RET_HEADS * RET_DK
CHUNK = 128
ROPE_BASE = 10000.0
POOL_WINDOWS = (2, 4, 8, 16)
POOL_GROUPS = len(POOL_WINDOWS)
POOL_WIDTH = D_MODEL // 2
POOL_CH = POOL_WIDTH // POOL_GROUPS
MIX_WIDTH = RET_WIDTH + POOL_WIDTH
IN_COLS = 2 * RET_QK_WIDTH + 2 * RET_WIDTH + POOL_WIDTH
N_GROUPS = 4
EXPERTS_PER_GROUP = 8
N_EXPERTS = N_GROUPS * EXPERTS_PER_GROUP
D_EXPERT = D_MODEL // 2
TOP_K = 2
MOE_BLOCK = 128
LN_EPS = 1e-5
GN_EPS = 1e-6
ALPHA = (2 * DEPTH) ** 0.25
BETA = (8 * DEPTH) ** -0.25

kernel_name = 'hybrid_retention_pool_hmoe'


def layer_norm(x, g, b):
    xf = x.astype(jnp.float32)
    mu = jnp.mean(xf, axis=-1, keepdims=True)
    var = jnp.mean(jnp.square(xf - mu), axis=-1, keepdims=True)
    return ((xf - mu) * lax.rsqrt(var + LN_EPS) * g.astype(jnp.float32) + b.astype(jnp.float32)).astype(x.dtype)


def rotary(x, pos):
    half = x.shape[-1] // 2
    inv = ROPE_BASE ** (-jnp.arange(half, dtype=jnp.float32) / half)
    ang = pos.astype(jnp.float32)[:, None] * inv[None, :]
    cos = jnp.cos(ang)[None, :, None, :]
    sin = jnp.sin(ang)[None, :, None, :]
    x1, x2 = x[..., :half], x[..., half:]
    return jnp.concatenate([x1 * cos - x2 * sin, x1 * sin + x2 * cos], axis=-1).astype(x.dtype)


def retention_chunkwise(q, k, v):
    B, L, H, _ = q.shape
    pad = CHUNK - N_META
    padw = ((0, 0), (pad, 0), (0, 0), (0, 0))
    q, k, v = jnp.pad(q, padw), jnp.pad(k, padw), jnp.pad(v, padw)
    Lp = L + pad
    nc = Lp // CHUNK
    qc = q.reshape(B, nc, CHUNK, H, RET_DK)
    kc = k.reshape(B, nc, CHUNK, H, RET_DK)
    vc = v.reshape(B, nc, CHUNK, H, RET_DV)
    log_g = jnp.log1p(-jnp.power(2.0, -5.0 - jnp.arange(H, dtype=jnp.float32)))
    i = jnp.arange(CHUNK, dtype=jnp.float32)
    rel = i[:, None] - i[None, :]
    dmask = jnp.where(rel[None] >= 0, jnp.exp(jnp.maximum(rel, 0.0)[None] * log_g[:, None, None]), 0.0)
    scores = jnp.einsum('bnihd,bnjhd->bnhij', qc, kc) * dmask
    inner = jnp.einsum('bnhij,bnjhv->bnihv', scores, vc)
    zeta = jnp.exp((CHUNK - 1 - i)[None, :] * log_g[:, None])
    kv = jnp.einsum('bnjhd,hj,bnjhv->nbhdv', kc, zeta, vc)
    chunk_decay = jnp.exp(CHUNK * log_g)[:, None, None]

    def step(state, kv_n):
        return chunk_decay * state + kv_n, state

    _, prev = lax.scan(step, jnp.zeros((B, H, RET_DK, RET_DV), kv.dtype), kv)
    xi = jnp.exp((i + 1)[None, :] * log_g[:, None])
    cross = jnp.einsum('bnihd,nbhdv,hi->bnihv', qc, prev, xi)
    out = (inner + cross).reshape(B, Lp, H, RET_DV)
    return out[:, pad:]


def head_group_norm(y):
    yf = y.astype(jnp.float32)
    mu = jnp.mean(yf, axis=-1, keepdims=True)
    var = jnp.mean(jnp.square(yf - mu), axis=-1, keepdims=True)
    return (yf - mu) * lax.rsqrt(var + GN_EPS)


def causal_multiscale_pool(u):
    L = u.shape[1]
    uf = u.astype(jnp.float32)
    cs = jnp.cumsum(uf, axis=1)
    t = jnp.arange(L)
    outs = []
    for gi, w in enumerate(POOL_WINDOWS):
        sl = slice(gi * POOL_CH, (gi + 1) * POOL_CH)
        c = cs[..., sl]
        shifted = jnp.pad(c, ((0, 0), (w, 0), (0, 0)))[:, :L]
        count = jnp.minimum(t + 1, w).astype(jnp.float32)[None, :, None]
        outs.append((c - shifted) / count - uf[..., sl])
    return jnp.concatenate(outs, axis=-1)


def token_mixer(h, w_in, pool_w, pool_b, pool_scale, w_out):
    B, L, _ = h.shape
    proj = h @ w_in
    q, k, v, gate, u = jnp.split(
        proj, [RET_QK_WIDTH, 2 * RET_QK_WIDTH, 2 * RET_QK_WIDTH + RET_WIDTH, 2 * RET_QK_WIDTH + 2 * RET_WIDTH], axis=-1)
    pos = jnp.arange(L)
    q = rotary(q.reshape(B, L, RET_HEADS, RET_DK), pos)
    k = rotary(k.reshape(B, L, RET_HEADS, RET_DK), pos) * (RET_DK ** -0.5)
    ret = retention_chunkwise(q, k, v.reshape(B, L, RET_HEADS, RET_DV))
    ret = head_group_norm(ret).reshape(B, L, RET_WIDTH).astype(h.dtype)
    ret_out = jax.nn.silu(gate) * ret
    pooled = causal_multiscale_pool(u).astype(h.dtype).reshape(B, L, POOL_GROUPS, POOL_CH)
    pooled = jnp.einsum('blgc,gcd->blgd', pooled, pool_w) + pool_b[None, None]
    pool_out = pooled.reshape(B, L, POOL_WIDTH) * pool_scale
    return jnp.concatenate([ret_out, pool_out], axis=-1) @ w_out


def hierarchical_moe(h2d, rg_w, rg_b, re_w, re_b, w_gate, w_up, w_down):
    N = h2d.shape[0]
    g_logits = (h2d @ rg_w + rg_b).astype(jnp.float32)
    g_p, g_idx = lax.top_k(jax.nn.softmax(g_logits, axis=-1), 1)
    e_logits = (h2d @ re_w + re_b).astype(jnp.float32).reshape(N, N_GROUPS, EXPERTS_PER_GROUP)
    sel = e_logits[jnp.arange(N), g_idx[:, 0]]
    e_p, e_idx = lax.top_k(jax.nn.softmax(sel, axis=-1), TOP_K)
    e_p = e_p / jnp.sum(e_p, axis=-1, keepdims=True)
    pair_w = (g_p * e_p).reshape(-1).astype(h2d.dtype)
    pair_e = (g_idx * EXPERTS_PER_GROUP + e_idx).reshape(-1).astype(jnp.int32)
    pair_tok = jnp.repeat(jnp.arange(N, dtype=jnp.int32), TOP_K)
    P = N * TOP_K
    order = jnp.argsort(pair_e)
    se = pair_e[order]
    stok = pair_tok[order]
    sw = pair_w[order]
    counts = jnp.bincount(pair_e, length=N_EXPERTS)
    starts = jnp.cumsum(counts) - counts
    padded = ((counts + MOE_BLOCK - 1) // MOE_BLOCK) * MOE_BLOCK
    pends = jnp.cumsum(padded)
    pstarts = pends - padded
    dest = pstarts[se] + (jnp.arange(P, dtype=jnp.int32) - starts[se])
    n_blocks = P // MOE_BLOCK + N_EXPERTS + 1
    buf = jnp.zeros((n_blocks * MOE_BLOCK, h2d.shape[1]), h2d.dtype).at[dest].set(h2d[stok])
    block_start = jnp.arange(n_blocks, dtype=jnp.int32) * MOE_BLOCK
    block_e = jnp.minimum(jnp.searchsorted(pends, block_start, side='right'), N_EXPERTS - 1)

    def expert_block(args):
        xb, e = args
        return (jax.nn.silu(xb @ w_gate[e]) * (xb @ w_up[e])) @ w_down[e]

    y_buf = lax.map(expert_block, (buf.reshape(n_blocks, MOE_BLOCK, -1), block_e)).reshape(n_blocks * MOE_BLOCK, -1)
    y_pairs = y_buf[dest] * sw[:, None]
    return jax.ops.segment_sum(y_pairs, stok, num_segments=N)


def setup_inputs(seed: int = 0) -> dict:
    key = jax.random.key(seed)
    ks = jax.random.split(key, 22)

    def nrm(k, shape, scale):
        return jax.random.normal(k, shape, jnp.float32) * scale

    return {
        'x': nrm(ks[0], (BATCH, SEQ, D_MODEL), 1.0),
        'meta_tokens': nrm(ks[1], (N_META, D_MODEL), 1.0),
        'ln_emb_g': 1.0 + nrm(ks[2], (D_MODEL,), 0.02),
        'ln_emb_b': nrm(ks[3], (D_MODEL,), 0.02),
        'w_in': nrm(ks[4], (DEPTH, D_MODEL, IN_COLS), D_MODEL ** -0.5),
        'pool_w': nrm(ks[5], (DEPTH, POOL_GROUPS, POOL_CH, POOL_CH), POOL_CH ** -0.5),
        'pool_b': nrm(ks[6], (DEPTH, POOL_GROUPS, POOL_CH), 0.01),
        'pool_scale': 1.0 + nrm(ks[7], (DEPTH, POOL_WIDTH), 0.02),
        'w_out': nrm(ks[8], (DEPTH, MIX_WIDTH, D_MODEL), BETA * MIX_WIDTH ** -0.5),
        'ln1_g': 1.0 + nrm(ks[9], (DEPTH, D_MODEL), 0.02),
        'ln1_b': nrm(ks[10], (DEPTH, D_MODEL), 0.02),
        'router_group_w': nrm(ks[11], (DEPTH, D_MODEL, N_GROUPS), D_MODEL ** -0.5),
        'router_group_b': nrm(ks[12], (DEPTH, N_GROUPS), 0.01),
        'router_expert_w': nrm(ks[13], (DEPTH, D_MODEL, N_EXPERTS), D_MODEL ** -0.5),
        'router_expert_b': nrm(ks[14], (DEPTH, N_EXPERTS), 0.01),
        'expert_w_gate': nrm(ks[15], (DEPTH, N_EXPERTS, D_MODEL, D_EXPERT), D_MODEL ** -0.5),
        'expert_w_up': nrm(ks[16], (DEPTH, N_EXPERTS, D_MODEL, D_EXPERT), D_MODEL ** -0.5),
        'expert_w_down': nrm(ks[17], (DEPTH, N_EXPERTS, D_EXPERT, D_MODEL), BETA * D_EXPERT ** -0.5),
        'ln2_g': 1.0 + nrm(ks[18], (DEPTH, D_MODEL), 0.02),
        'ln2_b': nrm(ks[19], (DEPTH, D_MODEL), 0.02),
    }


def reference(x, meta_tokens, ln_emb_g, ln_emb_b, w_in, pool_w, pool_b, pool_scale, w_out,
              ln1_g, ln1_b, router_group_w, router_group_b, router_expert_w, router_expert_b,
              expert_w_gate, expert_w_up, expert_w_down, ln2_g, ln2_b):
    B = x.shape[0]
    meta = jnp.broadcast_to(meta_tokens[None].astype(x.dtype), (B, N_META, D_MODEL))
    h = jnp.concatenate([meta, x], axis=1)
    h = layer_norm(h, ln_emb_g, ln_emb_b)
    for l in range(DEPTH):
        mix = token_mixer(h, w_in[l], pool_w[l], pool_b[l], pool_scale[l], w_out[l])
        h = layer_norm(ALPHA * h + mix, ln1_g[l], ln1_b[l])
        y = hierarchical_moe(h.reshape(-1, D_MODEL), router_group_w[l], router_group_b[l],
                             router_expert_w[l], router_expert_b[l],
                             expert_w_gate[l], expert_w_up[l], expert_w_down[l]).reshape(h.shape)
        h = layer_norm(ALPHA * h + y, ln2_g[l], ln2_b[l])
    return h[:, N_META:]
```

```cpp
#include <hip/hip_runtime.h>
#include <cstdio>
#include <cstdint>
#ifndef MK_N_LAUNCHES
#define MK_N_LAUNCHES 10
#endif
namespace pg8 {
#define PG8_LAS __attribute__((address_space(3)))
typedef unsigned short bf16_t;
typedef short bf16x8 __attribute__((ext_vector_type(8)));
typedef float f32x4 __attribute__((ext_vector_type(4)));
typedef unsigned u32x4 __attribute__((ext_vector_type(4)));
constexpr int BM = 256, BK = 64, HALF = 128, HTB = HALF * BK * 2  , STAGE_BYTES = 8 * HTB, NXCD = 8, WGM = 8;

__host__ __device__ __forceinline__ int lds_byte(int r, int c) { const int st = (r >> 4) * 2 + (c >> 5), rr = r & 15, cc = c & 31, ob = rr * 64 + cc * 2; return st * 1024 + (ob ^ (((ob >> 9) & 1) << 5)); }
__host__ __device__ __forceinline__ void stage_rc(int b, int& R, int& C) { const int st = b / 1024, sb = b % 1024, swz = sb ^ (((sb >> 9) & 1) << 5); R = (st >> 1) * 16 + swz / 64; C = (st & 1) * 32 + (swz % 64) / 2; }
__host__ __device__ __forceinline__ int perm32(int rho) { const int n = rho >> 4, i = rho & 15; return 8 * (i >> 2) + 4 * n + (i & 3); }

struct Unit { int pm, pn; };
struct Gemm { const bf16_t* A; const bf16_t* Bt; int M, N, K; };

struct StaticOrder {
    int nM, nN, nwg, G, c;
    __host__ __device__ void init(int M, int N, int G_, int c_) { nM = M / BM; nN = N / BM; nwg = nM * nN; G = G_; c = c_; }
    __host__ __device__ bool next(int i, Unit& u) const {
        const long L = (long)i * G + c; if (L >= nwg) return false;
        int wgid = (int)L; { const int q = nwg / NXCD, r = nwg % NXCD, xcd = wgid % NXCD, off = wgid / NXCD; wgid = (xcd < r ? xcd * (q + 1) : r * (q + 1) + (xcd - r) * q) + off; }
        const int nig = WGM * nN, gid = wgid / nig, fm = gid * WGM, gsz = (nM - fm) < WGM ? (nM - fm) : WGM;
        u.pm = fm + ((wgid % nig) % gsz); u.pn = (wgid % nig) / gsz; return true;
    }
    __device__ __forceinline__ void a_ready(const Unit&) const {}
    __device__ __forceinline__ void done(const Unit&) const {}
};

__device__ __forceinline__ unsigned cvt_pk_bf16(float lo, float hi) { unsigned r; asm volatile("v_cvt_pk_bf16_f32 %0, %1, %2" : "=v"(r) : "v"(lo), "v"(hi)); return r; }
__device__ __forceinline__ float bf_lo(unsigned w) { return __uint_as_float(w << 16); }
__device__ __forceinline__ float bf_hi(unsigned w) { return __uint_as_float(w & 0xffff0000u); }

struct EpiProj {
    static constexpr bool PERM = true, AFTER_DRAIN = false;
    bf16_t *Q, *V; const float* rope;
    __device__ __forceinline__ void operator()(const f32x4 (&acc)[2][2][4][2], const Unit& u, int wr, int wc, int fr, int fq) const {
        const int row0 = u.pm * BM + wr * 64 + fr, lc0 = wc * 32 + 8 * fq;
        if (u.pn < 2) {
            bf16_t* base = Q + (size_t)u.pn * ((size_t)65536 * 256); const float sc = u.pn == 0 ? 1.0f : 0.125f;
#pragma unroll
            for (int ai = 0; ai < 2; ++ai)
#pragma unroll
                for (int m = 0; m < 4; ++m) { const int row = row0 + ai * HALF + m * 16; const int pos = 16 + (row & 4095);
#pragma unroll
                    for (int bj = 0; bj < 2; ++bj) { const int lc = lc0 + bj * HALF; const int i0 = (lc & 63) >> 1;
                        const f32x4* tp = (const f32x4*)(rope + ((size_t)pos * 32 + i0) * 2); const f32x4 t0 = tp[0], t1 = tp[1];
                        const f32x4 v0 = acc[ai][bj][m][0], v1 = acc[ai][bj][m][1];
                        const float o0 = (v0[0] * t0[0] - v0[1] * t0[1]) * sc, o1 = (v0[0] * t0[1] + v0[1] * t0[0]) * sc;
                        const float o2 = (v0[2] * t0[2] - v0[3] * t0[3]) * sc, o3 = (v0[2] * t0[3] + v0[3] * t0[2]) * sc;
                        const float o4 = (v1[0] * t1[0] - v1[1] * t1[1]) * sc, o5 = (v1[0] * t1[1] + v1[1] * t1[0]) * sc;
                        const float o6 = (v1[2] * t1[2] - v1[3] * t1[3]) * sc, o7 = (v1[2] * t1[3] + v1[3] * t1[2]) * sc;
                        u32x4 w; w.x = cvt_pk_bf16(o0, o1); w.y = cvt_pk_bf16(o2, o3); w.z = cvt_pk_bf16(o4, o5); w.w = cvt_pk_bf16(o6, o7);
                        *(u32x4*)(base + (size_t)row * 256 + lc) = w; } }
        } else {
            bf16_t* base = V + (size_t)((u.pn - 2) >> 1) * ((size_t)65536 * 512); const int colt = (u.pn & 1) * 256;
#pragma unroll
            for (int ai = 0; ai < 2; ++ai)
#pragma unroll
                for (int m = 0; m < 4; ++m) { bf16_t* rowp = base + (size_t)(row0 + ai * HALF + m * 16) * 512 + colt + lc0;
#pragma unroll
                    for (int bj = 0; bj < 2; ++bj) { const f32x4 v0 = acc[ai][bj][m][0], v1 = acc[ai][bj][m][1];
                        u32x4 w; w.x = cvt_pk_bf16(v0[0], v0[1]); w.y = cvt_pk_bf16(v0[2], v0[3]); w.z = cvt_pk_bf16(v1[0], v1[1]); w.w = cvt_pk_bf16(v1[2], v1[3]);
                        *(u32x4*)(rowp + bj * HALF) = w; } }
        }
    }
};
struct EpiRes {
    static constexpr bool PERM = false, AFTER_DRAIN = false;
    const bf16_t* H0; float* T; float alpha;
    __device__ __forceinline__ void operator()(const f32x4 (&acc)[2][2][4][2], const Unit& u, int wr, int wc, int fr, int fq) const {
        typedef unsigned u32x2 __attribute__((ext_vector_type(2)));
        const int row0 = u.pm * BM + wr * 64 + fr, col0 = u.pn * BM + wc * 32 + 4 * fq;
#pragma unroll
        for (int ai = 0; ai < 2; ++ai)
#pragma unroll
            for (int m = 0; m < 4; ++m) { const size_t off = (size_t)(row0 + ai * HALF + m * 16) * 1024 + col0;
#pragma unroll
                for (int bj = 0; bj < 2; ++bj)
#pragma unroll
                    for (int n = 0; n < 2; ++n) { const u32x2 hb = *(const u32x2*)(H0 + off + bj * HALF + n * 16); const f32x4 a = acc[ai][bj][m][n];
                        f32x4 o; o[0] = alpha * bf_lo(hb.x) + a[0]; o[1] = alpha * bf_hi(hb.x) + a[1]; o[2] = alpha * bf_lo(hb.y) + a[2]; o[3] = alpha * bf_hi(hb.y) + a[3];
                        *(f32x4*)(T + off + bj * HALF + n * 16) = o; } }
    }
};
struct EpiGateUp {
    static constexpr bool PERM = true, AFTER_DRAIN = false;
    bf16_t* HID;
    __device__ __forceinline__ void operator()(const f32x4 (&acc)[2][2][4][2], const Unit& u, int wr, int wc, int fr, int fq) const {
        const int row0 = u.pm * BM + wr * 64 + fr, hc = (u.pn & 3) * 128 + wc * 32 + 8 * fq;
#pragma unroll
        for (int ai = 0; ai < 2; ++ai)
#pragma unroll
            for (int m = 0; m < 4; ++m) { float h[8];
#pragma unroll
                for (int n = 0; n < 2; ++n)
#pragma unroll
                    for (int j = 0; j < 4; ++j) { const float g = acc[ai][0][m][n][j], up = acc[ai][1][m][n][j]; h[4 * n + j] = g * up * __builtin_amdgcn_rcpf(1.0f + __expf(-g)); }
                u32x4 w; w.x = cvt_pk_bf16(h[0], h[1]); w.y = cvt_pk_bf16(h[2], h[3]); w.z = cvt_pk_bf16(h[4], h[5]); w.w = cvt_pk_bf16(h[6], h[7]);
                *(u32x4*)(HID + (size_t)(row0 + ai * HALF + m * 16) * 512 + hc) = w; }
    }
};
struct EpiDown {
    static constexpr bool PERM = true, AFTER_DRAIN = false;
    bf16_t* YP; const float* PW;
    __device__ __forceinline__ void operator()(const f32x4 (&acc)[2][2][4][2], const Unit& u, int wr, int wc, int fr, int fq) const {
        const int row0 = u.pm * BM + wr * 64 + fr, col0 = (u.pn & 3) * BM + wc * 32 + 8 * fq;
#pragma unroll
        for (int ai = 0; ai < 2; ++ai)
#pragma unroll
            for (int m = 0; m < 4; ++m) { const int row = row0 + ai * HALF + m * 16; const float pw = PW[row]; bf16_t* rowp = YP + (size_t)row * 1024 + col0;
#pragma unroll
                for (int bj = 0; bj < 2; ++bj) { const f32x4 v0 = acc[ai][bj][m][0] * pw, v1 = acc[ai][bj][m][1] * pw;
                    u32x4 w; w.x = cvt_pk_bf16(v0[0], v0[1]); w.y = cvt_pk_bf16(v0[2], v0[3]); w.z = cvt_pk_bf16(v1[0], v1[1]); w.w = cvt_pk_bf16(v1[2], v1[3]);
                    *(u32x4*)(rowp + bj * HALF) = w; } }
    }
};
struct GroupedOrder {
    const PG8_LAS int* pp; int nwg, G, c;
    __device__ __forceinline__ void init(const PG8_LAS int* pp_, int G_, int c_) { pp = pp_; nwg = pp_[32] * 4; G = G_; c = c_; }
    __device__ __forceinline__ bool next(int i, Unit& u) const {
        const long L = (long)i * G + c; if (L >= nwg) return false;
        int wgid = (int)L; { const int q = nwg / NXCD, r = nwg % NXCD, xcd = wgid % NXCD, off = wgid / NXCD; wgid = (xcd < r ? xcd * (q + 1) : r * (q + 1) + (xcd - r) * q) + off; }
        const int panel = wgid >> 2; int e = 0;
#pragma unroll
        for (int k = 1; k < 32; ++k) e += (pp[k] <= panel) ? 1 : 0;
        u.pm = panel; u.pn = e * 4 + (wgid & 3); return true;
    }
    __device__ __forceinline__ void a_ready(const Unit&) const {}
    __device__ __forceinline__ void done(const Unit&) const {}
};
template <class Epi, class Sched, bool ALIGN_EPI = false, bool SP2 = false>
__device__ __forceinline__ void gemm_phase(PG8_LAS unsigned char* lds, const Gemm g, const Sched& S, const Epi& E) {
    const int tid = threadIdx.x, wid = __builtin_amdgcn_readfirstlane(tid >> 6), lane = tid & 63, wr = wid >> 2, wc = wid & 3, fr = lane & 15, fq = lane >> 4;
    const int K = g.K, nt = K / BK;
    unsigned voffA[2], voffB[2];
#pragma unroll
    for (int i = 0; i < 2; ++i) { int R, C; stage_rc(tid * 16 + i * 8192, R, C); const int Rb = Epi::PERM ? ((R & ~31) + perm32(R & 31)) : R;
        voffA[i] = (unsigned)(R * K + C) * 2u; voffB[i] = (unsigned)(Rb * K + C) * 2u; }
    const size_t kstep = (size_t)(BK * 2);
    const size_t hstep = (size_t)HALF * K * 2;
    const size_t tstep = 2 * hstep;
    const unsigned ldsw = (unsigned)wid * 1024u;
    const int aoff = lds_byte(wr * 64 + fr, fq * 8), boff = lds_byte(wc * 32 + fr, fq * 8);
#define PG8_SA(b, h) (((b) * 2 + (h)) * HTB)
#define PG8_SB(b, h) ((4 + (b) * 2 + (h)) * HTB)
#define PG8_STAGE(bufoff, gbase, voff) do { _Pragma("unroll") for (int _i = 0; _i < 2; ++_i) \
        __builtin_amdgcn_global_load_lds((const unsigned*)((const char*)(gbase) + (voff)[_i]), (PG8_LAS unsigned*)(lds + (bufoff) + ldsw + _i * 8192), 16, 0, 0); } while (0)
#define PG8_LDA(dst, b, h) do { _Pragma("unroll") for (int m = 0; m < 4; ++m) _Pragma("unroll") for (int k = 0; k < 2; ++k) dst[m][k] = *(const PG8_LAS bf16x8*)(lds + PG8_SA(b, h) + aoff + m * 2048 + k * 1024); } while (0)
#define PG8_LDB(dst, b, h) do { _Pragma("unroll") for (int n = 0; n < 2; ++n) _Pragma("unroll") for (int k = 0; k < 2; ++k) dst[n][k] = *(const PG8_LAS bf16x8*)(lds + PG8_SB(b, h) + boff + n * 2048 + k * 1024); } while (0)
#define PG8_MMA(ai, bj, At, Bt) do { __builtin_amdgcn_s_setprio(1); _Pragma("unroll") for (int m = 0; m < 4; ++m) _Pragma("unroll") for (int n = 0; n < 2; ++n) _Pragma("unroll") for (int k = 0; k < 2; ++k) \
        acc[ai][bj][m][n] = __builtin_amdgcn_mfma_f32_16x16x32_bf16(Bt[n][k], At[m][k], acc[ai][bj][m][n], 0, 0, 0); __builtin_amdgcn_s_setprio(0); } while (0)
#define PG8_WAIT_V(n) asm volatile("s_waitcnt vmcnt(" #n ")" ::: "memory")
#define PG8_WAIT_L(n) asm volatile("s_waitcnt lgkmcnt(" #n ")" ::: "memory")
#define PG8_BAR __builtin_amdgcn_s_barrier()
#define PG8_SCHED __builtin_amdgcn_sched_barrier(0)
    Unit cur, nxt; int ui = 0;
    if (!S.next(0, cur)) return;
    f32x4 acc[2][2][4][2];
#pragma unroll
    for (int a = 0; a < 2; ++a)
#pragma unroll
        for (int b = 0; b < 2; ++b)
#pragma unroll
            for (int m = 0; m < 4; ++m)
#pragma unroll
                for (int n = 0; n < 2; ++n) acc[a][b][m][n] = (f32x4){0.f, 0.f, 0.f, 0.f};
    bf16x8 At[4][2], B0[2][2], B1[2][2];
    const char* cA = (const char*)g.A + (size_t)cur.pm * tstep; const char* cB = (const char*)g.Bt + (size_t)cur.pn * tstep;
    S.a_ready(cur);
    if constexpr (SP2) {
        PG8_STAGE(PG8_SB(0, 0), cB, voffB); PG8_STAGE(PG8_SB(0, 1), cB + hstep, voffB); PG8_STAGE(PG8_SA(0, 0), cA, voffA); PG8_STAGE(PG8_SA(0, 1), cA + hstep, voffA);
        if (wr == 1) PG8_BAR;
        PG8_WAIT_V(2); PG8_BAR;
        PG8_STAGE(PG8_SB(1, 0), cB + kstep, voffB); PG8_STAGE(PG8_SA(1, 0), cA + kstep, voffA); PG8_STAGE(PG8_SB(1, 1), cB + hstep + kstep, voffB);
        PG8_WAIT_V(6); PG8_BAR;
    } else {
        PG8_STAGE(PG8_SB(0, 0), cB, voffB); PG8_STAGE(PG8_SA(0, 0), cA, voffA); PG8_STAGE(PG8_SB(0, 1), cB + hstep, voffB); PG8_STAGE(PG8_SA(0, 1), cA + hstep, voffA);
        if (wr == 1) PG8_BAR;
        PG8_WAIT_V(4); PG8_BAR;
        PG8_STAGE(PG8_SB(1, 0), cB + kstep, voffB); PG8_STAGE(PG8_SA(1, 0), cA + kstep, voffA); PG8_STAGE(PG8_SB(1, 1), cB + hstep + kstep, voffB);
        PG8_WAIT_V(6); PG8_BAR;
    }
    for (;;) {
        const bool has_next = S.next(ui + 1, nxt);
        const char* nA = has_next ? (const char*)g.A + (size_t)nxt.pm * tstep : cA; const char* nB = has_next ? (const char*)g.Bt + (size_t)nxt.pn * tstep : cB;
        for (int t = 0; t < nt; t += 2) {
            const bool last = (t == nt - 2);
            const char* a1 = cA + (size_t)(t + 1) * kstep;
            const char* a2 = last ? nA : cA + (size_t)(t + 2) * kstep; const char* b2 = last ? nB : cB + (size_t)(t + 2) * kstep;
            const char* a3 = a2 + kstep; const char* b3 = b2 + kstep;
            if (last && has_next) S.a_ready(nxt);
            if constexpr (SP2) {
            PG8_LDB(B0, 0, 0); PG8_LDB(B1, 0, 1); PG8_SCHED; PG8_LDA(At, 0, 0); PG8_STAGE(PG8_SA(1, 1), a1 + hstep, voffA);
            PG8_WAIT_V(8); PG8_WAIT_L(0); PG8_BAR; PG8_MMA(0, 0, At, B0); PG8_MMA(0, 1, At, B1); PG8_BAR; PG8_SCHED;
            PG8_LDA(At, 0, 1); PG8_STAGE(PG8_SB(0, 0), b2, voffB); PG8_STAGE(PG8_SB(0, 1), b2 + hstep, voffB); PG8_STAGE(PG8_SA(0, 0), a2, voffA);
            PG8_WAIT_V(8); PG8_WAIT_L(0); PG8_BAR; PG8_MMA(1, 0, At, B0); PG8_MMA(1, 1, At, B1); PG8_BAR; PG8_SCHED;
            PG8_LDB(B0, 1, 0); PG8_LDB(B1, 1, 1); PG8_SCHED; PG8_LDA(At, 1, 0); PG8_STAGE(PG8_SA(0, 1), a2 + hstep, voffA);
            PG8_WAIT_V(8); PG8_WAIT_L(0); PG8_BAR; PG8_MMA(0, 0, At, B0); PG8_MMA(0, 1, At, B1); PG8_BAR; PG8_SCHED;
            PG8_LDA(At, 1, 1); PG8_STAGE(PG8_SB(1, 0), b3, voffB); PG8_STAGE(PG8_SB(1, 1), b3 + hstep, voffB); PG8_STAGE(PG8_SA(1, 0), a3, voffA);
            PG8_WAIT_V(8); PG8_WAIT_L(0); PG8_BAR; PG8_MMA(1, 0, At, B0); PG8_MMA(1, 1, At, B1); PG8_BAR; PG8_SCHED;
            } else {
            PG8_LDB(B0, 0, 0); PG8_SCHED; PG8_LDA(At, 0, 0); PG8_STAGE(PG8_SA(1, 1), a1 + hstep, voffA);
            PG8_WAIT_L(8); PG8_BAR; PG8_WAIT_L(0); PG8_MMA(0, 0, At, B0); PG8_BAR; PG8_SCHED;
            PG8_LDB(B1, 0, 1); PG8_STAGE(PG8_SB(0, 0), b2, voffB);
            PG8_BAR; PG8_WAIT_L(0); PG8_MMA(0, 1, At, B1); PG8_BAR;
            PG8_LDA(At, 0, 1); PG8_STAGE(PG8_SA(0, 0), a2, voffA);
            PG8_BAR; PG8_WAIT_L(0); PG8_MMA(1, 0, At, B0); PG8_BAR; PG8_SCHED;
            PG8_STAGE(PG8_SB(0, 1), b2 + hstep, voffB);
            PG8_WAIT_V(6); PG8_BAR; PG8_MMA(1, 1, At, B1); PG8_BAR;
            PG8_LDB(B0, 1, 0); PG8_SCHED; PG8_LDA(At, 1, 0); PG8_STAGE(PG8_SA(0, 1), a2 + hstep, voffA);
            PG8_WAIT_L(8); PG8_BAR; PG8_WAIT_L(0); PG8_MMA(0, 0, At, B0); PG8_BAR; PG8_SCHED;
            PG8_LDB(B1, 1, 1); PG8_STAGE(PG8_SB(1, 0), b3, voffB);
            PG8_BAR; PG8_WAIT_L(0); PG8_MMA(0, 1, At, B1); PG8_BAR;
            PG8_LDA(At, 1, 1); PG8_STAGE(PG8_SA(1, 0), a3, voffA);
            PG8_BAR; PG8_WAIT_L(0); PG8_MMA(1, 0, At, B0); PG8_BAR; PG8_SCHED;
            PG8_STAGE(PG8_SB(1, 1), b3 + hstep, voffB);
            PG8_WAIT_V(6); PG8_BAR; PG8_MMA(1, 1, At, B1); PG8_BAR;
            }
        }
        if constexpr (ALIGN_EPI) { if (wr == 0) PG8_BAR; }
        if constexpr (!Epi::AFTER_DRAIN) { E(acc, cur, wr, wc, fr, fq); S.done(cur); }
        if (!has_next) break;
#pragma unroll
        for (int a = 0; a < 2; ++a)
#pragma unroll
            for (int b = 0; b < 2; ++b)
#pragma unroll
                for (int m = 0; m < 4; ++m)
#pragma unroll
                    for (int n = 0; n < 2; ++n) acc[a][b][m][n] = (f32x4){0.f, 0.f, 0.f, 0.f};
        cur = nxt; cA = nA; cB = nB; ++ui;
        if constexpr (ALIGN_EPI) { if (wr == 1) PG8_BAR; }
    }
    PG8_WAIT_V(0);
    if constexpr (!ALIGN_EPI) { if (wr == 0) PG8_BAR; }
    PG8_BAR;
    if constexpr (Epi::AFTER_DRAIN) { E.fused(acc, cur, wr, wc, fr, fq, lds, wid, lane); S.done(cur); }
#undef PG8_SA
#undef PG8_SB
#undef PG8_STAGE
#undef PG8_LDA
#undef PG8_LDB
#undef PG8_MMA
#undef PG8_WAIT_V
#undef PG8_WAIT_L
#undef PG8_BAR
#undef PG8_SCHED
}
}

constexpr int NWAVES = 8;
constexpr int N_LAUNCHES = MK_N_LAUNCHES;
constexpr int PER_PHASE = 10;

constexpr int BATCH = 16, SEQ = 4096, D = 1024, NMETA = 16;
constexpr int M = BATCH * SEQ;
constexpr int NPROJ = 2048, NEXP = 32, DEXP = 512;
constexpr int NPANEL_MAX = 544, SLOTS = NPANEL_MAX * 256;
constexpr float LN_EPS = 1e-5f, GN_EPS = 1e-6f;
constexpr float ALPHA = 1.189207115002721f;

constexpr size_t MiB = 1u << 20;
constexpr size_t WS_CTL = 0, CTL_ZERO_BYTES = 1 * MiB;
constexpr size_t WS_WIN = 2 * MiB;
constexpr size_t WS_WOUT = 6 * MiB;
constexpr size_t WS_WPOOL = 8 * MiB;
constexpr size_t WS_RW = 8 * MiB + 256 * 1024;
constexpr size_t WS_METAK = 8 * MiB + 512 * 1024;
constexpr size_t WS_METAV = WS_METAK + 16 * 256 * 4;
constexpr size_t WS_METAU = WS_METAV + 16 * 512 * 4;
constexpr size_t WS_ROPE = 9 * MiB;
constexpr size_t WS_TOKE = 12 * MiB;
constexpr size_t WS_TOKL = WS_TOKE + (size_t)M * 4;
constexpr size_t WS_TOKW = WS_TOKL + (size_t)M * 4;
constexpr size_t WS_TOKS = WS_TOKW + (size_t)M * 8;
constexpr size_t WS_CNT = 14 * MiB;
constexpr size_t WS_PW = 15 * MiB;
constexpr size_t WS_WGU = 32 * MiB;
constexpr size_t WS_WD = 96 * MiB;
constexpr size_t WS_ST = 128 * MiB;
constexpr size_t WS_H0 = 160 * MiB;
constexpr size_t WS_Q = 288 * MiB, WS_K = 320 * MiB;
constexpr size_t WS_V = 352 * MiB, WS_GATE = 416 * MiB, WS_U = 480 * MiB;
constexpr size_t WS_MIXIN = 544 * MiB;
constexpr size_t WS_T1 = 672 * MiB;
constexpr size_t WS_H1B = 288 * MiB;
constexpr size_t WS_XG = 416 * MiB;
constexpr size_t WS_HID = 688 * MiB;
constexpr size_t WS_YP = 416 * MiB;
constexpr size_t WS_END = 928 * MiB;
static_assert(WS_ROPE + (size_t)4112 * 32 * 8 <= WS_TOKE && WS_TOKS + (size_t)M * 8 <= WS_CNT && WS_PW + (size_t)SLOTS * 4 <= WS_WGU, "small tables");
static_assert(WS_K == WS_Q + (size_t)M * 256 * 2 && WS_GATE == WS_V + (size_t)M * 512 * 2 && WS_U == WS_GATE + (size_t)M * 512 * 2, "EpiProj addresses K, gate, u relative to Q, V");
static_assert(WS_XG + (size_t)SLOTS * 1024 * 2 <= WS_HID && WS_HID + (size_t)SLOTS * 512 * 2 <= WS_END && WS_T1 + (size_t)M * 1024 * 4 <= WS_END, "d_ws map");
constexpr int CW_BAR = 4096;

constexpr int RING_OFF = 0, RING_BYTES = 131072;
constexpr int LDSCTL_OFF = RING_BYTES;
constexpr int PP_OFF = LDSCTL_OFF, TOT_OFF = LDSCTL_OFF + 192, BEF_OFF = LDSCTL_OFF + 320, BASE_OFF = LDSCTL_OFF + 448, LCNT_OFF = LDSCTL_OFF + 576, MISC_OFF = LDSCTL_OFF + 768;
constexpr int LDS_BYTES = 147456;
static_assert(MISC_OFF + 128 <= LDS_BYTES, "LDS map");
#define GAS __attribute__((address_space(1)))
#define LAS __attribute__((address_space(3)))
typedef unsigned short bf16;
typedef unsigned v4u __attribute__((ext_vector_type(4)));
typedef float f32x4 __attribute__((ext_vector_type(4)));
typedef short bf16x8 __attribute__((ext_vector_type(8)));
typedef GAS unsigned gu32;
typedef GAS unsigned long long gu64;
#define RLX_AGENT __ATOMIC_RELAXED, __HIP_MEMORY_SCOPE_AGENT
#define LDS_WAIT() asm volatile("s_waitcnt lgkmcnt(0)" ::: "memory")
#define VM_WAIT() asm volatile("s_waitcnt vmcnt(0)" ::: "memory")
__device__ __forceinline__ unsigned long long rt() { return __builtin_amdgcn_s_memrealtime(); }
__device__ __forceinline__ unsigned f2bf(float f) { unsigned u = __builtin_bit_cast(unsigned, f); return (u + 0x7fffu + ((u >> 16) & 1u)) >> 16; }
__device__ __forceinline__ unsigned pk2(float lo, float hi) { return f2bf(lo) | (f2bf(hi) << 16); }

#define XB_TMO      128
#define XB_XCNT(j)  (256  + 64 * (j))
#define XB_XSUB(j)  (1280 + 64 * (j))
#define XB_XGEN(j)  (2304 + 64 * (j))
#define XB_TOP      3328
#define XB_TOPGEN   3392
#define XCD_BAR_WORDS 3456
#define XB_SPIN_CAP (1u << 18)

__device__ __forceinline__ unsigned xb_ld(unsigned* p)              { return __hip_atomic_load(p, __ATOMIC_RELAXED, __HIP_MEMORY_SCOPE_AGENT); }
__device__ __forceinline__ unsigned xb_add(unsigned* p, unsigned v) { return __hip_atomic_fetch_add(p, v, __ATOMIC_RELAXED, __HIP_MEMORY_SCOPE_AGENT); }
__device__ __forceinline__ unsigned xb_xcc_id() { return (unsigned)__builtin_amdgcn_s_getreg((3 << 11) | 20) & 0xFu; }
#define XB_SPIN(cond, bar) do { unsigned _sp = 0; while (cond) { __builtin_amdgcn_s_sleep(1); \
    if ((++_sp & 255u) == 0u) { if (xb_ld(&(bar)[XB_TMO])) break; if (_sp > XB_SPIN_CAP) { atomicAdd(&(bar)[XB_TMO], 1u); break; } } } } while (0)

struct XcdBarrier {
    unsigned* bar; unsigned x;
    volatile LAS unsigned* st;
};

__device__ __forceinline__ XcdBarrier xcd_barrier_post(unsigned* bar, volatile LAS unsigned* st) {
    XcdBarrier b; b.bar = bar; b.x = xb_xcc_id(); b.st = st;
    if (threadIdx.x == 0) (void)xb_add(&bar[XB_XCNT(b.x)], 1u);
    return b;
}
__device__ __forceinline__ void xcd_barrier_complete(unsigned* bar, unsigned x, unsigned& nloc, unsigned& nx) {
    const unsigned G = gridDim.x * gridDim.y * gridDim.z;
    unsigned sum, cnt, mine, sp = 0u;
    for (;;) {
        sum = 0u; cnt = 0u; mine = 0u;
#pragma unroll
        for (unsigned j = 0; j < 16; ++j) { const unsigned c = xb_ld(&bar[XB_XCNT(j)]); sum += c; cnt += (c > 0u) ? 1u : 0u; mine = (j == x) ? c : mine; }
        if (sum == G) break;
        __builtin_amdgcn_s_sleep(1);
        if ((++sp & 255u) == 0u) { if (xb_ld(&bar[XB_TMO])) break; if (sp > XB_SPIN_CAP) { atomicAdd(&bar[XB_TMO], 1u); break; } }
    }
    nloc = mine > 0u ? mine : 1u; nx = cnt > 0u ? cnt : 1u;
}

__device__ __forceinline__ void xcd_barrier(const XcdBarrier& b) {
    asm volatile("s_waitcnt vmcnt(0)" ::: "memory");
    __syncthreads();
    if (threadIdx.x == 0) {
        unsigned* bar = b.bar;
        __builtin_amdgcn_s_waitcnt(0);
        unsigned nloc = b.st[0], nx = b.st[1];
        if (nloc == 0u) { xcd_barrier_complete(bar, b.x, nloc, nx); b.st[0] = nloc; b.st[1] = nx; }
        const unsigned old = xb_add(&bar[XB_XSUB(b.x)], 1u);
        const unsigned gen = old / nloc;
        if (old + 1u == (gen + 1u) * nloc) {
            __builtin_amdgcn_fence(__ATOMIC_RELEASE, "agent");
            asm volatile("s_waitcnt vmcnt(0)" ::: "memory");
            const unsigned og = xb_add(&bar[XB_TOP], 1u);
            const unsigned tg = og / nx;
            if (og + 1u == (tg + 1u) * nx) xb_add(&bar[XB_TOPGEN], 1u);
            else XB_SPIN(xb_ld(&bar[XB_TOPGEN]) == tg, bar);
            __builtin_amdgcn_fence(__ATOMIC_ACQUIRE, "agent");
            xb_add(&bar[XB_XGEN(b.x)], 1u);
            asm volatile("s_waitcnt vmcnt(0)" ::: "memory");
        } else {
            XB_SPIN(xb_ld(&bar[XB_XGEN(b.x)]) == gen, bar);
            __builtin_amdgcn_fence(__ATOMIC_ACQUIRE, "agent");
            asm volatile("s_waitcnt vmcnt(0)" ::: "memory");
        }
    }
    __syncthreads();
}

#define DI __device__ __forceinline__
typedef short v4i16_t __attribute__((ext_vector_type(4)));
typedef unsigned u32x2 __attribute__((ext_vector_type(2)));
typedef float f32x2 __attribute__((ext_vector_type(2)));
struct Frame {
    LAS unsigned char* lds;
    volatile LAS unsigned* MISC;
    gu32* ctl;
    int tid, lane, wave;
    int vcu, G;
    const float *x, *meta, *lne_g, *lne_b, *w_in, *pool_w, *pool_b, *pool_scale, *w_out, *ln1_g, *ln1_b, *rg_w, *rg_b, *re_w, *re_b, *w_gate, *w_up, *w_down, *ln2_g, *ln2_b;
    float* out;
    bf16 *Win_t, *Wout_t, *Wpool_t, *Wgu_t, *Wd_t;
    float *RW, *metak, *metav, *metau, *rope, *T1, *PW;
    unsigned *toke, *tokl; f32x2* tokw; int* toks; int* cnt;
    bf16 *ST, *H0, *Qb, *Kb, *Vb, *Gb, *Ub, *MIXIN, *H1B, *XG, *HID, *YP;
};
DI float wave_sum(float v) {
#pragma unroll
    for (int o = 1; o < 64; o <<= 1) v += __shfl_xor(v, o);
    return v;
}
DI float bf2f(bf16 v) { return __uint_as_float(((unsigned)v) << 16); }
DI float bflo(unsigned w) { return __uint_as_float(w << 16); }
DI float bfhi(unsigned w) { return __uint_as_float(w & 0xffff0000u); }
DI unsigned cvtpk(float lo, float hi) { return pg8::cvt_pk_bf16(lo, hi); }

template <int MODE> DI int rowmap(int n) {
    if (MODE == 1) { if (n < 512) { const int i = n & 63; return (n & ~63) + (i < 32 ? 2 * i : 2 * (i - 32) + 1); } return n; }
    if (MODE == 2) return 256 * (n >> 7) + (n & 127);
    if (MODE == 3) return 256 * (n >> 7) + 128 + (n & 127);
    return n;
}
template <int MODE> DI void p0_transpose_item(const float* W, int K, int N, bf16* WT, LAS float* scr, int item, int lane) {
    const int nblk = N / 32, kb = item / nblk, nb = item % nblk, k0 = 64 * kb, n0 = 32 * nb;
#pragma unroll 8
    for (int i = 0; i < 32; ++i) { const int kk = 2 * i + (lane >> 5); scr[kk * 33 + (lane & 31)] = W[(size_t)(k0 + kk) * N + n0 + (lane & 31)]; }
    LDS_WAIT(); asm volatile("" ::: "memory");
    const int c = lane & 7;
#pragma unroll
    for (int j = 0; j < 4; ++j) { const int n = (lane >> 3) + 8 * j; const LAS float* s = scr + (8 * c) * 33 + n;
        v4u o; o.x = pk2(s[0 * 33], s[1 * 33]); o.y = pk2(s[2 * 33], s[3 * 33]); o.z = pk2(s[4 * 33], s[5 * 33]); o.w = pk2(s[6 * 33], s[7 * 33]);
        *(GAS v4u*)(WT + (size_t)rowmap<MODE>(n0 + n) * K + k0 + 8 * c) = o; }
    LDS_WAIT(); asm volatile("" ::: "memory");
}
DI void ln_row(const float* xrow, const f32x4 (&gv)[4], const f32x4 (&bv)[4], f32x4 (&v)[4], int lane, float eps) {
    const GAS f32x4* xr = (const GAS f32x4*)xrow + lane; float s = 0.f;
#pragma unroll
    for (int j = 0; j < 4; ++j) { v[j] = xr[64 * j]; s += (v[j].x + v[j].y) + (v[j].z + v[j].w); }
    const float mean = wave_sum(s) * (1.f / D); float s2 = 0.f;
#pragma unroll
    for (int j = 0; j < 4; ++j) { v[j] = v[j] - mean; s2 += (v[j].x * v[j].x + v[j].y * v[j].y) + (v[j].z * v[j].z + v[j].w * v[j].w); }
    const float rstd = 1.f / sqrtf(wave_sum(s2) * (1.f / D) + eps);
#pragma unroll
    for (int j = 0; j < 4; ++j) v[j] = v[j] * rstd * gv[j] + bv[j];
}
DI void store_row_bf16(bf16* orow, const f32x4 (&v)[4], int lane) {
    GAS unsigned long long* o8 = (GAS unsigned long long*)orow + lane;
#pragma unroll
    for (int j = 0; j < 4; ++j) o8[64 * j] = (unsigned long long)pk2(v[j].x, v[j].y) | ((unsigned long long)pk2(v[j].z, v[j].w) << 32);
}
DI void p0_prologue(Frame& F) {
    LAS float* scr = (LAS float*)(F.lds + RING_OFF + F.wave * 16384);
    const int gw = F.vcu * NWAVES + F.wave, NGW = F.G * NWAVES;
    constexpr int I_IN = 16 * 64, I_OUT = 16 * 32, I_POOL = 4 * 8, I_G = 32 * 256, I_U = 32 * 256, I_D = 32 * 256;
    constexpr int NITEMS = I_IN + I_OUT + I_POOL + I_G + I_U + I_D;
    for (int it = gw; it < NITEMS; it += NGW) {
        int r = it;
        if (r < I_IN) { p0_transpose_item<1>(F.w_in, 1024, 2048, F.Win_t, scr, r, F.lane); continue; } r -= I_IN;
        if (r < I_OUT) { p0_transpose_item<0>(F.w_out, 1024, 1024, F.Wout_t, scr, r, F.lane); continue; } r -= I_OUT;
        if (r < I_POOL) { const int g = r >> 3; p0_transpose_item<0>(F.pool_w + g * 16384, 128, 128, F.Wpool_t + g * 16384, scr, r & 7, F.lane); continue; } r -= I_POOL;
        if (r < I_G) { const int e = r >> 8; p0_transpose_item<2>(F.w_gate + (size_t)e * 524288, 1024, 512, F.Wgu_t + (size_t)e * 1048576, scr, r & 255, F.lane); continue; } r -= I_G;
        if (r < I_U) { const int e = r >> 8; p0_transpose_item<3>(F.w_up + (size_t)e * 524288, 1024, 512, F.Wgu_t + (size_t)e * 1048576, scr, r & 255, F.lane); continue; } r -= I_U;
        { const int e = r >> 8; p0_transpose_item<0>(F.w_down + (size_t)e * 524288, 512, 1024, F.Wd_t + (size_t)e * 524288, scr, r & 255, F.lane); }
    }
    { f32x4 gv[4], bv[4];
#pragma unroll
      for (int j = 0; j < 4; ++j) { gv[j] = *(const f32x4*)(F.lne_g + 4 * F.lane + 256 * j); bv[j] = *(const f32x4*)(F.lne_b + 4 * F.lane + 256 * j); }
      for (int m = gw; m < M; m += NGW) { f32x4 v[4]; ln_row(F.x + (size_t)m * D, gv, bv, v, F.lane, LN_EPS); store_row_bf16(F.H0 + (size_t)m * D, v, F.lane); }
    }
    { const int gt = gw * 64 + F.lane, NT = NGW * 64;
      for (int idx = gt; idx < 4112 * 32; idx += NT) { const int pos = idx >> 5, i = idx & 31;
          const float inv = exp2f(-(float)i * 0.415241011860920f);
          const float ang = (float)pos * inv;
          const double a = (double)ang; const double k = __builtin_rint(a * 0.15915494309189535); const float rr = (float)__builtin_fma(-k, 6.283185307179586, a);
          F.rope[(size_t)idx * 2] = cosf(rr); F.rope[(size_t)idx * 2 + 1] = sinf(rr); }
      for (int idx = gt; idx < 36 * 1024; idx += NT) { const int c = idx >> 10, k = idx & 1023; F.RW[idx] = c < 4 ? F.rg_w[k * 4 + c] : F.re_w[k * 32 + (c - 4)]; }
    }
    if (blockIdx.x < 20) {
        __syncthreads();
        LAS float* ML = (LAS float*)(F.lds);
        LAS float* RED = (LAS float*)(F.lds + 65536);
        LAS float* OUTM = (LAS float*)(F.lds + 98304);
        { f32x4 gv[4], bv[4];
#pragma unroll
          for (int j = 0; j < 4; ++j) { gv[j] = *(const f32x4*)(F.lne_g + 4 * F.lane + 256 * j); bv[j] = *(const f32x4*)(F.lne_b + 4 * F.lane + 256 * j); }
          for (int rr = 0; rr < 2; ++rr) { const int m = F.wave * 2 + rr; f32x4 v[4]; ln_row(F.meta + (size_t)m * D, gv, bv, v, F.lane, LN_EPS);
#pragma unroll
              for (int j = 0; j < 4; ++j) *(LAS f32x4*)(ML + m * 1024 + 4 * F.lane + 256 * j) = v[j]; } }
        __syncthreads();
        const int item = blockIdx.x;
        const int col0 = item < 4 ? 256 + 64 * item : (item < 12 ? 512 + 64 * (item - 4) : 1536 + 64 * (item - 12));
        float acc[16];
#pragma unroll
        for (int m = 0; m < 16; ++m) acc[m] = 0.f;
        for (int kk = 0; kk < 128; ++kk) { const int k = F.wave * 128 + kk; const float wv = F.w_in[(size_t)k * 2048 + col0 + F.lane];
#pragma unroll
            for (int m = 0; m < 16; ++m) acc[m] += ML[m * 1024 + k] * wv; }
#pragma unroll
        for (int m = 0; m < 16; ++m) RED[(F.wave * 16 + m) * 64 + F.lane] = acc[m];
        __syncthreads();
        for (int o = F.tid; o < 1024; o += 512) { float s = 0.f;
#pragma unroll
            for (int w = 0; w < 8; ++w) s += RED[w * 1024 + o];
            OUTM[o] = s; }
        __syncthreads();
        for (int o = F.tid; o < 1024; o += 512) { const int m = o >> 6, ii = o & 63;
            if (item < 4) {
                const int i = ii >> 1; const float x1 = OUTM[m * 64 + i], x2 = OUTM[m * 64 + 32 + i];
                const float inv = exp2f(-(float)i * 0.415241011860920f); const float ang = (float)m * inv;
                const double a = (double)ang; const double kq = __builtin_rint(a * 0.15915494309189535); const float rr = (float)__builtin_fma(-kq, 6.283185307179586, a);
                const float cs = cosf(rr), sn = sinf(rr);
                F.metak[m * 256 + item * 64 + ii] = ((ii & 1) ? (x1 * sn + x2 * cs) : (x1 * cs - x2 * sn)) * 0.125f;
            } else if (item < 12) F.metav[m * 512 + (item - 4) * 64 + ii] = OUTM[o];
            else F.metau[m * 512 + (item - 12) * 64 + ii] = OUTM[o];
        }
        __syncthreads();
    }
}

DI void p2_scan(Frame& F) {
    LAS bf16* Ks = (LAS bf16*)(F.lds);
    LAS bf16* Vs = (LAS bf16*)(F.lds + 16384);
    LAS float* Z = (LAS float*)(F.lds + 24576);
    for (int unit = blockIdx.x; unit < 256; unit += F.G) {
        const int b = unit >> 4, h = (unit >> 2) & 3, vs = unit & 3;
        const int d = F.tid >> 3, vq = F.tid & 7;
        const float lg = log2f(1.0f - exp2f(-5.0f - (float)h));
        __syncthreads();
        if (F.tid < 128) Z[F.tid] = exp2f((float)(127 - F.tid) * lg);
        float st[4] = {0.f, 0.f, 0.f, 0.f};
        for (int m = 0; m < 16; ++m) { const float kz = F.metak[m * 256 + h * 64 + d] * exp2f((float)(15 - m) * lg);
            const f32x4 vv = *(const f32x4*)(F.metav + m * 512 + h * 128 + vs * 32 + 4 * vq);
            st[0] += kz * vv.x; st[1] += kz * vv.y; st[2] += kz * vv.z; st[3] += kz * vv.w; }
        const float cd = exp2f(128.0f * lg);
        bf16* STb = F.ST + (size_t)((b * 4 + h) * 32) * 8192;
        const size_t rowbase = (size_t)b * 4096;
        for (int n = 0; n < 32; ++n) {
#pragma unroll
            for (int x = 0; x < 4; ++x) STb[(size_t)n * 8192 + (vs * 32 + 4 * vq + x) * 64 + d] = (bf16)f2bf(st[x]);
            if (n == 31) break;
            __syncthreads();
#pragma unroll
            for (int i = 0; i < 2; ++i) { const int ch = F.tid + 512 * i, r = ch >> 3, c8 = ch & 7;
                *(LAS v4u*)(Ks + r * 64 + c8 * 8) = *(const GAS v4u*)(F.Kb + (rowbase + n * 128 + r) * 256 + h * 64 + c8 * 8); }
            { const int r = F.tid >> 2, c4 = F.tid & 3;
                *(LAS v4u*)(Vs + r * 32 + c4 * 8) = *(const GAS v4u*)(F.Vb + (rowbase + n * 128 + r) * 512 + h * 128 + vs * 32 + c4 * 8); }
            __syncthreads();
            float a0 = 0.f, a1 = 0.f, a2 = 0.f, a3 = 0.f;
#pragma unroll 8
            for (int j = 0; j < 128; ++j) { const float kz = bf2f(Ks[j * 64 + d]) * Z[j]; const u32x2 vv = *(const LAS u32x2*)(Vs + j * 32 + 4 * vq);
                a0 += kz * bflo(vv.x); a1 += kz * bfhi(vv.x); a2 += kz * bflo(vv.y); a3 += kz * bfhi(vv.y); }
            st[0] = cd * st[0] + a0; st[1] = cd * st[1] + a1; st[2] = cd * st[2] + a2; st[3] = cd * st[3] + a3;
        }
    }
    __syncthreads();
}

DI f32x4 mma(bf16x8 xf, bf16x8 yf, f32x4 acc) { return __builtin_amdgcn_mfma_f32_16x16x32_bf16(xf, yf, acc, 0, 0, 0); }
DI bf16x8 frag_row(const LAS unsigned char* base, int stride, int row0, int k0, int lane) {
    return *(const LAS bf16x8*)(base + (row0 + (lane & 15)) * stride + (k0 + 8 * (lane >> 4)) * 2);
}
DI bf16x8 frag_tr(const LAS unsigned char* base, int stride, int k0, int x0, int lane) {
    const int g = lane >> 4, q = (lane & 15) >> 2, p = lane & 3;
    const LAS unsigned char* a = base + (k0 + 8 * g + q) * stride + (x0 + 4 * p) * 2;
    const v4i16_t lo = __builtin_amdgcn_ds_read_tr16_b64_v4i16((LAS v4i16_t*)a);
    const v4i16_t hi = __builtin_amdgcn_ds_read_tr16_b64_v4i16((LAS v4i16_t*)(a + 4 * stride));
    return __builtin_shufflevector(lo, hi, 0, 1, 2, 3, 4, 5, 6, 7);
}
constexpr int SQ = 144, SV = 272;
DI void ret_unit(Frame& F, int b, int h, int nn) {
    LAS unsigned char* QS = F.lds; LAS unsigned char* KS = F.lds + 18432; LAS unsigned char* VS = F.lds + 36864; LAS unsigned char* SS = F.lds + 71680; LAS unsigned char* CS = F.lds + 90112;
    const size_t R0 = (size_t)b * 4096 + (size_t)nn * 128;
    __syncthreads();
#pragma unroll
    for (int i = 0; i < 2; ++i) { const int ch = F.tid + 512 * i, r = ch >> 3, c8 = ch & 7;
        *(LAS v4u*)(QS + r * SQ + c8 * 16) = *(const GAS v4u*)(F.Qb + (R0 + r) * 256 + h * 64 + c8 * 8);
        *(LAS v4u*)(KS + r * SQ + c8 * 16) = *(const GAS v4u*)(F.Kb + (R0 + r) * 256 + h * 64 + c8 * 8);
        *(LAS v4u*)(SS + r * SQ + c8 * 16) = *(const GAS v4u*)(F.ST + (size_t)((b * 4 + h) * 32 + nn) * 8192 + r * 64 + c8 * 8); }
#pragma unroll
    for (int i = 0; i < 4; ++i) { const int ch = F.tid + 512 * i, r = ch >> 4, c16 = ch & 15;
        *(LAS v4u*)(VS + r * SV + c16 * 16) = *(const GAS v4u*)(F.Vb + (R0 + r) * 512 + h * 128 + c16 * 8); }
    __syncthreads();
    const int w = F.wave, lane = F.lane, fr = lane & 15, fq = lane >> 4;
    const float lg = log2f(1.0f - exp2f(-5.0f - (float)h));
    const int il = 16 * w + fr;
    const bf16x8 qf0 = frag_row(QS, SQ, 16 * w, 0, lane), qf1 = frag_row(QS, SQ, 16 * w, 32, lane);
    const int jtmax = w | 1;
    for (int jt = 0; jt <= jtmax; ++jt) {
        f32x4 a = {0.f, 0.f, 0.f, 0.f};
        a = mma(frag_row(KS, SQ, 16 * jt, 0, lane), qf0, a); a = mma(frag_row(KS, SQ, 16 * jt, 32, lane), qf1, a);
        float o[4];
#pragma unroll
        for (int r = 0; r < 4; ++r) { const int dl = il - (16 * jt + 4 * fq + r); o[r] = dl >= 0 ? a[r] * exp2f((float)dl * lg) : 0.f; }
        u32x2 pk; pk.x = cvtpk(o[0], o[1]); pk.y = cvtpk(o[2], o[3]);
        *(LAS u32x2*)(CS + il * SV + (16 * jt + 4 * fq) * 2) = pk;
    }
    asm volatile("s_waitcnt lgkmcnt(0)" ::: "memory");
    f32x4 accI[8], accC[8];
#pragma unroll
    for (int vt = 0; vt < 8; ++vt) { accI[vt] = (f32x4){0.f, 0.f, 0.f, 0.f}; accC[vt] = (f32x4){0.f, 0.f, 0.f, 0.f}; }
    const int kkmax = w >> 1;
    for (int kk = 0; kk <= kkmax; ++kk) { const bf16x8 cf = frag_row(CS, SV, 16 * w, 32 * kk, lane);
#pragma unroll
        for (int vt = 0; vt < 8; ++vt) accI[vt] = mma(frag_tr(VS, SV, 32 * kk, 16 * vt, lane), cf, accI[vt]); }
#pragma unroll
    for (int vt = 0; vt < 8; ++vt) { accC[vt] = mma(frag_row(SS, SQ, 16 * vt, 0, lane), qf0, accC[vt]); accC[vt] = mma(frag_row(SS, SQ, 16 * vt, 32, lane), qf1, accC[vt]); }
    const float xi = exp2f((float)(il + 1) * lg);
    float s = 0.f;
#pragma unroll
    for (int vt = 0; vt < 8; ++vt) { accI[vt] = accI[vt] + accC[vt] * xi; s += (accI[vt][0] + accI[vt][1]) + (accI[vt][2] + accI[vt][3]); }
    s += __shfl_xor(s, 16); s += __shfl_xor(s, 32);
    const float mean = s * (1.0f / 128.0f); float q = 0.f;
#pragma unroll
    for (int vt = 0; vt < 8; ++vt) { accI[vt] = accI[vt] - mean; q += (accI[vt][0] * accI[vt][0] + accI[vt][1] * accI[vt][1]) + (accI[vt][2] * accI[vt][2] + accI[vt][3] * accI[vt][3]); }
    q += __shfl_xor(q, 16); q += __shfl_xor(q, 32);
    const float rstd = 1.0f / sqrtf(q * (1.0f / 128.0f) + GN_EPS);
    const bf16* grow = F.Gb + (R0 + il) * 512 + h * 128 + 4 * fq; bf16* orow = F.MIXIN + (R0 + il) * 1024 + h * 128 + 4 * fq;
#pragma unroll
    for (int vt = 0; vt < 8; ++vt) { const u32x2 gb = *(const GAS u32x2*)(grow + 16 * vt);
        const float g0 = bflo(gb.x), g1 = bfhi(gb.x), g2 = bflo(gb.y), g3 = bfhi(gb.y);
        const float y0 = accI[vt][0] * rstd * g0 / (1.0f + __expf(-g0)), y1 = accI[vt][1] * rstd * g1 / (1.0f + __expf(-g1));
        const float y2 = accI[vt][2] * rstd * g2 / (1.0f + __expf(-g2)), y3 = accI[vt][3] * rstd * g3 / (1.0f + __expf(-g3));
        u32x2 pk; pk.x = cvtpk(y0, y1); pk.y = cvtpk(y2, y3); *(GAS u32x2*)(orow + 16 * vt) = pk; }
}
DI void pool_unit(Frame& F, int b, int g, int nn) {
    LAS unsigned char* US = F.lds; LAS unsigned char* PS = F.lds + 40960; LAS unsigned char* WSM = F.lds + 77824;
    const size_t R0 = (size_t)b * 4096 + (size_t)nn * 128;
    __syncthreads();
    for (int ch = F.tid; ch < 144 * 16; ch += 512) { const int rr = ch >> 4, c16 = ch & 15, t = nn * 128 - 16 + rr; v4u val;
        if (t >= 0) val = *(const GAS v4u*)(F.Ub + ((size_t)b * 4096 + t) * 512 + g * 128 + c16 * 8);
        else { const float* mu = F.metau + (16 + t) * 512 + g * 128 + c16 * 8; val.x = pk2(mu[0], mu[1]); val.y = pk2(mu[2], mu[3]); val.z = pk2(mu[4], mu[5]); val.w = pk2(mu[6], mu[7]); }
        *(LAS v4u*)(US + rr * SV + c16 * 16) = val; }
#pragma unroll
    for (int i = 0; i < 4; ++i) { const int ch = F.tid + 512 * i, r = ch >> 4, c16 = ch & 15;
        *(LAS v4u*)(WSM + r * SV + c16 * 16) = *(const GAS v4u*)(F.Wpool_t + g * 16384 + r * 128 + c16 * 8); }
    __syncthreads();
    const int win = 2 << g; const float invw = 1.0f / (float)win;
    { const int c2 = F.tid & 63, ib = F.tid >> 6; float run0 = 0.f, run1 = 0.f;
      for (int sI = 0; sI < win; ++sI) { const unsigned xw = *(const LAS unsigned*)(US + (16 + 16 * ib - sI) * SV + c2 * 4); run0 += bflo(xw); run1 += bfhi(xw); }
      for (int ii = 0; ii < 16; ++ii) { const int i = 16 * ib + ii; const unsigned cur = *(const LAS unsigned*)(US + (16 + i) * SV + c2 * 4);
          if (ii > 0) { const unsigned old = *(const LAS unsigned*)(US + (16 + i - win) * SV + c2 * 4); run0 += bflo(cur) - bflo(old); run1 += bfhi(cur) - bfhi(old); }
          *(LAS unsigned*)(PS + i * SV + c2 * 4) = cvtpk(run0 * invw - bflo(cur), run1 * invw - bfhi(cur)); } }
    __syncthreads();
    const int w = F.wave, lane = F.lane, fr = lane & 15, fq = lane >> 4;
    bf16x8 pf[4];
#pragma unroll
    for (int kk = 0; kk < 4; ++kk) pf[kk] = frag_row(PS, SV, 16 * w, 32 * kk, lane);
    bf16* orow = F.MIXIN + (R0 + 16 * w + fr) * 1024 + 512 + g * 128 + 4 * fq;
#pragma unroll
    for (int dt = 0; dt < 8; ++dt) { f32x4 a = {0.f, 0.f, 0.f, 0.f};
#pragma unroll
        for (int kk = 0; kk < 4; ++kk) a = mma(frag_row(WSM, SV, 16 * dt, 32 * kk, lane), pf[kk], a);
        const f32x4 pb = *(const f32x4*)(F.pool_b + g * 128 + 16 * dt + 4 * fq), psc = *(const f32x4*)(F.pool_scale + g * 128 + 16 * dt + 4 * fq);
        a = (a + pb) * psc;
        u32x2 pk; pk.x = cvtpk(a[0], a[1]); pk.y = cvtpk(a[2], a[3]); *(GAS u32x2*)(orow + 16 * dt) = pk; }
}
DI void p3_mixer(Frame& F) {
    int i = 0;
    for (int U = blockIdx.x; U < 4096; U += F.G, ++i) {
        const int tile = U >> 3, part = (U + i) & 7, b = tile >> 5, nn = tile & 31;
        if (part < 4) ret_unit(F, b, part, nn); else pool_unit(F, b, part - 4, nn);
    }
    __syncthreads();
}

DI void p5_ln_router(Frame& F) {
    LAS int* LCNT = (LAS int*)(F.lds + LCNT_OFF);
    if (F.tid < 32) LCNT[F.tid] = 0;
    __syncthreads();
    f32x4 gv[4], bv[4];
#pragma unroll
    for (int j = 0; j < 4; ++j) { gv[j] = *(const f32x4*)(F.ln1_g + 4 * F.lane + 256 * j); bv[j] = *(const f32x4*)(F.ln1_b + 4 * F.lane + 256 * j); }
    const int c = blockIdx.x;
    for (int r = 0; r < 32; ++r) {
        const int row = c * 256 + F.wave * 32 + r;
        f32x4 v[4]; ln_row(F.T1 + (size_t)row * D, gv, bv, v, F.lane, LN_EPS);
        store_row_bf16(F.H1B + (size_t)row * D, v, F.lane);
        float lgt[36];
#pragma unroll
        for (int cc = 0; cc < 36; ++cc) { const GAS f32x4* wr = (const GAS f32x4*)(F.RW + cc * 1024) + F.lane; float p = 0.f;
#pragma unroll
            for (int j = 0; j < 4; ++j) { const f32x4 wv = wr[64 * j]; p += (v[j].x * wv.x + v[j].y * wv.y) + (v[j].z * wv.z + v[j].w * wv.w); }
            lgt[cc] = wave_sum(p) + (cc < 4 ? F.rg_b[cc] : F.re_b[cc - 4]); }
        const float gmax = fmaxf(fmaxf(lgt[0], lgt[1]), fmaxf(lgt[2], lgt[3]));
        const int gi = lgt[0] == gmax ? 0 : (lgt[1] == gmax ? 1 : (lgt[2] == gmax ? 2 : 3));
        const float gp = 1.0f / ((expf(lgt[0] - gmax) + expf(lgt[1] - gmax)) + (expf(lgt[2] - gmax) + expf(lgt[3] - gmax)));
        float sel[8];
#pragma unroll
        for (int k = 0; k < 8; ++k) sel[k] = gi == 0 ? lgt[4 + k] : (gi == 1 ? lgt[12 + k] : (gi == 2 ? lgt[20 + k] : lgt[28 + k]));
        float m1 = sel[0];
#pragma unroll
        for (int k = 1; k < 8; ++k) m1 = fmaxf(m1, sel[k]);
        int i1 = 7;
#pragma unroll
        for (int k = 6; k >= 0; --k) i1 = sel[k] == m1 ? k : i1;
        float m2 = -3.0e38f;
#pragma unroll
        for (int k = 0; k < 8; ++k) m2 = (k != i1) ? fmaxf(m2, sel[k]) : m2;
        int i2 = -1;
#pragma unroll
        for (int k = 7; k >= 0; --k) i2 = (k != i1 && sel[k] == m2) ? k : i2;
        const float tt = expf(m2 - m1); const float w0 = gp / (1.0f + tt), w1 = gp * tt / (1.0f + tt);
        if (F.lane == 0) { const int e0 = gi * 8 + i1, e1 = gi * 8 + i2;
            const int li0 = __hip_atomic_fetch_add(LCNT + e0, 1, __ATOMIC_RELAXED, __HIP_MEMORY_SCOPE_WORKGROUP), li1 = __hip_atomic_fetch_add(LCNT + e1, 1, __ATOMIC_RELAXED, __HIP_MEMORY_SCOPE_WORKGROUP);
            F.toke[row] = (unsigned)e0 | ((unsigned)e1 << 8); F.tokl[row] = (unsigned)li0 | ((unsigned)li1 << 16); F.tokw[row] = (f32x2){w0, w1}; }
    }
    __syncthreads();
    if (F.tid < 32) F.cnt[c * 32 + F.tid] = LCNT[F.tid];
}
DI void moe_layout(Frame& F) {
    LAS int* red = (LAS int*)(F.lds);
    LAS int* PP = (LAS int*)(F.lds + PP_OFF); LAS int* TOT = (LAS int*)(F.lds + TOT_OFF); LAS int* BEF = (LAS int*)(F.lds + BEF_OFF); LAS int* BASE = (LAS int*)(F.lds + BASE_OFF);
    __syncthreads();
    { const int e = F.tid & 31, part = F.tid >> 5; int tot = 0, bef = 0;
      for (int k = 0; k < 16; ++k) { const int c2 = part * 16 + k; const int v = F.cnt[c2 * 32 + e]; tot += v; bef += (c2 < (int)blockIdx.x) ? v : 0; }
      red[(part * 32 + e) * 2] = tot; red[(part * 32 + e) * 2 + 1] = bef; }
    __syncthreads();
    if (F.tid < 32) { int t = 0, bf = 0;
        for (int p = 0; p < 16; ++p) { t += red[(p * 32 + F.tid) * 2]; bf += red[(p * 32 + F.tid) * 2 + 1]; }
        TOT[F.tid] = t; BEF[F.tid] = bf; }
    __syncthreads();
    if (F.tid == 0) { int acc = 0; for (int e = 0; e < 32; ++e) { PP[e] = acc; acc += (TOT[e] + 255) >> 8; } PP[32] = acc; }
    __syncthreads();
    if (F.tid < 32) BASE[F.tid] = PP[F.tid] * 256 + BEF[F.tid];
    __syncthreads();
}
DI void p6_assign_gather(Frame& F) {
    moe_layout(F);
    const LAS int* BASE = (const LAS int*)(F.lds + BASE_OFF);
    const int c = blockIdx.x;
    for (int r = 0; r < 32; ++r) {
        const int row = c * 256 + F.wave * 32 + r;
        const unsigned te = F.toke[row], tl = F.tokl[row];
        const int s0 = BASE[te & 255u] + (int)(tl & 0xffffu), s1 = BASE[(te >> 8) & 255u] + (int)(tl >> 16);
        const GAS v4u* src = (const GAS v4u*)(F.H1B + (size_t)row * D); const v4u a = src[F.lane], b2 = src[F.lane + 64];
        GAS v4u* d0 = (GAS v4u*)(F.XG + (size_t)s0 * D); GAS v4u* d1 = (GAS v4u*)(F.XG + (size_t)s1 * D);
        d0[F.lane] = a; d0[F.lane + 64] = b2; d1[F.lane] = a; d1[F.lane + 64] = b2;
        if (F.lane == 0) { F.toks[row * 2] = s0; F.toks[row * 2 + 1] = s1; const f32x2 wv = F.tokw[row]; F.PW[s0] = wv.x; F.PW[s1] = wv.y; }
    }
}
DI void p9_final(Frame& F) {
    const int gw = F.vcu * NWAVES + F.wave, NGW = F.G * NWAVES;
    f32x4 gv[4], bv[4];
#pragma unroll
    for (int j = 0; j < 4; ++j) { gv[j] = *(const f32x4*)(F.ln2_g + 4 * F.lane + 256 * j); bv[j] = *(const f32x4*)(F.ln2_b + 4 * F.lane + 256 * j); }
    for (int row = gw; row < M; row += NGW) {
        const int s0 = F.toks[row * 2], s1 = F.toks[row * 2 + 1];
        const GAS u32x2* hp = (const GAS u32x2*)(F.H1B + (size_t)row * D) + F.lane;
        const GAS u32x2* y0 = (const GAS u32x2*)(F.YP + (size_t)s0 * D) + F.lane; const GAS u32x2* y1 = (const GAS u32x2*)(F.YP + (size_t)s1 * D) + F.lane;
        f32x4 v[4]; float s = 0.f;
#pragma unroll
        for (int j = 0; j < 4; ++j) { const u32x2 hb = hp[64 * j], a = y0[64 * j], b2 = y1[64 * j];
            v[j].x = ALPHA * bflo(hb.x) + (bflo(a.x) + bflo(b2.x)); v[j].y = ALPHA * bfhi(hb.x) + (bfhi(a.x) + bfhi(b2.x));
            v[j].z = ALPHA * bflo(hb.y) + (bflo(a.y) + bflo(b2.y)); v[j].w = ALPHA * bfhi(hb.y) + (bfhi(a.y) + bfhi(b2.y));
            s += (v[j].x + v[j].y) + (v[j].z + v[j].w); }
        const float mean = wave_sum(s) * (1.f / D); float s2 = 0.f;
#pragma unroll
        for (int j = 0; j < 4; ++j) { v[j] = v[j] - mean; s2 += (v[j].x * v[j].x + v[j].y * v[j].y) + (v[j].z * v[j].z + v[j].w * v[j].w); }
        const float rstd = 1.f / sqrtf(wave_sum(s2) * (1.f / D) + LN_EPS);
        GAS f32x4* op = (GAS f32x4*)(F.out + (size_t)row * D) + F.lane;
#pragma unroll
        for (int j = 0; j < 4; ++j) op[64 * j] = v[j] * rstd * gv[j] + bv[j];
    }
}

struct Args { const float* in[20]; float* out; unsigned char* ws; int ph_lo, ph_hi; };
__global__ void __launch_bounds__(NWAVES * 64, 2) hrp_fwd(Args args) {
    extern __shared__ __attribute__((aligned(16))) unsigned char lds[];
    Frame F;
    F.lds = (LAS unsigned char*)lds;
    F.MISC = (volatile LAS unsigned*)(F.lds + MISC_OFF);
    F.tid = threadIdx.x; F.lane = F.tid & 63; F.wave = __builtin_amdgcn_readfirstlane(F.tid >> 6);
    F.G = gridDim.x; { const int bx = blockIdx.x; F.vcu = (F.G % 8 == 0) ? (bx % 8) * (F.G / 8) + bx / 8 : bx; }
    unsigned char* ws = args.ws;
    F.ctl = (gu32*)(ws + WS_CTL);
    F.x = args.in[0]; F.meta = args.in[1]; F.lne_g = args.in[2]; F.lne_b = args.in[3]; F.w_in = args.in[4]; F.pool_w = args.in[5]; F.pool_b = args.in[6]; F.pool_scale = args.in[7];
    F.w_out = args.in[8]; F.ln1_g = args.in[9]; F.ln1_b = args.in[10]; F.rg_w = args.in[11]; F.rg_b = args.in[12]; F.re_w = args.in[13]; F.re_b = args.in[14];
    F.w_gate = args.in[15]; F.w_up = args.in[16]; F.w_down = args.in[17]; F.ln2_g = args.in[18]; F.ln2_b = args.in[19]; F.out = args.out;
    F.Win_t = (bf16*)(ws + WS_WIN); F.Wout_t = (bf16*)(ws + WS_WOUT); F.Wpool_t = (bf16*)(ws + WS_WPOOL); F.Wgu_t = (bf16*)(ws + WS_WGU); F.Wd_t = (bf16*)(ws + WS_WD);
    F.RW = (float*)(ws + WS_RW); F.metak = (float*)(ws + WS_METAK); F.metav = (float*)(ws + WS_METAV); F.metau = (float*)(ws + WS_METAU); F.rope = (float*)(ws + WS_ROPE);
    F.T1 = (float*)(ws + WS_T1); F.PW = (float*)(ws + WS_PW);
    F.toke = (unsigned*)(ws + WS_TOKE); F.tokl = (unsigned*)(ws + WS_TOKL); F.tokw = (f32x2*)(ws + WS_TOKW); F.toks = (int*)(ws + WS_TOKS); F.cnt = (int*)(ws + WS_CNT);
    F.ST = (bf16*)(ws + WS_ST); F.H0 = (bf16*)(ws + WS_H0); F.Qb = (bf16*)(ws + WS_Q); F.Kb = (bf16*)(ws + WS_K); F.Vb = (bf16*)(ws + WS_V); F.Gb = (bf16*)(ws + WS_GATE); F.Ub = (bf16*)(ws + WS_U);
    F.MIXIN = (bf16*)(ws + WS_MIXIN); F.H1B = (bf16*)(ws + WS_H1B); F.XG = (bf16*)(ws + WS_XG); F.HID = (bf16*)(ws + WS_HID); F.YP = (bf16*)(ws + WS_YP);
    for (int u = F.tid; u < (LDS_BYTES - LDSCTL_OFF) / 4; u += NWAVES * 64) ((LAS unsigned*)(F.lds + LDSCTL_OFF))[u] = 0u;
    __syncthreads();
    if (F.G != 256) return;
    XcdBarrier bar; bar.bar = (unsigned*)(F.ctl + CW_BAR); bar.x = 0; bar.st = nullptr;
    if (N_LAUNCHES != PER_PHASE) bar = xcd_barrier_post((unsigned*)(F.ctl + CW_BAR), F.MISC + 8);
#define GRID_BAR() do { if (N_LAUNCHES != PER_PHASE) xcd_barrier(bar); } while (0)
    const int lo = args.ph_lo, hi = args.ph_hi;
#define IN(k) (lo <= (k) && (k) < hi)
#define BOTH(k) (IN(k) && IN((k) + 1))

    if (IN(0)) { p0_prologue(F); if (BOTH(0)) GRID_BAR(); }
    if (IN(1)) {
        pg8::Gemm g{F.H0, F.Win_t, M, NPROJ, D}; pg8::StaticOrder S; S.init(M, NPROJ, F.G, (int)blockIdx.x);
        pg8::EpiProj E{F.Qb, F.Vb, F.rope};
        pg8::gemm_phase<pg8::EpiProj, pg8::StaticOrder, true, true>(F.lds + RING_OFF, g, S, E);
        if (BOTH(1)) GRID_BAR();
    }
    if (IN(2)) { p2_scan(F); if (BOTH(2)) GRID_BAR(); }
    if (IN(3)) { p3_mixer(F); if (BOTH(3)) GRID_BAR(); }
    if (IN(4)) {
        pg8::Gemm g{F.MIXIN, F.Wout_t, M, D, D}; pg8::StaticOrder S; S.init(M, D, F.G, (int)blockIdx.x);
        pg8::EpiRes E{F.H0, F.T1, ALPHA};
        pg8::gemm_phase<pg8::EpiRes, pg8::StaticOrder, true, true>(F.lds + RING_OFF, g, S, E);
        if (BOTH(4)) GRID_BAR();
    }
    if (IN(5)) { p5_ln_router(F); if (BOTH(5)) GRID_BAR(); }
    if (IN(6)) { p6_assign_gather(F); if (BOTH(6)) GRID_BAR(); }
    if (IN(7)) {
        if (!IN(6)) moe_layout(F);
        pg8::Gemm g{F.XG, F.Wgu_t, SLOTS, 1024, D}; pg8::GroupedOrder S; S.init((const LAS int*)(F.lds + PP_OFF), F.G, (int)blockIdx.x);
        pg8::EpiGateUp E{F.HID};
        pg8::gemm_phase<pg8::EpiGateUp, pg8::GroupedOrder, true, true>(F.lds + RING_OFF, g, S, E);
        if (BOTH(7)) GRID_BAR();
    }
    if (IN(8)) {
        if (!IN(6)) moe_layout(F);
        pg8::Gemm g{F.HID, F.Wd_t, SLOTS, 1024, DEXP}; pg8::GroupedOrder S; S.init((const LAS int*)(F.lds + PP_OFF), F.G, (int)blockIdx.x);
        pg8::EpiDown E{F.YP, F.PW};
        pg8::gemm_phase<pg8::EpiDown, pg8::GroupedOrder, true, true>(F.lds + RING_OFF, g, S, E);
        if (BOTH(8)) GRID_BAR();
    }
    if (IN(9)) p9_final(F);
#undef IN
#undef BOTH
#undef GRID_BAR
}

extern "C" void kernel_launch(void* const* d_in, const int* in_sizes, int n_in, void* d_out, int out_size, void* d_ws, size_t ws_size, hipStream_t stream) {
    static int grid = 0;
    if (grid == 0) {
        if (n_in != 20 || in_sizes[0] != M * D || out_size != M * D || ws_size < WS_END) { fprintf(stderr, "kernel_launch: built for 20 inputs, x and out of %d floats, >= %zu bytes of workspace; got n_in %d, in0 %d, out %d, ws %zu; nothing launched\n", M * D, (size_t)WS_END, n_in, n_in > 0 ? in_sizes[0] : -1, out_size, ws_size); grid = -1; return; }
        int dev = 0, cus = 0, per_cu = 0;
        if (hipGetDevice(&dev) != hipSuccess || hipDeviceGetAttribute(&cus, hipDeviceAttributeMultiprocessorCount, dev) != hipSuccess) { fprintf(stderr, "kernel_launch: hipGetDevice / hipDeviceGetAttribute failed; nothing launched\n"); grid = -1; return; }
        if (hipFuncSetAttribute((const void*)hrp_fwd, hipFuncAttributeMaxDynamicSharedMemorySize, LDS_BYTES) != hipSuccess) { fprintf(stderr, "kernel_launch: hipFuncSetAttribute failed (%d bytes of dynamic LDS); nothing launched\n", LDS_BYTES); grid = -1; return; }
        if (hipOccupancyMaxActiveBlocksPerMultiprocessor(&per_cu, (const void*)hrp_fwd, NWAVES * 64, LDS_BYTES) != hipSuccess || per_cu < 1)
            fprintf(stderr, "kernel_launch: note: the occupancy query reports %d workgroups per CU; the launch goes ahead with one per CU\n", per_cu);
        (void)hipGetLastError();
        grid = cus;
        if (grid != 256) fprintf(stderr, "kernel_launch: %d CUs; this kernel is built for 256 and will leave the output unwritten\n", grid);
    }
    if (grid < 0) return;
    if (hipMemsetAsync((char*)d_ws + WS_CTL, 0, CTL_ZERO_BYTES, stream) != hipSuccess) { fprintf(stderr, "kernel_launch: hipMemsetAsync of the control words failed; nothing launched\n"); return; }
    Args a{};
    for (int i = 0; i < 20; ++i) a.in[i] = (const float*)d_in[i];
    a.out = (float*)d_out; a.ws = (unsigned char*)d_ws;
    for (int li = 0; li < N_LAUNCHES; ++li) {
        a.ph_lo = (N_LAUNCHES == PER_PHASE) ? li : 0; a.ph_hi = (N_LAUNCHES == PER_PHASE) ? li + 1 : PER_PHASE;
        hipLaunchKernelGGL(hrp_fwd, dim3(grid), dim3(NWAVES * 64), LDS_BYTES, stream, a);
        const hipError_t le = hipPeekAtLastError();
        if (le != hipSuccess) { fprintf(stderr, "kernel_launch: launch %d failed: %s\n", li, hipGetErrorName(le)); break; }
    }
}
```

```cpp
#include <hip/hip_runtime.h>
#include <cstdio>
#include <cstdint>
#ifndef MK_N_LAUNCHES
#define MK_N_LAUNCHES 1
#endif
namespace pg8 {
#define PG8_LAS __attribute__((address_space(3)))
typedef unsigned short bf16_t;
typedef short bf16x8 __attribute__((ext_vector_type(8)));
typedef float f32x4 __attribute__((ext_vector_type(4)));
typedef unsigned u32x4 __attribute__((ext_vector_type(4)));
constexpr int BM = 256, BK = 64, HALF = 128, HTB = HALF * BK * 2  , STAGE_BYTES = 8 * HTB, NXCD = 8, WGM = 8;

__host__ __device__ __forceinline__ int lds_byte(int r, int c) { const int st = (r >> 4) * 2 + (c >> 5), rr = r & 15, cc = c & 31, ob = rr * 64 + cc * 2; return st * 1024 + (ob ^ (((ob >> 9) & 1) << 5)); }
__host__ __device__ __forceinline__ void stage_rc(int b, int& R, int& C) { const int st = b / 1024, sb = b % 1024, swz = sb ^ (((sb >> 9) & 1) << 5); R = (st >> 1) * 16 + swz / 64; C = (st & 1) * 32 + (swz % 64) / 2; }
__host__ __device__ __forceinline__ int perm32(int rho) { const int n = rho >> 4, i = rho & 15; return 8 * (i >> 2) + 4 * n + (i & 3); }

struct Unit { int pm, pn; };
struct Gemm { const bf16_t* A; const bf16_t* Bt; int M, N, K; const int* gidx; };

struct StaticOrder {
    int nM, nN, nwg, G, c;
    __host__ __device__ void init(int M, int N, int G_, int c_) { nM = M / BM; nN = N / BM; nwg = nM * nN; G = G_; c = c_; }
    __host__ __device__ bool next(int i, Unit& u) const {
        const long L = (long)i * G + c; if (L >= nwg) return false;
        int wgid = (int)L; { const int q = nwg / NXCD, r = nwg % NXCD, xcd = wgid % NXCD, off = wgid / NXCD; wgid = (xcd < r ? xcd * (q + 1) : r * (q + 1) + (xcd - r) * q) + off; }
        const int nig = WGM * nN, gid = wgid / nig, fm = gid * WGM, gsz = (nM - fm) < WGM ? (nM - fm) : WGM;
        u.pm = fm + ((wgid % nig) % gsz); u.pn = (wgid % nig) / gsz; return true;
    }
    __device__ __forceinline__ void a_ready(const Unit&) const {}
    __device__ __forceinline__ void done(const Unit&) const {}
};

__device__ __forceinline__ unsigned cvt_pk_bf16(float lo, float hi) { unsigned r; asm volatile("v_cvt_pk_bf16_f32 %0, %1, %2" : "=v"(r) : "v"(lo), "v"(hi)); return r; }
__device__ __forceinline__ float bf_lo(unsigned w) { return __uint_as_float(w << 16); }
__device__ __forceinline__ float bf_hi(unsigned w) { return __uint_as_float(w & 0xffff0000u); }

struct EpiProj {
    static constexpr bool PERM = true, AFTER_DRAIN = false;
    bf16_t *Q, *V; const float* rope;
    __device__ __forceinline__ void operator()(const f32x4 (&acc)[2][2][4][2], const Unit& u, int wr, int wc, int fr, int fq) const {
        const int row0 = u.pm * BM + wr * 64 + fr, lc0 = wc * 32 + 8 * fq;
        if (u.pn < 2) {
            bf16_t* base = Q + (size_t)u.pn * ((size_t)65536 * 256); const float sc = u.pn == 0 ? 1.0f : 0.125f;
            f32x4 tb[4][2][2]; u32x4 wv[4][2];
#pragma unroll
            for (int ai = 0; ai < 2; ++ai) {
#pragma unroll
                for (int m = 0; m < 4; ++m) { const int pos = 16 + ((row0 + ai * HALF + m * 16) & 4095);
#pragma unroll
                    for (int bj = 0; bj < 2; ++bj) { const f32x4* tp = (const f32x4*)(rope + ((size_t)pos * 32 + (((lc0 + bj * HALF) & 63) >> 1)) * 2); tb[m][bj][0] = tp[0]; tb[m][bj][1] = tp[1]; } }
                asm volatile("" ::: "memory");
                if (ai == 1) {
#pragma unroll
                    for (int m = 0; m < 4; ++m)
#pragma unroll
                        for (int bj = 0; bj < 2; ++bj) *(u32x4*)(base + (size_t)(row0 + m * 16) * 256 + lc0 + bj * HALF) = wv[m][bj];
                    asm volatile("" ::: "memory"); }
#pragma unroll
                for (int m = 0; m < 4; ++m)
#pragma unroll
                    for (int bj = 0; bj < 2; ++bj) { const f32x4 t0 = tb[m][bj][0], t1 = tb[m][bj][1]; const f32x4 v0 = acc[ai][bj][m][0], v1 = acc[ai][bj][m][1];
                        const float o0 = (v0[0] * t0[0] - v0[1] * t0[1]) * sc, o1 = (v0[0] * t0[1] + v0[1] * t0[0]) * sc;
                        const float o2 = (v0[2] * t0[2] - v0[3] * t0[3]) * sc, o3 = (v0[2] * t0[3] + v0[3] * t0[2]) * sc;
                        const float o4 = (v1[0] * t1[0] - v1[1] * t1[1]) * sc, o5 = (v1[0] * t1[1] + v1[1] * t1[0]) * sc;
                        const float o6 = (v1[2] * t1[2] - v1[3] * t1[3]) * sc, o7 = (v1[2] * t1[3] + v1[3] * t1[2]) * sc;
                        wv[m][bj].x = cvt_pk_bf16(o0, o1); wv[m][bj].y = cvt_pk_bf16(o2, o3); wv[m][bj].z = cvt_pk_bf16(o4, o5); wv[m][bj].w = cvt_pk_bf16(o6, o7); }
            }
#pragma unroll
            for (int m = 0; m < 4; ++m)
#pragma unroll
                for (int bj = 0; bj < 2; ++bj) *(u32x4*)(base + (size_t)(row0 + HALF + m * 16) * 256 + lc0 + bj * HALF) = wv[m][bj];
        } else {
            bf16_t* base = V + (size_t)((u.pn - 2) >> 1) * ((size_t)65536 * 512); const int colt = (u.pn & 1) * 256;
#pragma unroll
            for (int ai = 0; ai < 2; ++ai)
#pragma unroll
                for (int m = 0; m < 4; ++m) { bf16_t* rowp = base + (size_t)(row0 + ai * HALF + m * 16) * 512 + colt + lc0;
#pragma unroll
                    for (int bj = 0; bj < 2; ++bj) { const f32x4 v0 = acc[ai][bj][m][0], v1 = acc[ai][bj][m][1];
                        u32x4 w; w.x = cvt_pk_bf16(v0[0], v0[1]); w.y = cvt_pk_bf16(v0[2], v0[3]); w.z = cvt_pk_bf16(v1[0], v1[1]); w.w = cvt_pk_bf16(v1[2], v1[3]);
                        *(u32x4*)(rowp + bj * HALF) = w; } }
        }
    }
};
struct EpiRes {
    static constexpr bool PERM = true, AFTER_DRAIN = false;
    const bf16_t* H0; bf16_t* T; float alpha;
    __device__ __forceinline__ void operator()(const f32x4 (&acc)[2][2][4][2], const Unit& u, int wr, int wc, int fr, int fq) const {
        const int row0 = u.pm * BM + wr * 64 + fr, col0 = u.pn * BM + wc * 32 + 8 * fq;
        u32x4 hv[2][4][2];
#pragma unroll
        for (int ai = 0; ai < 2; ++ai)
#pragma unroll
            for (int m = 0; m < 4; ++m)
#pragma unroll
                for (int bj = 0; bj < 2; ++bj) hv[ai][m][bj] = *(const u32x4*)(H0 + (size_t)(row0 + ai * HALF + m * 16) * 1024 + col0 + bj * HALF);
        asm volatile("" ::: "memory");
#pragma unroll
        for (int ai = 0; ai < 2; ++ai)
#pragma unroll
            for (int m = 0; m < 4; ++m) { const size_t off = (size_t)(row0 + ai * HALF + m * 16) * 1024 + col0;
#pragma unroll
                for (int bj = 0; bj < 2; ++bj) { const u32x4 hb = hv[ai][m][bj]; const f32x4 a0 = acc[ai][bj][m][0], a1 = acc[ai][bj][m][1];
                    u32x4 w; w.x = cvt_pk_bf16(alpha * bf_lo(hb.x) + a0[0], alpha * bf_hi(hb.x) + a0[1]); w.y = cvt_pk_bf16(alpha * bf_lo(hb.y) + a0[2], alpha * bf_hi(hb.y) + a0[3]);
                    w.z = cvt_pk_bf16(alpha * bf_lo(hb.z) + a1[0], alpha * bf_hi(hb.z) + a1[1]); w.w = cvt_pk_bf16(alpha * bf_lo(hb.w) + a1[2], alpha * bf_hi(hb.w) + a1[3]);
                    *(u32x4*)(T + off + bj * HALF) = w; } }
    }
};
struct EpiGateUp {
    static constexpr bool PERM = true, AFTER_DRAIN = false;
    bf16_t* HID;
    __device__ __forceinline__ void operator()(const f32x4 (&acc)[2][2][4][2], const Unit& u, int wr, int wc, int fr, int fq) const {
        const int row0 = u.pm * BM + wr * 64 + fr, hc = (u.pn & 3) * 128 + wc * 32 + 8 * fq;
#pragma unroll
        for (int ai = 0; ai < 2; ++ai)
#pragma unroll
            for (int m = 0; m < 4; ++m) { float h[8];
#pragma unroll
                for (int n = 0; n < 2; ++n)
#pragma unroll
                    for (int j = 0; j < 4; ++j) { const float g = acc[ai][0][m][n][j], up = acc[ai][1][m][n][j]; h[4 * n + j] = g * up * __builtin_amdgcn_rcpf(1.0f + __expf(-g)); }
                u32x4 w; w.x = cvt_pk_bf16(h[0], h[1]); w.y = cvt_pk_bf16(h[2], h[3]); w.z = cvt_pk_bf16(h[4], h[5]); w.w = cvt_pk_bf16(h[6], h[7]);
                *(u32x4*)(HID + (size_t)(row0 + ai * HALF + m * 16) * 512 + hc) = w; }
    }
};
__device__ __forceinline__ unsigned pk4_fp8(const f32x4 v) { int w = __builtin_amdgcn_cvt_pk_fp8_f32(v[0], v[1], 0, false); w = __builtin_amdgcn_cvt_pk_fp8_f32(v[2], v[3], w, true); return (unsigned)w; }
struct EpiDown {
    static constexpr bool PERM = true, AFTER_DRAIN = false;
    unsigned char* YP; const float* PW;
    __device__ __forceinline__ void operator()(const f32x4 (&acc)[2][2][4][2], const Unit& u, int wr, int wc, int fr, int fq) const {
        const int row0 = u.pm * BM + wr * 64 + fr, col0 = (u.pn & 3) * BM + wc * 64 + 16 * fq;
        float pwv[8];
#pragma unroll
        for (int i = 0; i < 8; ++i) pwv[i] = PW[row0 + (i >> 2) * HALF + (i & 3) * 16];
        asm volatile("" ::: "memory");
#pragma unroll
        for (int ai = 0; ai < 2; ++ai)
#pragma unroll
            for (int m = 0; m < 4; ++m) { const int row = row0 + ai * HALF + m * 16; const float sc = pwv[ai * 4 + m] * 64.0f;
                u32x4 w; w.x = pk4_fp8(acc[ai][0][m][0] * sc); w.y = pk4_fp8(acc[ai][0][m][1] * sc); w.z = pk4_fp8(acc[ai][1][m][0] * sc); w.w = pk4_fp8(acc[ai][1][m][1] * sc);
                *(u32x4*)(YP + (size_t)row * 1024 + col0) = w; }
    }
};
struct OwnPanelOrder {
    int c, ntn;
    __device__ __forceinline__ bool next(int i, Unit& u) const { if (i >= ntn) return false; u.pm = c; u.pn = i; return true; }
    __device__ __forceinline__ void a_ready(const Unit&) const {}
    __device__ __forceinline__ void done(const Unit&) const {}
};
struct GroupedOrder {
    const PG8_LAS int* pp; int nwg, G, c;
    __device__ __forceinline__ void init(const PG8_LAS int* pp_, int G_, int c_) { pp = pp_; nwg = pp_[32] * 4; G = G_; c = c_; }
    __device__ __forceinline__ bool next(int i, Unit& u) const {
        const long L = (long)i * G + c; if (L >= nwg) return false;
        int wgid = (int)L; { const int q = nwg / NXCD, r = nwg % NXCD, xcd = wgid % NXCD, off = wgid / NXCD; wgid = (xcd < r ? xcd * (q + 1) : r * (q + 1) + (xcd - r) * q) + off; }
        const int panel = wgid >> 2; int e = 0;
#pragma unroll
        for (int k = 1; k < 32; ++k) e += (pp[k] <= panel) ? 1 : 0;
        u.pm = panel; u.pn = e * 4 + (wgid & 3); return true;
    }
    __device__ __forceinline__ void a_ready(const Unit&) const {}
    __device__ __forceinline__ void done(const Unit&) const {}
};
__device__ __forceinline__ void gather_off(const int* gidx, int pm, int K, int tid, unsigned (&v0)[2], unsigned (&v1)[2]) {
#pragma unroll
    for (int i = 0; i < 2; ++i) { int R, C; stage_rc(tid * 16 + i * 8192, R, C); v0[i] = (unsigned)(gidx[pm * 256 + R] * K + C) * 2u; v1[i] = (unsigned)(gidx[pm * 256 + 128 + R] * K + C) * 2u; }
}
template <class Epi, class Sched, bool ALIGN_EPI = false, bool SP2 = false, bool GATHER = false>
__device__ __forceinline__ void gemm_phase(PG8_LAS unsigned char* lds, const Gemm g, const Sched& S, const Epi& E) {
    const int tid = threadIdx.x, wid = __builtin_amdgcn_readfirstlane(tid >> 6), lane = tid & 63, wr = wid >> 2, wc = wid & 3, fr = lane & 15, fq = lane >> 4;
    const int K = g.K, nt = K / BK;
    unsigned voffA[2], voffB[2];
#pragma unroll
    for (int i = 0; i < 2; ++i) { int R, C; stage_rc(tid * 16 + i * 8192, R, C); const int Rb = Epi::PERM ? ((R & ~31) + perm32(R & 31)) : R;
        voffA[i] = (unsigned)(R * K + C) * 2u; voffB[i] = (unsigned)(Rb * K + C) * 2u; }
    static_assert(SP2 || !GATHER, "GATHER is written for the SP2 loop");
    unsigned cv0[2] = {0u, 0u}, cv1[2] = {0u, 0u}, nv0[2] = {0u, 0u}, nv1[2] = {0u, 0u};
    const size_t kstep = (size_t)(BK * 2);
    const size_t hstep = (size_t)HALF * K * 2;
    const size_t tstep = 2 * hstep;
    const unsigned ldsw = (unsigned)wid * 1024u;
    const int aoff = lds_byte(wr * 64 + fr, fq * 8), boff = lds_byte(wc * 32 + fr, fq * 8);
#define PG8_SA(b, h) (((b) * 2 + (h)) * HTB)
#define PG8_SB(b, h) ((4 + (b) * 2 + (h)) * HTB)
#define PG8_STAGE(bufoff, gbase, voff) do { _Pragma("unroll") for (int _i = 0; _i < 2; ++_i) \
        __builtin_amdgcn_global_load_lds((const unsigned*)((const char*)(gbase) + (voff)[_i]), (PG8_LAS unsigned*)(lds + (bufoff) + ldsw + _i * 8192), 16, 0, 0); } while (0)
#define PG8_STAGE_A0C(bufoff, gb) do { if constexpr (GATHER) PG8_STAGE(bufoff, gb, cv0); else PG8_STAGE(bufoff, gb, voffA); } while (0)
#define PG8_STAGE_A1C(bufoff, gb) do { if constexpr (GATHER) PG8_STAGE(bufoff, gb, cv1); else PG8_STAGE(bufoff, (gb) + hstep, voffA); } while (0)
#define PG8_STAGE_A0X(bufoff, gb) do { if constexpr (GATHER) PG8_STAGE(bufoff, gb, sv0); else PG8_STAGE(bufoff, gb, voffA); } while (0)
#define PG8_STAGE_A1X(bufoff, gb) do { if constexpr (GATHER) PG8_STAGE(bufoff, gb, sv1); else PG8_STAGE(bufoff, (gb) + hstep, voffA); } while (0)
#define PG8_LDA(dst, b, h) do { _Pragma("unroll") for (int m = 0; m < 4; ++m) _Pragma("unroll") for (int k = 0; k < 2; ++k) dst[m][k] = *(const PG8_LAS bf16x8*)(lds + PG8_SA(b, h) + aoff + m * 2048 + k * 1024); } while (0)
#define PG8_LDB(dst, b, h) do { _Pragma("unroll") for (int n = 0; n < 2; ++n) _Pragma("unroll") for (int k = 0; k < 2; ++k) dst[n][k] = *(const PG8_LAS bf16x8*)(lds + PG8_SB(b, h) + boff + n * 2048 + k * 1024); } while (0)
#define PG8_MMA(ai, bj, At, Bt) do { __builtin_amdgcn_s_setprio(1); _Pragma("unroll") for (int m = 0; m < 4; ++m) _Pragma("unroll") for (int n = 0; n < 2; ++n) _Pragma("unroll") for (int k = 0; k < 2; ++k) \
        acc[ai][bj][m][n] = __builtin_amdgcn_mfma_f32_16x16x32_bf16(Bt[n][k], At[m][k], acc[ai][bj][m][n], 0, 0, 0); __builtin_amdgcn_s_setprio(0); } while (0)
#define PG8_WAIT_V(n) asm volatile("s_waitcnt vmcnt(" #n ")" ::: "memory")
#define PG8_WAIT_L(n) asm volatile("s_waitcnt lgkmcnt(" #n ")" ::: "memory")
#define PG8_BAR __builtin_amdgcn_s_barrier()
#define PG8_SCHED __builtin_amdgcn_sched_barrier(0)
    Unit cur, nxt; int ui = 0;
    if (!S.next(0, cur)) return;
    f32x4 acc[2][2][4][2];
#pragma unroll
    for (int a = 0; a < 2; ++a)
#pragma unroll
        for (int b = 0; b < 2; ++b)
#pragma unroll
            for (int m = 0; m < 4; ++m)
#pragma unroll
                for (int n = 0; n < 2; ++n) acc[a][b][m][n] = (f32x4){0.f, 0.f, 0.f, 0.f};
    bf16x8 At[4][2], B0[2][2], B1[2][2];
    const char* cA = (const char*)g.A + (GATHER ? (size_t)0 : (size_t)cur.pm * tstep); const char* cB = (const char*)g.Bt + (size_t)cur.pn * tstep;
    if constexpr (GATHER) gather_off(g.gidx, cur.pm, K, tid, cv0, cv1);
    S.a_ready(cur);
    if constexpr (SP2) {
        PG8_STAGE(PG8_SB(0, 0), cB, voffB); PG8_STAGE(PG8_SB(0, 1), cB + hstep, voffB); PG8_STAGE_A0C(PG8_SA(0, 0), cA); PG8_STAGE_A1C(PG8_SA(0, 1), cA);
        if (wr == 1) PG8_BAR;
        PG8_WAIT_V(2); PG8_BAR;
        PG8_STAGE(PG8_SB(1, 0), cB + kstep, voffB); PG8_STAGE_A0C(PG8_SA(1, 0), cA + kstep); PG8_STAGE(PG8_SB(1, 1), cB + hstep + kstep, voffB);
        PG8_WAIT_V(6); PG8_BAR;
    } else {
        PG8_STAGE(PG8_SB(0, 0), cB, voffB); PG8_STAGE(PG8_SA(0, 0), cA, voffA); PG8_STAGE(PG8_SB(0, 1), cB + hstep, voffB); PG8_STAGE(PG8_SA(0, 1), cA + hstep, voffA);
        if (wr == 1) PG8_BAR;
        PG8_WAIT_V(4); PG8_BAR;
        PG8_STAGE(PG8_SB(1, 0), cB + kstep, voffB); PG8_STAGE(PG8_SA(1, 0), cA + kstep, voffA); PG8_STAGE(PG8_SB(1, 1), cB + hstep + kstep, voffB);
        PG8_WAIT_V(6); PG8_BAR;
    }
    for (;;) {
        const bool has_next = S.next(ui + 1, nxt);
        if constexpr (GATHER) { if (has_next) gather_off(g.gidx, nxt.pm, K, tid, nv0, nv1); else { nv0[0] = cv0[0]; nv0[1] = cv0[1]; nv1[0] = cv1[0]; nv1[1] = cv1[1]; } }
        const char* nA = GATHER ? cA : (has_next ? (const char*)g.A + (size_t)nxt.pm * tstep : cA); const char* nB = has_next ? (const char*)g.Bt + (size_t)nxt.pn * tstep : cB;
        for (int t = 0; t < nt; t += 2) {
            const bool last = (t == nt - 2);
            const char* a1 = cA + (size_t)(t + 1) * kstep;
            const char* a2 = last ? nA : cA + (size_t)(t + 2) * kstep; const char* b2 = last ? nB : cB + (size_t)(t + 2) * kstep;
            const char* a3 = a2 + kstep; const char* b3 = b2 + kstep;
            if (last && has_next) S.a_ready(nxt);
            unsigned sv0[2], sv1[2]; sv0[0] = last ? nv0[0] : cv0[0]; sv0[1] = last ? nv0[1] : cv0[1]; sv1[0] = last ? nv1[0] : cv1[0]; sv1[1] = last ? nv1[1] : cv1[1];
            if constexpr (SP2) {
            PG8_LDB(B0, 0, 0); PG8_LDB(B1, 0, 1); PG8_SCHED; PG8_LDA(At, 0, 0); PG8_STAGE_A1C(PG8_SA(1, 1), a1);
            PG8_WAIT_V(8); PG8_WAIT_L(0); PG8_BAR; PG8_MMA(0, 0, At, B0); PG8_MMA(0, 1, At, B1); PG8_BAR; PG8_SCHED;
            PG8_LDA(At, 0, 1); PG8_STAGE(PG8_SB(0, 0), b2, voffB); PG8_STAGE(PG8_SB(0, 1), b2 + hstep, voffB); PG8_STAGE_A0X(PG8_SA(0, 0), a2);
            PG8_WAIT_V(8); PG8_WAIT_L(0); PG8_BAR; PG8_MMA(1, 0, At, B0); PG8_MMA(1, 1, At, B1); PG8_BAR; PG8_SCHED;
            PG8_LDB(B0, 1, 0); PG8_LDB(B1, 1, 1); PG8_SCHED; PG8_LDA(At, 1, 0); PG8_STAGE_A1X(PG8_SA(0, 1), a2);
            PG8_WAIT_V(8); PG8_WAIT_L(0); PG8_BAR; PG8_MMA(0, 0, At, B0); PG8_MMA(0, 1, At, B1); PG8_BAR; PG8_SCHED;
            PG8_LDA(At, 1, 1); PG8_STAGE(PG8_SB(1, 0), b3, voffB); PG8_STAGE(PG8_SB(1, 1), b3 + hstep, voffB); PG8_STAGE_A0X(PG8_SA(1, 0), a3);
            PG8_WAIT_V(8); PG8_WAIT_L(0); PG8_BAR; PG8_MMA(1, 0, At, B0); PG8_MMA(1, 1, At, B1); PG8_BAR; PG8_SCHED;
            } else {
            PG8_LDB(B0, 0, 0); PG8_SCHED; PG8_LDA(At, 0, 0); PG8_STAGE(PG8_SA(1, 1), a1 + hstep, voffA);
            PG8_WAIT_L(8); PG8_BAR; PG8_WAIT_L(0); PG8_MMA(0, 0, At, B0); PG8_BAR; PG8_SCHED;
            PG8_LDB(B1, 0, 1); PG8_STAGE(PG8_SB(0, 0), b2, voffB);
            PG8_BAR; PG8_WAIT_L(0); PG8_MMA(0, 1, At, B1); PG8_BAR;
            PG8_LDA(At, 0, 1); PG8_STAGE(PG8_SA(0, 0), a2, voffA);
            PG8_BAR; PG8_WAIT_L(0); PG8_MMA(1, 0, At, B0); PG8_BAR; PG8_SCHED;
            PG8_STAGE(PG8_SB(0, 1), b2 + hstep, voffB);
            PG8_WAIT_V(6); PG8_BAR; PG8_MMA(1, 1, At, B1); PG8_BAR;
            PG8_LDB(B0, 1, 0); PG8_SCHED; PG8_LDA(At, 1, 0); PG8_STAGE(PG8_SA(0, 1), a2 + hstep, voffA);
            PG8_WAIT_L(8); PG8_BAR; PG8_WAIT_L(0); PG8_MMA(0, 0, At, B0); PG8_BAR; PG8_SCHED;
            PG8_LDB(B1, 1, 1); PG8_STAGE(PG8_SB(1, 0), b3, voffB);
            PG8_BAR; PG8_WAIT_L(0); PG8_MMA(0, 1, At, B1); PG8_BAR;
            PG8_LDA(At, 1, 1); PG8_STAGE(PG8_SA(1, 0), a3, voffA);
            PG8_BAR; PG8_WAIT_L(0); PG8_MMA(1, 0, At, B0); PG8_BAR; PG8_SCHED;
            PG8_STAGE(PG8_SB(1, 1), b3 + hstep, voffB);
            PG8_WAIT_V(6); PG8_BAR; PG8_MMA(1, 1, At, B1); PG8_BAR;
            }
        }
        if constexpr (ALIGN_EPI) { if (wr == 0) PG8_BAR; }
        if constexpr (!Epi::AFTER_DRAIN) { E(acc, cur, wr, wc, fr, fq); S.done(cur); }
        if (!has_next) break;
#pragma unroll
        for (int a = 0; a < 2; ++a)
#pragma unroll
            for (int b = 0; b < 2; ++b)
#pragma unroll
                for (int m = 0; m < 4; ++m)
#pragma unroll
                    for (int n = 0; n < 2; ++n) acc[a][b][m][n] = (f32x4){0.f, 0.f, 0.f, 0.f};
        cur = nxt; cA = nA; cB = nB; ++ui;
        if constexpr (GATHER) { cv0[0] = nv0[0]; cv0[1] = nv0[1]; cv1[0] = nv1[0]; cv1[1] = nv1[1]; }
        if constexpr (ALIGN_EPI) { if (wr == 1) PG8_BAR; }
    }
    PG8_WAIT_V(0);
    if constexpr (!ALIGN_EPI) { if (wr == 0) PG8_BAR; }
    PG8_BAR;
    if constexpr (Epi::AFTER_DRAIN) { E.fused(acc, cur, wr, wc, fr, fq, lds, wid, lane); S.done(cur); }
#undef PG8_SA
#undef PG8_SB
#undef PG8_STAGE
#undef PG8_LDA
#undef PG8_STAGE_A0C
#undef PG8_STAGE_A1C
#undef PG8_STAGE_A0X
#undef PG8_STAGE_A1X
#undef PG8_LDB
#undef PG8_MMA
#undef PG8_WAIT_V
#undef PG8_WAIT_L
#undef PG8_BAR
#undef PG8_SCHED
}
}

constexpr int NWAVES = 8;
constexpr int N_LAUNCHES = MK_N_LAUNCHES;
constexpr int PER_PHASE = 10;

constexpr int BATCH = 16, SEQ = 4096, D = 1024, NMETA = 16;
constexpr int M = BATCH * SEQ;
constexpr int NPROJ = 2048, NEXP = 32, DEXP = 512;
constexpr int NPANEL_MAX = 544, SLOTS = NPANEL_MAX * 256;
constexpr float LN_EPS = 1e-5f, GN_EPS = 1e-6f;
constexpr float ALPHA = 1.189207115002721f;

constexpr size_t MiB = 1u << 20;
constexpr size_t WS_CTL = 0, CTL_ZERO_BYTES = 1 * MiB;
constexpr size_t WS_WIN = 2 * MiB;
constexpr size_t WS_WOUT = 6 * MiB;
constexpr size_t WS_WPOOL = 8 * MiB;
constexpr size_t WS_RW = 8 * MiB + 256 * 1024;
constexpr size_t WS_METAK = 8 * MiB + 512 * 1024;
constexpr size_t WS_METAV = WS_METAK + 16 * 256 * 4;
constexpr size_t WS_METAU = WS_METAV + 16 * 512 * 4;
constexpr size_t WS_ROPE = 9 * MiB;
constexpr size_t WS_TOKE = 12 * MiB;
constexpr size_t WS_TOKL = WS_TOKE + (size_t)M * 4;
constexpr size_t WS_TOKW = WS_TOKL + (size_t)M * 4;
constexpr size_t WS_TOKS = WS_TOKW + (size_t)M * 8;
constexpr size_t WS_CNT = 14 * MiB;
constexpr size_t WS_PW = 15 * MiB;
constexpr size_t WS_STOK = 16 * MiB;
constexpr size_t WS_WGU = 32 * MiB;
constexpr size_t WS_WD = 96 * MiB;
constexpr size_t WS_ST = 128 * MiB;
constexpr size_t WS_H0 = 160 * MiB;
constexpr size_t WS_Q = 288 * MiB, WS_K = 320 * MiB;
constexpr size_t WS_V = 352 * MiB, WS_GATE = 416 * MiB, WS_U = 480 * MiB;
constexpr size_t WS_MIXIN = 544 * MiB;
constexpr size_t WS_T1 = 672 * MiB;
constexpr size_t WS_H1B = 288 * MiB;
constexpr size_t WS_HID = 688 * MiB;
constexpr size_t WS_YP = 416 * MiB;
constexpr size_t WS_END = 928 * MiB;
static_assert(WS_ROPE + (size_t)4112 * 32 * 8 <= WS_TOKE && WS_TOKS + (size_t)M * 8 <= WS_CNT && WS_PW + (size_t)SLOTS * 4 <= WS_WGU, "small tables");
static_assert(WS_K == WS_Q + (size_t)M * 256 * 2 && WS_GATE == WS_V + (size_t)M * 512 * 2 && WS_U == WS_GATE + (size_t)M * 512 * 2, "EpiProj addresses K, gate, u relative to Q, V");
static_assert(WS_STOK + (size_t)SLOTS * 4 <= WS_WGU && WS_YP + (size_t)SLOTS * 1024 <= WS_HID && WS_HID + (size_t)SLOTS * 512 * 2 <= WS_END && WS_T1 + (size_t)M * 1024 * 2 <= WS_END, "d_ws map");
constexpr int CW_BAR = 4096;

constexpr int RING_OFF = 0, RING_BYTES = 131072;
constexpr int LDSCTL_OFF = RING_BYTES;
constexpr int PP_OFF = LDSCTL_OFF, TOT_OFF = LDSCTL_OFF + 192, BEF_OFF = LDSCTL_OFF + 320, BASE_OFF = LDSCTL_OFF + 448, LCNT_OFF = LDSCTL_OFF + 576, MISC_OFF = LDSCTL_OFF + 768;
constexpr int LDS_BYTES = 147456;
static_assert(MISC_OFF + 128 <= LDS_BYTES, "LDS map");
#define GAS __attribute__((address_space(1)))
#define LAS __attribute__((address_space(3)))
typedef unsigned short bf16;
typedef unsigned v4u __attribute__((ext_vector_type(4)));
typedef float f32x4 __attribute__((ext_vector_type(4)));
typedef short bf16x8 __attribute__((ext_vector_type(8)));
typedef GAS unsigned gu32;
typedef GAS unsigned long long gu64;
#define RLX_AGENT __ATOMIC_RELAXED, __HIP_MEMORY_SCOPE_AGENT
#define LDS_WAIT() asm volatile("s_waitcnt lgkmcnt(0)" ::: "memory")
#define VM_WAIT() asm volatile("s_waitcnt vmcnt(0)" ::: "memory")
__device__ __forceinline__ unsigned long long rt() { return __builtin_amdgcn_s_memrealtime(); }
__device__ __forceinline__ unsigned f2bf(float f) { unsigned u = __builtin_bit_cast(unsigned, f); return (u + 0x7fffu + ((u >> 16) & 1u)) >> 16; }
__device__ __forceinline__ unsigned pk2(float lo, float hi) { return f2bf(lo) | (f2bf(hi) << 16); }

#define XB_TMO      128
#define XB_XCNT(j)  (256  + 64 * (j))
#define XB_XSUB(j)  (1280 + 64 * (j))
#define XB_XGEN(j)  (2304 + 64 * (j))
#define XB_TOP      3328
#define XB_TOPGEN   3392
#define XCD_BAR_WORDS 3456
#define XB_SPIN_CAP (1u << 18)

__device__ __forceinline__ unsigned xb_ld(unsigned* p)              { return __hip_atomic_load(p, __ATOMIC_RELAXED, __HIP_MEMORY_SCOPE_AGENT); }
__device__ __forceinline__ unsigned xb_add(unsigned* p, unsigned v) { return __hip_atomic_fetch_add(p, v, __ATOMIC_RELAXED, __HIP_MEMORY_SCOPE_AGENT); }
__device__ __forceinline__ unsigned xb_xcc_id() { return (unsigned)__builtin_amdgcn_s_getreg((3 << 11) | 20) & 0xFu; }
#define XB_SPIN(cond, bar) do { unsigned _sp = 0; while (cond) { __builtin_amdgcn_s_sleep(1); \
    if ((++_sp & 255u) == 0u) { if (xb_ld(&(bar)[XB_TMO])) break; if (_sp > XB_SPIN_CAP) { atomicAdd(&(bar)[XB_TMO], 1u); break; } } } } while (0)

struct XcdBarrier {
    unsigned* bar; unsigned x;
    volatile LAS unsigned* st;
};

__device__ __forceinline__ XcdBarrier xcd_barrier_post(unsigned* bar, volatile LAS unsigned* st) {
    XcdBarrier b; b.bar = bar; b.x = xb_xcc_id(); b.st = st;
    if (threadIdx.x == 0) (void)xb_add(&bar[XB_XCNT(b.x)], 1u);
    return b;
}
__device__ __forceinline__ void xcd_barrier_complete(unsigned* bar, unsigned x, unsigned& nloc, unsigned& nx) {
    const unsigned G = gridDim.x * gridDim.y * gridDim.z;
    unsigned sum, cnt, mine, sp = 0u;
    for (;;) {
        sum = 0u; cnt = 0u; mine = 0u;
#pragma unroll
        for (unsigned j = 0; j < 16; ++j) { const unsigned c = xb_ld(&bar[XB_XCNT(j)]); sum += c; cnt += (c > 0u) ? 1u : 0u; mine = (j == x) ? c : mine; }
        if (sum == G) break;
        __builtin_amdgcn_s_sleep(1);
        if ((++sp & 255u) == 0u) { if (xb_ld(&bar[XB_TMO])) break; if (sp > XB_SPIN_CAP) { atomicAdd(&bar[XB_TMO], 1u); break; } }
    }
    nloc = mine > 0u ? mine : 1u; nx = cnt > 0u ? cnt : 1u;
}

__device__ __forceinline__ void xcd_barrier(const XcdBarrier& b) {
    asm volatile("s_waitcnt vmcnt(0)" ::: "memory");
    __syncthreads();
    if (threadIdx.x == 0) {
        unsigned* bar = b.bar;
        __builtin_amdgcn_s_waitcnt(0);
        unsigned nloc = b.st[0], nx = b.st[1];
        if (nloc == 0u) { xcd_barrier_complete(bar, b.x, nloc, nx); b.st[0] = nloc; b.st[1] = nx; }
        const unsigned old = xb_add(&bar[XB_XSUB(b.x)], 1u);
        const unsigned gen = old / nloc;
        if (old + 1u == (gen + 1u) * nloc) {
            __builtin_amdgcn_fence(__ATOMIC_RELEASE, "agent");
            asm volatile("s_waitcnt vmcnt(0)" ::: "memory");
            const unsigned og = xb_add(&bar[XB_TOP], 1u);
            const unsigned tg = og / nx;
            if (og + 1u == (tg + 1u) * nx) xb_add(&bar[XB_TOPGEN], 1u);
            else XB_SPIN(xb_ld(&bar[XB_TOPGEN]) == tg, bar);
            __builtin_amdgcn_fence(__ATOMIC_ACQUIRE, "agent");
            xb_add(&bar[XB_XGEN(b.x)], 1u);
            asm volatile("s_waitcnt vmcnt(0)" ::: "memory");
        } else {
            XB_SPIN(xb_ld(&bar[XB_XGEN(b.x)]) == gen, bar);
            __builtin_amdgcn_fence(__ATOMIC_ACQUIRE, "agent");
            asm volatile("s_waitcnt vmcnt(0)" ::: "memory");
        }
    }
    __syncthreads();
}

#define DI __device__ __forceinline__
typedef short v4i16_t __attribute__((ext_vector_type(4)));
typedef unsigned u32x2 __attribute__((ext_vector_type(2)));
typedef float f32x2 __attribute__((ext_vector_type(2)));
struct Frame {
    LAS unsigned char* lds;
    volatile LAS unsigned* MISC;
    gu32* ctl;
    int tid, lane, wave;
    int vcu, G;
    const float *x, *meta, *lne_g, *lne_b, *w_in, *pool_w, *pool_b, *pool_scale, *w_out, *ln1_g, *ln1_b, *rg_w, *rg_b, *re_w, *re_b, *w_gate, *w_up, *w_down, *ln2_g, *ln2_b;
    float* out;
    bf16 *Win_t, *Wout_t, *Wpool_t, *Wgu_t, *Wd_t;
    float *RW, *metak, *metav, *metau, *rope, *PW; bf16* T1;
    unsigned *toke, *tokl; f32x2* tokw; int* toks; int* cnt; int* stok;
    bf16 *ST, *H0, *Qb, *Kb, *Vb, *Gb, *Ub, *MIXIN, *H1B, *HID; unsigned char* YP;
};
DI float wave_sum(float v) {
#pragma unroll
    for (int o = 1; o < 64; o <<= 1) v += __shfl_xor(v, o);
    return v;
}
DI float bf2f(bf16 v) { return __uint_as_float(((unsigned)v) << 16); }
DI float bflo(unsigned w) { return __uint_as_float(w << 16); }
DI float bfhi(unsigned w) { return __uint_as_float(w & 0xffff0000u); }
DI unsigned cvtpk(float lo, float hi) { return pg8::cvt_pk_bf16(lo, hi); }

template <int MODE> DI int rowmap(int n) {
    if (MODE == 1) { if (n < 512) { const int i = n & 63; return (n & ~63) + (i < 32 ? 2 * i : 2 * (i - 32) + 1); } return n; }
    if (MODE == 2) return 256 * (n >> 7) + (n & 127);
    if (MODE == 3) return 256 * (n >> 7) + 128 + (n & 127);
    if (MODE == 4) { const int o = n & 255; return (n & ~255) + 128 * ((o >> 3) & 1) + 32 * (o >> 6) + 8 * ((o >> 4) & 3) + (o & 7); }
    return n;
}
template <int MODE> DI void p0_transpose_item(const float* W, int K, int N, bf16* WT, LAS float* scr, int item, int lane) {
    const int nblk = N / 32, kb = item / nblk, nb = item % nblk, k0 = 64 * kb, n0 = 32 * nb;
    f32x4 tv[8];
#pragma unroll
    for (int i = 0; i < 8; ++i) tv[i] = *(const GAS f32x4*)(W + (size_t)(k0 + i * 8 + (lane >> 3)) * N + n0 + 4 * (lane & 7));
#pragma unroll
    for (int i = 0; i < 8; ++i) { LAS float* d = scr + (i * 8 + (lane >> 3)) * 33 + 4 * (lane & 7); d[0] = tv[i].x; d[1] = tv[i].y; d[2] = tv[i].z; d[3] = tv[i].w; }
    LDS_WAIT(); asm volatile("" ::: "memory");
    const int c = lane & 7;
#pragma unroll
    for (int j = 0; j < 4; ++j) { const int n = (lane >> 3) + 8 * j; const LAS float* s = scr + (8 * c) * 33 + n;
        v4u o; o.x = pk2(s[0 * 33], s[1 * 33]); o.y = pk2(s[2 * 33], s[3 * 33]); o.z = pk2(s[4 * 33], s[5 * 33]); o.w = pk2(s[6 * 33], s[7 * 33]);
        *(GAS v4u*)(WT + (size_t)rowmap<MODE>(n0 + n) * K + k0 + 8 * c) = o; }
    LDS_WAIT(); asm volatile("" ::: "memory");
}
DI void ld_row(const float* xrow, f32x4 (&v)[4], int lane) {
    const GAS f32x4* xr = (const GAS f32x4*)xrow + lane;
#pragma unroll
    for (int j = 0; j < 4; ++j) v[j] = xr[64 * j];
}
DI void ln_regs(const f32x4 (&gv)[4], const f32x4 (&bv)[4], f32x4 (&v)[4], float eps) {
    float s = 0.f;
#pragma unroll
    for (int j = 0; j < 4; ++j) s += (v[j].x + v[j].y) + (v[j].z + v[j].w);
    const float mean = wave_sum(s) * (1.f / D); float s2 = 0.f;
#pragma unroll
    for (int j = 0; j < 4; ++j) { v[j] = v[j] - mean; s2 += (v[j].x * v[j].x + v[j].y * v[j].y) + (v[j].z * v[j].z + v[j].w * v[j].w); }
    const float rstd = 1.f / sqrtf(wave_sum(s2) * (1.f / D) + eps);
#pragma unroll
    for (int j = 0; j < 4; ++j) v[j] = v[j] * rstd * gv[j] + bv[j];
}
DI void ln_row(const float* xrow, const f32x4 (&gv)[4], const f32x4 (&bv)[4], f32x4 (&v)[4], int lane, float eps) { ld_row(xrow, v, lane); ln_regs(gv, bv, v, eps); }
DI void store_row_bf16(bf16* orow, const f32x4 (&v)[4], int lane) {
    GAS unsigned long long* o8 = (GAS unsigned long long*)orow + lane;
#pragma unroll
    for (int j = 0; j < 4; ++j) o8[64 * j] = (unsigned long long)pk2(v[j].x, v[j].y) | ((unsigned long long)pk2(v[j].z, v[j].w) << 32);
}
DI void p0_prologue(Frame& F) {
    LAS float* scr = (LAS float*)(F.lds + RING_OFF + F.wave * 16384);
    const int gw = F.vcu * NWAVES + F.wave, NGW = F.G * NWAVES;
    constexpr int I_IN = 16 * 64, I_OUT = 16 * 32, I_POOL = 4 * 8, I_G = 32 * 256, I_U = 32 * 256, I_D = 32 * 256;
    constexpr int NITEMS = I_IN + I_OUT + I_POOL + I_G + I_U + I_D;
    for (int it = gw; it < NITEMS; it += NGW) {
        int r = it;
        if (r < I_IN) { p0_transpose_item<1>(F.w_in, 1024, 2048, F.Win_t, scr, r, F.lane); continue; } r -= I_IN;
        if (r < I_OUT) { p0_transpose_item<0>(F.w_out, 1024, 1024, F.Wout_t, scr, r, F.lane); continue; } r -= I_OUT;
        if (r < I_POOL) { const int g = r >> 3; p0_transpose_item<0>(F.pool_w + g * 16384, 128, 128, F.Wpool_t + g * 16384, scr, r & 7, F.lane); continue; } r -= I_POOL;
        if (r < I_G) { const int e = r >> 8; p0_transpose_item<2>(F.w_gate + (size_t)e * 524288, 1024, 512, F.Wgu_t + (size_t)e * 1048576, scr, r & 255, F.lane); continue; } r -= I_G;
        if (r < I_U) { const int e = r >> 8; p0_transpose_item<3>(F.w_up + (size_t)e * 524288, 1024, 512, F.Wgu_t + (size_t)e * 1048576, scr, r & 255, F.lane); continue; } r -= I_U;
        { const int e = r >> 8; p0_transpose_item<4>(F.w_down + (size_t)e * 524288, 512, 1024, F.Wd_t + (size_t)e * 524288, scr, r & 255, F.lane); }
    }
    { f32x4 gv[4], bv[4];
#pragma unroll
      for (int j = 0; j < 4; ++j) { gv[j] = *(const f32x4*)(F.lne_g + 4 * F.lane + 256 * j); bv[j] = *(const f32x4*)(F.lne_b + 4 * F.lane + 256 * j); }
      f32x4 nx[4], ny[4]; ld_row(F.x + (size_t)gw * D, nx, F.lane); ld_row(F.x + (size_t)(gw + NGW) * D, ny, F.lane);
      for (int m = gw; m < M; m += NGW) { f32x4 v[4];
#pragma unroll
          for (int j = 0; j < 4; ++j) { v[j] = nx[j]; nx[j] = ny[j]; }
          if (m + 2 * NGW < M) ld_row(F.x + (size_t)(m + 2 * NGW) * D, ny, F.lane);
          ln_regs(gv, bv, v, LN_EPS); store_row_bf16(F.H0 + (size_t)m * D, v, F.lane); }
    }
    { const int gt = gw * 64 + F.lane, NT = NGW * 64;
      for (int idx = gt; idx < 4112 * 32; idx += NT) { const int pos = idx >> 5, i = idx & 31;
          const float inv = exp2f(-(float)i * 0.415241011860920f);
          const float ang = (float)pos * inv;
          const double a = (double)ang; const double k = __builtin_rint(a * 0.15915494309189535); const float rr = (float)__builtin_fma(-k, 6.283185307179586, a);
          F.rope[(size_t)idx * 2] = cosf(rr); F.rope[(size_t)idx * 2 + 1] = sinf(rr); }
      for (int idx = gt; idx < 36 * 1024; idx += NT) { const int c = idx >> 10, k = idx & 1023; F.RW[idx] = c < 4 ? F.rg_w[k * 4 + c] : F.re_w[k * 32 + (c - 4)]; }
    }
    if (blockIdx.x < 20) {
        __syncthreads();
        LAS float* ML = (LAS float*)(F.lds);
        LAS float* RED = (LAS float*)(F.lds + 65536);
        LAS float* OUTM = (LAS float*)(F.lds + 98304);
        { f32x4 gv[4], bv[4];
#pragma unroll
          for (int j = 0; j < 4; ++j) { gv[j] = *(const f32x4*)(F.lne_g + 4 * F.lane + 256 * j); bv[j] = *(const f32x4*)(F.lne_b + 4 * F.lane + 256 * j); }
          for (int rr = 0; rr < 2; ++rr) { const int m = F.wave * 2 + rr; f32x4 v[4]; ln_row(F.meta + (size_t)m * D, gv, bv, v, F.lane, LN_EPS);
#pragma unroll
              for (int j = 0; j < 4; ++j) *(LAS f32x4*)(ML + m * 1024 + 4 * F.lane + 256 * j) = v[j]; } }
        __syncthreads();
        const int item = blockIdx.x;
        const int col0 = item < 4 ? 256 + 64 * item : (item < 12 ? 512 + 64 * (item - 4) : 1536 + 64 * (item - 12));
        float acc[16];
#pragma unroll
        for (int m = 0; m < 16; ++m) acc[m] = 0.f;
        for (int kk = 0; kk < 128; ++kk) { const int k = F.wave * 128 + kk; const float wv = F.w_in[(size_t)k * 2048 + col0 + F.lane];
#pragma unroll
            for (int m = 0; m < 16; ++m) acc[m] += ML[m * 1024 + k] * wv; }
#pragma unroll
        for (int m = 0; m < 16; ++m) RED[(F.wave * 16 + m) * 64 + F.lane] = acc[m];
        __syncthreads();
        for (int o = F.tid; o < 1024; o += 512) { float s = 0.f;
#pragma unroll
            for (int w = 0; w < 8; ++w) s += RED[w * 1024 + o];
            OUTM[o] = s; }
        __syncthreads();
        for (int o = F.tid; o < 1024; o += 512) { const int m = o >> 6, ii = o & 63;
            if (item < 4) {
                const int i = ii >> 1; const float x1 = OUTM[m * 64 + i], x2 = OUTM[m * 64 + 32 + i];
                const float inv = exp2f(-(float)i * 0.415241011860920f); const float ang = (float)m * inv;
                const double a = (double)ang; const double kq = __builtin_rint(a * 0.15915494309189535); const float rr = (float)__builtin_fma(-kq, 6.283185307179586, a);
                const float cs = cosf(rr), sn = sinf(rr);
                F.metak[m * 256 + item * 64 + ii] = ((ii & 1) ? (x1 * sn + x2 * cs) : (x1 * cs - x2 * sn)) * 0.125f;
            } else if (item < 12) F.metav[m * 512 + (item - 4) * 64 + ii] = OUTM[o];
            else F.metau[m * 512 + (item - 12) * 64 + ii] = OUTM[o];
        }
        __syncthreads();
    }
}

DI f32x4 mma(bf16x8 xf, bf16x8 yf, f32x4 acc) { return __builtin_amdgcn_mfma_f32_16x16x32_bf16(xf, yf, acc, 0, 0, 0); }
DI bf16x8 frag_row(const LAS unsigned char* base, int stride, int row0, int k0, int lane) {
    return *(const LAS bf16x8*)(base + (row0 + (lane & 15)) * stride + (k0 + 8 * (lane >> 4)) * 2);
}
DI bf16x8 frag_tr(const LAS unsigned char* base, int stride, int k0, int x0, int lane) {
    const int g = lane >> 4, q = (lane & 15) >> 2, p = lane & 3;
    const LAS unsigned char* a = base + (k0 + 8 * g + q) * stride + (x0 + 4 * p) * 2;
    const v4i16_t lo = __builtin_amdgcn_ds_read_tr16_b64_v4i16((LAS v4i16_t*)a);
    const v4i16_t hi = __builtin_amdgcn_ds_read_tr16_b64_v4i16((LAS v4i16_t*)(a + 4 * stride));
    return __builtin_shufflevector(lo, hi, 0, 1, 2, 3, 4, 5, 6, 7);
}
constexpr int SQ = 144, SV = 272;
DI v4u scale8(v4u x, float z) { v4u o;
#pragma unroll
    for (int p = 0; p < 4; ++p) o[p] = cvtpk(bflo(x[p]) * z, bfhi(x[p]) * z);
    return o; }
DI void p2_scan(Frame& F) {
    constexpr int SVS = 80;
    LAS unsigned char* KS = F.lds; LAS unsigned char* VSL = F.lds + 18432;
    const int w = F.wave, lane = F.lane, fr = lane & 15, fq = lane >> 4, dt = w >> 1, vt = w & 1;
    for (int unit = blockIdx.x; unit < 256; unit += F.G) {
        const int b = unit >> 4, h = (unit >> 2) & 3, vs = unit & 3;
        const float lg = log2f(1.0f - exp2f(-5.0f - (float)h));
        const float cd = exp2f(128.0f * lg);
        const int kr0 = F.tid >> 3, kc8 = F.tid & 7, vr = F.tid >> 2, vc4 = F.tid & 3;
        const float z0 = exp2f((float)(127 - kr0) * lg), z1 = exp2f((float)(63 - kr0) * lg);
        const int d0 = 16 * dt + 4 * fq, vcol = vs * 32 + 16 * vt + fr;
        f32x4 st = {0.f, 0.f, 0.f, 0.f};
        for (int m = 0; m < 16; ++m) { const float zm = exp2f((float)(15 - m) * lg) * F.metav[m * 512 + h * 128 + vcol]; const f32x4 kk = *(const f32x4*)(F.metak + m * 256 + h * 64 + d0); st = st + kk * zm; }
        bf16* STb = F.ST + (size_t)((b * 4 + h) * 32) * 8192 + vcol * 64 + d0;
        const bf16* kp = F.Kb + ((size_t)b * 4096 + kr0) * 256 + h * 64 + kc8 * 8; const bf16* vp = F.Vb + ((size_t)b * 4096 + vr) * 512 + h * 128 + vs * 32 + vc4 * 8;
        v4u rk0[4], rk1[4], rvv[4];
#pragma unroll
        for (int u = 0; u < 4; ++u) { const size_t o = (size_t)u * 128; rk0[u] = *(const GAS v4u*)(kp + o * 256); rk1[u] = *(const GAS v4u*)(kp + (o + 64) * 256); rvv[u] = *(const GAS v4u*)(vp + o * 512); }
        for (int n0 = 0; n0 < 32; n0 += 4) {
#pragma unroll
            for (int u = 0; u < 4; ++u) { const int n = n0 + u;
                { u32x2 pk; pk.x = cvtpk(st[0], st[1]); pk.y = cvtpk(st[2], st[3]); *(GAS u32x2*)(STb + (size_t)n * 8192) = pk; }
                if (n < 31) {
                    __syncthreads();
                    *(LAS v4u*)(KS + kr0 * SQ + kc8 * 16) = scale8(rk0[u], z0); *(LAS v4u*)(KS + (kr0 + 64) * SQ + kc8 * 16) = scale8(rk1[u], z1);
                    *(LAS v4u*)(VSL + vr * SVS + vc4 * 16) = rvv[u];
                    __syncthreads();
                    if (n + 4 < 31) { const size_t o = (size_t)(n + 4) * 128; rk0[u] = *(const GAS v4u*)(kp + o * 256); rk1[u] = *(const GAS v4u*)(kp + (o + 64) * 256); rvv[u] = *(const GAS v4u*)(vp + o * 512); }
                    f32x4 a = {0.f, 0.f, 0.f, 0.f};
#pragma unroll
                    for (int kk = 0; kk < 4; ++kk) a = mma(frag_tr(KS, SQ, 32 * kk, 16 * dt, lane), frag_tr(VSL, SVS, 32 * kk, 16 * vt, lane), a);
                    st = st * cd + a;
                }
            }
        }
    }
    __syncthreads();
}

struct RetRegs { v4u q[2], k[2], s[2], v[4]; u32x2 g[8]; };
DI void ret_fetch(const Frame& F, RetRegs& r, int b, int h, int nn) {
    const size_t R0 = (size_t)b * 4096 + (size_t)nn * 128;
#pragma unroll
    for (int i = 0; i < 2; ++i) { const int ch = F.tid + 512 * i, rw = ch >> 3, c8 = ch & 7;
        r.q[i] = *(const GAS v4u*)(F.Qb + (R0 + rw) * 256 + h * 64 + c8 * 8); r.k[i] = *(const GAS v4u*)(F.Kb + (R0 + rw) * 256 + h * 64 + c8 * 8);
        r.s[i] = *(const GAS v4u*)(F.ST + (size_t)((b * 4 + h) * 32 + nn) * 8192 + rw * 64 + c8 * 8); }
#pragma unroll
    for (int i = 0; i < 4; ++i) { const int ch = F.tid + 512 * i, rw = ch >> 4, c16 = ch & 15; r.v[i] = *(const GAS v4u*)(F.Vb + (R0 + rw) * 512 + h * 128 + c16 * 8); }
    { const bf16* grow = F.Gb + (R0 + 16 * F.wave + (F.lane & 15)) * 512 + h * 128 + 4 * (F.lane >> 4);
#pragma unroll
      for (int vt = 0; vt < 8; ++vt) r.g[vt] = *(const GAS u32x2*)(grow + 16 * vt); }
}
DI void ret_compute(Frame& F, int b, int h, int nn, float lg, const u32x2 (&gb)[8]) {
    LAS unsigned char* QS = F.lds; LAS unsigned char* KS = F.lds + 18432; LAS unsigned char* VS = F.lds + 36864; LAS unsigned char* SS = F.lds + 71680; LAS unsigned char* CS = F.lds + 90112;
    const size_t R0 = (size_t)b * 4096 + (size_t)nn * 128;
    const int w = F.wave, lane = F.lane, fr = lane & 15, fq = lane >> 4;
    const int il = 16 * w + fr;
    const bf16x8 qf0 = frag_row(QS, SQ, 16 * w, 0, lane), qf1 = frag_row(QS, SQ, 16 * w, 32, lane);
    const int jtmax = w | 1;
    for (int jt = 0; jt <= jtmax; ++jt) {
        f32x4 a = {0.f, 0.f, 0.f, 0.f};
        a = mma(frag_row(KS, SQ, 16 * jt, 0, lane), qf0, a); a = mma(frag_row(KS, SQ, 16 * jt, 32, lane), qf1, a);
        float o[4];
#pragma unroll
        for (int r = 0; r < 4; ++r) { const int dl = il - (16 * jt + 4 * fq + r); o[r] = dl >= 0 ? a[r] * exp2f((float)dl * lg) : 0.f; }
        u32x2 pk; pk.x = cvtpk(o[0], o[1]); pk.y = cvtpk(o[2], o[3]);
        *(LAS u32x2*)(CS + il * SV + (16 * jt + 4 * fq) * 2) = pk;
    }
    asm volatile("s_waitcnt lgkmcnt(0)" ::: "memory");
    f32x4 accI[8], accC[8];
#pragma unroll
    for (int vt = 0; vt < 8; ++vt) { accI[vt] = (f32x4){0.f, 0.f, 0.f, 0.f}; accC[vt] = (f32x4){0.f, 0.f, 0.f, 0.f}; }
    const int kkmax = w >> 1;
    for (int kk = 0; kk <= kkmax; ++kk) { const bf16x8 cf = frag_row(CS, SV, 16 * w, 32 * kk, lane);
#pragma unroll
        for (int vt = 0; vt < 8; ++vt) accI[vt] = mma(frag_tr(VS, SV, 32 * kk, 16 * vt, lane), cf, accI[vt]); }
#pragma unroll
    for (int vt = 0; vt < 8; ++vt) { accC[vt] = mma(frag_row(SS, SQ, 16 * vt, 0, lane), qf0, accC[vt]); accC[vt] = mma(frag_row(SS, SQ, 16 * vt, 32, lane), qf1, accC[vt]); }
    const float xi = exp2f((float)(il + 1) * lg);
    float s = 0.f;
#pragma unroll
    for (int vt = 0; vt < 8; ++vt) { accI[vt] = accI[vt] + accC[vt] * xi; s += (accI[vt][0] + accI[vt][1]) + (accI[vt][2] + accI[vt][3]); }
    s += __shfl_xor(s, 16); s += __shfl_xor(s, 32);
    const float mean = s * (1.0f / 128.0f); float q = 0.f;
#pragma unroll
    for (int vt = 0; vt < 8; ++vt) { accI[vt] = accI[vt] - mean; q += (accI[vt][0] * accI[vt][0] + accI[vt][1] * accI[vt][1]) + (accI[vt][2] * accI[vt][2] + accI[vt][3] * accI[vt][3]); }
    q += __shfl_xor(q, 16); q += __shfl_xor(q, 32);
    const float rstd = 1.0f / sqrtf(q * (1.0f / 128.0f) + GN_EPS);
    bf16* orow = F.MIXIN + (R0 + il) * 1024 + h * 128 + 4 * fq;
#pragma unroll
    for (int vt = 0; vt < 8; ++vt) {
        const float g0 = bflo(gb[vt].x), g1 = bfhi(gb[vt].x), g2 = bflo(gb[vt].y), g3 = bfhi(gb[vt].y);
        const float y0 = accI[vt][0] * rstd * g0 / (1.0f + __expf(-g0)), y1 = accI[vt][1] * rstd * g1 / (1.0f + __expf(-g1));
        const float y2 = accI[vt][2] * rstd * g2 / (1.0f + __expf(-g2)), y3 = accI[vt][3] * rstd * g3 / (1.0f + __expf(-g3));
        u32x2 pk; pk.x = cvtpk(y0, y1); pk.y = cvtpk(y2, y3); *(GAS u32x2*)(orow + 16 * vt) = pk; }
}
DI void pool_fetch(const Frame& F, v4u (&ru)[5], int b, int g, int nn) {
#pragma unroll
    for (int i = 0; i < 5; ++i) { const int ch = F.tid + 512 * i; ru[i] = (v4u){0u, 0u, 0u, 0u};
        if (ch < 144 * 16) { const int rr = ch >> 4, c16 = ch & 15, t = nn * 128 - 16 + rr;
            if (t >= 0) ru[i] = *(const GAS v4u*)(F.Ub + ((size_t)b * 4096 + t) * 512 + g * 128 + c16 * 8);
            else { const float* mu = F.metau + (16 + t) * 512 + g * 128 + c16 * 8; ru[i].x = pk2(mu[0], mu[1]); ru[i].y = pk2(mu[2], mu[3]); ru[i].z = pk2(mu[4], mu[5]); ru[i].w = pk2(mu[6], mu[7]); } } }
}
DI void p3_mixer(Frame& F) {
    const int c = blockIdx.x;
    {
        LAS unsigned char* QS = F.lds; LAS unsigned char* KS = F.lds + 18432; LAS unsigned char* VS = F.lds + 36864; LAS unsigned char* SS = F.lds + 71680;
        RetRegs rg; { const int tile = 2 * c; ret_fetch(F, rg, tile >> 5, 0, tile & 31); }
        for (int i = 0; i < 8; ++i) {
            const int tile = 2 * c + (i >> 2), hg = i & 3, b = tile >> 5, nn = tile & 31;
            const float lg = log2f(1.0f - exp2f(-5.0f - (float)hg));
            __syncthreads();
#pragma unroll
            for (int k = 0; k < 2; ++k) { const int ch = F.tid + 512 * k, rw = ch >> 3, c8 = ch & 7;
                *(LAS v4u*)(QS + rw * SQ + c8 * 16) = rg.q[k]; *(LAS v4u*)(KS + rw * SQ + c8 * 16) = rg.k[k]; *(LAS v4u*)(SS + rw * SQ + c8 * 16) = rg.s[k]; }
#pragma unroll
            for (int k = 0; k < 4; ++k) { const int ch = F.tid + 512 * k, rw = ch >> 4, c16 = ch & 15; *(LAS v4u*)(VS + rw * SV + c16 * 16) = rg.v[k]; }
            __syncthreads();
            u32x2 gcur[8];
#pragma unroll
            for (int vt = 0; vt < 8; ++vt) gcur[vt] = rg.g[vt];
            if (i < 7) { const int t2 = 2 * c + ((i + 1) >> 2); ret_fetch(F, rg, t2 >> 5, (i + 1) & 3, t2 & 31); }
            ret_compute(F, b, hg, nn, lg, gcur);
        }
    }
    {
        LAS unsigned char* US = F.lds; LAS unsigned char* PS = F.lds + 40960; LAS unsigned char* WSM = F.lds + 77824;
        const int w = F.wave, lane = F.lane, fr = lane & 15, fq = lane >> 4;
        f32x4 pb[8], psc[8]; v4u wreg[4];
        v4u ru[5]; { const int tile = 2 * c; pool_fetch(F, ru, tile >> 5, 0, tile & 31); }
#pragma unroll
        for (int k = 0; k < 4; ++k) { const int ch = F.tid + 512 * k; wreg[k] = *(const GAS v4u*)(F.Wpool_t + (ch >> 4) * 128 + (ch & 15) * 8); }
        for (int i = 0; i < 8; ++i) {
            const int g = i >> 1, tile = 2 * c + (i & 1), b = tile >> 5, nn = tile & 31, win = 2 << g; const float invw = 1.0f / (float)win;
            const size_t R0 = (size_t)b * 4096 + (size_t)nn * 128;
            __syncthreads();
            if ((i & 1) == 0) {
#pragma unroll
                for (int k = 0; k < 4; ++k) { const int ch = F.tid + 512 * k; *(LAS v4u*)(WSM + (ch >> 4) * SV + (ch & 15) * 16) = wreg[k]; }
#pragma unroll
                for (int dt = 0; dt < 8; ++dt) { pb[dt] = *(const f32x4*)(F.pool_b + g * 128 + 16 * dt + 4 * fq); psc[dt] = *(const f32x4*)(F.pool_scale + g * 128 + 16 * dt + 4 * fq); } }
#pragma unroll
            for (int k = 0; k < 5; ++k) { const int ch = F.tid + 512 * k; if (ch < 144 * 16) *(LAS v4u*)(US + (ch >> 4) * SV + (ch & 15) * 16) = ru[k]; }
            __syncthreads();
            if (i < 7) { const int t2 = 2 * c + ((i + 1) & 1), g2 = (i + 1) >> 1; pool_fetch(F, ru, t2 >> 5, g2, t2 & 31);
                if ((i & 1) == 1) {
#pragma unroll
                    for (int k = 0; k < 4; ++k) { const int ch = F.tid + 512 * k; wreg[k] = *(const GAS v4u*)(F.Wpool_t + g2 * 16384 + (ch >> 4) * 128 + (ch & 15) * 8); } } }
            { const int c2 = F.tid & 63, ib = F.tid >> 6; float run0 = 0.f, run1 = 0.f;
              for (int sI = 0; sI < win; ++sI) { const unsigned xw = *(const LAS unsigned*)(US + (16 + 16 * ib - sI) * SV + c2 * 4); run0 += bflo(xw); run1 += bfhi(xw); }
              for (int ii = 0; ii < 16; ++ii) { const int ir = 16 * ib + ii; const unsigned cur = *(const LAS unsigned*)(US + (16 + ir) * SV + c2 * 4);
                  if (ii > 0) { const unsigned old = *(const LAS unsigned*)(US + (16 + ir - win) * SV + c2 * 4); run0 += bflo(cur) - bflo(old); run1 += bfhi(cur) - bfhi(old); }
                  *(LAS unsigned*)(PS + ir * SV + c2 * 4) = cvtpk(run0 * invw - bflo(cur), run1 * invw - bfhi(cur)); } }
            __syncthreads();
            bf16x8 pf[4];
#pragma unroll
            for (int kk = 0; kk < 4; ++kk) pf[kk] = frag_row(PS, SV, 16 * w, 32 * kk, lane);
            bf16* orow = F.MIXIN + (R0 + 16 * w + fr) * 1024 + 512 + g * 128 + 4 * fq;
#pragma unroll
            for (int dt = 0; dt < 8; ++dt) { f32x4 a = {0.f, 0.f, 0.f, 0.f};
#pragma unroll
                for (int kk = 0; kk < 4; ++kk) a = mma(frag_row(WSM, SV, 16 * dt, 32 * kk, lane), pf[kk], a);
                a = (a + pb[dt]) * psc[dt];
                u32x2 pk; pk.x = cvtpk(a[0], a[1]); pk.y = cvtpk(a[2], a[3]); *(GAS u32x2*)(orow + 16 * dt) = pk; }
        }
    }
    __syncthreads();
}

DI void split8(const float (&h)[8], bf16x8& hi, bf16x8& lo) {
    v4u a, b;
#pragma unroll
    for (int p = 0; p < 4; ++p) { const unsigned wd = cvtpk(h[2 * p], h[2 * p + 1]); a[p] = wd; b[p] = cvtpk(h[2 * p] - bflo(wd), h[2 * p + 1] - bfhi(wd)); }
    hi = __builtin_bit_cast(bf16x8, a); lo = __builtin_bit_cast(bf16x8, b);
}
DI void p5_ln_router(Frame& F) {
    LAS int* LCNT = (LAS int*)(F.lds + LCNT_OFF);
    LAS f32x2* SP = (LAS f32x2*)(F.lds);
    LAS float* LP = (LAS float*)(F.lds + 1024);
    LAS float* LG = (LAS float*)(F.lds + 1024 + 24576);
    LAS float* GB = (LAS float*)(F.lds + 32768);
    for (int i = F.tid; i < 256; i += 512) { *(LAS f32x4*)(GB + 4 * i) = *(const f32x4*)(F.ln1_g + 4 * i); *(LAS f32x4*)(GB + 1024 + 4 * i) = *(const f32x4*)(F.ln1_b + 4 * i); }
    if (F.tid < 32) LCNT[F.tid] = 0;
    const int w = F.wave, lane = F.lane, fr = lane & 15, fq = lane >> 4;
    const int kb = 128 * w + 8 * fq;
    bf16x8 wh[3][4], wl[3][4];
#pragma unroll
    for (int ct = 0; ct < 3; ++ct)
#pragma unroll
        for (int ks = 0; ks < 4; ++ks) { const int cc = 16 * ct + fr; float f[8];
            if (cc < 36) { const f32x4 a = *(const f32x4*)(F.RW + cc * 1024 + kb + 32 * ks), b = *(const f32x4*)(F.RW + cc * 1024 + kb + 32 * ks + 4);
                f[0] = a[0]; f[1] = a[1]; f[2] = a[2]; f[3] = a[3]; f[4] = b[0]; f[5] = b[1]; f[6] = b[2]; f[7] = b[3]; }
            else {
#pragma unroll
                for (int j = 0; j < 8; ++j) f[j] = 0.f; }
            split8(f, wh[ct][ks], wl[ct][ks]); }
    const int c = blockIdx.x;
    const float rbias = lane < 4 ? F.rg_b[lane] : (lane < 36 ? F.re_b[lane - 4] : 0.f);
    const bf16* tbase = F.T1 + (size_t)(c * 256 + fr) * D + kb;
    v4u tn[4], tm[4];
#pragma unroll
    for (int ks = 0; ks < 4; ++ks) { tn[ks] = *(const GAS v4u*)(tbase + 32 * ks); tm[ks] = *(const GAS v4u*)(tbase + (size_t)16 * D + 32 * ks); }
    __syncthreads();
    for (int grp = 0; grp < 16; ++grp) {
        f32x4 t[8];
#pragma unroll
        for (int i = 0; i < 4; ++i) { t[2 * i] = (f32x4){bflo(tn[i].x), bfhi(tn[i].x), bflo(tn[i].y), bfhi(tn[i].y)}; t[2 * i + 1] = (f32x4){bflo(tn[i].z), bfhi(tn[i].z), bflo(tn[i].w), bfhi(tn[i].w)}; }
#pragma unroll
        for (int ks = 0; ks < 4; ++ks) tn[ks] = tm[ks];
        if (grp < 14) { const bf16* nb = tbase + (size_t)(grp + 2) * 16 * D;
#pragma unroll
            for (int ks = 0; ks < 4; ++ks) tm[ks] = *(const GAS v4u*)(nb + 32 * ks); }
        float s = 0.f, s2 = 0.f;
#pragma unroll
        for (int i = 0; i < 8; ++i) { s += (t[i][0] + t[i][1]) + (t[i][2] + t[i][3]); s2 += (t[i][0] * t[i][0] + t[i][1] * t[i][1]) + (t[i][2] * t[i][2] + t[i][3] * t[i][3]); }
        s += __shfl_xor(s, 16); s += __shfl_xor(s, 32); s2 += __shfl_xor(s2, 16); s2 += __shfl_xor(s2, 32);
        if (fq == 0) SP[fr * 8 + w] = (f32x2){s, s2};
        __syncthreads();
        float ts = 0.f, ts2 = 0.f;
#pragma unroll
        for (int k = 0; k < 8; ++k) { const f32x2 p = SP[fr * 8 + k]; ts += p.x; ts2 += p.y; }
        const float mean = ts * (1.f / D); const float rstd = 1.f / sqrtf(ts2 * (1.f / D) - mean * mean + LN_EPS);
        f32x4 acc[3];
#pragma unroll
        for (int ct = 0; ct < 3; ++ct) acc[ct] = (f32x4){0.f, 0.f, 0.f, 0.f};
        bf16* hrow = F.H1B + (size_t)(c * 256 + grp * 16 + fr) * D + kb;
#pragma unroll
        for (int ks = 0; ks < 4; ++ks) { const int col = kb + 32 * ks;
            const f32x4 g0 = *(const LAS f32x4*)(GB + col), g1 = *(const LAS f32x4*)(GB + col + 4), b0 = *(const LAS f32x4*)(GB + 1024 + col), b1 = *(const LAS f32x4*)(GB + 1024 + col + 4);
            const f32x4 h0 = (t[2 * ks] - mean) * rstd * g0 + b0, h1 = (t[2 * ks + 1] - mean) * rstd * g1 + b1;
            const float h[8] = {h0[0], h0[1], h0[2], h0[3], h1[0], h1[1], h1[2], h1[3]};
            bf16x8 hh, hl; split8(h, hh, hl);
            *(GAS bf16x8*)(hrow + 32 * ks) = hh;
#pragma unroll
            for (int ct = 0; ct < 3; ++ct) { acc[ct] = mma(wh[ct][ks], hh, acc[ct]); acc[ct] = mma(wh[ct][ks], hl, acc[ct]); acc[ct] = mma(wl[ct][ks], hh, acc[ct]); } }
#pragma unroll
        for (int ct = 0; ct < 3; ++ct) *(LAS f32x4*)(LP + ((w * 16 + fr) * 48 + 16 * ct + 4 * fq)) = acc[ct];
        __syncthreads();
#pragma unroll
        for (int rr = 0; rr < 2; ++rr) { const int rl = 2 * w + rr;
            if (lane < 36) { float sg = 0.f;
#pragma unroll
                for (int k = 0; k < 8; ++k) sg += LP[(k * 16 + rl) * 48 + lane];
                LG[rl * 40 + lane] = sg + rbias; } }
        asm volatile("s_waitcnt lgkmcnt(0)" ::: "memory");
        if (lane < 2) { const int rl = 2 * w + lane, row = c * 256 + grp * 16 + rl; const LAS float* lg = LG + rl * 40;
            const float l0 = lg[0], l1 = lg[1], l2 = lg[2], l3 = lg[3];
            const float gmax = fmaxf(fmaxf(l0, l1), fmaxf(l2, l3));
            const int gi = l0 == gmax ? 0 : (l1 == gmax ? 1 : (l2 == gmax ? 2 : 3));
            const float gp = 1.0f / ((expf(l0 - gmax) + expf(l1 - gmax)) + (expf(l2 - gmax) + expf(l3 - gmax)));
            float sel[8];
#pragma unroll
            for (int k = 0; k < 8; ++k) sel[k] = lg[4 + gi * 8 + k];
            float m1 = sel[0];
#pragma unroll
            for (int k = 1; k < 8; ++k) m1 = fmaxf(m1, sel[k]);
            int i1 = 7;
#pragma unroll
            for (int k = 6; k >= 0; --k) i1 = sel[k] == m1 ? k : i1;
            float m2 = -3.0e38f;
#pragma unroll
            for (int k = 0; k < 8; ++k) m2 = (k != i1) ? fmaxf(m2, sel[k]) : m2;
            int i2 = -1;
#pragma unroll
            for (int k = 7; k >= 0; --k) i2 = (k != i1 && sel[k] == m2) ? k : i2;
            const float tt = expf(m2 - m1); const float w0 = gp / (1.0f + tt), w1 = gp * tt / (1.0f + tt);
            const int e0 = gi * 8 + i1, e1 = gi * 8 + i2;
            const int li0 = __hip_atomic_fetch_add(LCNT + e0, 1, __ATOMIC_RELAXED, __HIP_MEMORY_SCOPE_WORKGROUP), li1 = __hip_atomic_fetch_add(LCNT + e1, 1, __ATOMIC_RELAXED, __HIP_MEMORY_SCOPE_WORKGROUP);
            F.toke[row] = (unsigned)e0 | ((unsigned)e1 << 8); F.tokl[row] = (unsigned)li0 | ((unsigned)li1 << 16); F.tokw[row] = (f32x2){w0, w1}; }
    }
    __syncthreads();
    if (F.tid < 32) F.cnt[c * 32 + F.tid] = LCNT[F.tid];
}
DI void moe_layout(Frame& F) {
    LAS int* red = (LAS int*)(F.lds);
    LAS int* PP = (LAS int*)(F.lds + PP_OFF); LAS int* TOT = (LAS int*)(F.lds + TOT_OFF); LAS int* BEF = (LAS int*)(F.lds + BEF_OFF); LAS int* BASE = (LAS int*)(F.lds + BASE_OFF);
    __syncthreads();
    { const int e = F.tid & 31, part = F.tid >> 5; int tot = 0, bef = 0;
      for (int k = 0; k < 16; ++k) { const int c2 = part * 16 + k; const int v = F.cnt[c2 * 32 + e]; tot += v; bef += (c2 < (int)blockIdx.x) ? v : 0; }
      red[(part * 32 + e) * 2] = tot; red[(part * 32 + e) * 2 + 1] = bef; }
    __syncthreads();
    if (F.tid < 32) { int t = 0, bf = 0;
        for (int p = 0; p < 16; ++p) { t += red[(p * 32 + F.tid) * 2]; bf += red[(p * 32 + F.tid) * 2 + 1]; }
        TOT[F.tid] = t; BEF[F.tid] = bf; }
    __syncthreads();
    if (F.tid == 0) { int acc = 0; for (int e = 0; e < 32; ++e) { PP[e] = acc; acc += (TOT[e] + 255) >> 8; } PP[32] = acc; }
    __syncthreads();
    if (F.tid < 32) BASE[F.tid] = PP[F.tid] * 256 + BEF[F.tid];
    __syncthreads();
}
DI void p6_assign(Frame& F) {
    moe_layout(F);
    const LAS int* BASE = (const LAS int*)(F.lds + BASE_OFF); const LAS int* PP = (const LAS int*)(F.lds + PP_OFF); const LAS int* TOT = (const LAS int*)(F.lds + TOT_OFF);
    const int c = blockIdx.x;
    if (F.tid < 256) { const int row = c * 256 + F.tid; const unsigned te = F.toke[row], tl = F.tokl[row];
        const int s0 = BASE[te & 255u] + (int)(tl & 0xffffu), s1 = BASE[(te >> 8) & 255u] + (int)(tl >> 16);
        F.stok[s0] = row; F.stok[s1] = row; F.toks[row * 2] = s0; F.toks[row * 2 + 1] = s1; const f32x2 wv = F.tokw[row]; F.PW[s0] = wv.x; F.PW[s1] = wv.y; }
    if (c < 32) { const int lo = PP[c] * 256 + TOT[c], hi = PP[c + 1] * 256; for (int sl = lo + F.tid; sl < hi; sl += 512) { F.stok[sl] = 0; F.PW[sl] = 0.f; } }
}
DI void p9_final(Frame& F) {
    const int gw = F.vcu * NWAVES + F.wave, NGW = F.G * NWAVES;
    f32x4 gv[4], bv[4];
#pragma unroll
    for (int j = 0; j < 4; ++j) { gv[j] = *(const f32x4*)(F.ln2_g + 4 * F.lane + 256 * j); bv[j] = *(const f32x4*)(F.ln2_b + 4 * F.lane + 256 * j); }
    u32x2 nh[4], mh[4]; unsigned na[4], nb[4], ma[4], mb[4]; int s0n, s1n;
    { const int r0 = gw, r1 = gw + NGW, r2 = gw + 2 * NGW;
      const int a0 = F.toks[r0 * 2], a1 = F.toks[r0 * 2 + 1], b0 = F.toks[r1 * 2], b1 = F.toks[r1 * 2 + 1];
      const GAS u32x2* hp = (const GAS u32x2*)(F.H1B + (size_t)r0 * D) + F.lane; const GAS unsigned* y0 = (const GAS unsigned*)(F.YP + (size_t)a0 * D) + F.lane; const GAS unsigned* y1 = (const GAS unsigned*)(F.YP + (size_t)a1 * D) + F.lane;
      const GAS u32x2* hq = (const GAS u32x2*)(F.H1B + (size_t)r1 * D) + F.lane; const GAS unsigned* z0 = (const GAS unsigned*)(F.YP + (size_t)b0 * D) + F.lane; const GAS unsigned* z1 = (const GAS unsigned*)(F.YP + (size_t)b1 * D) + F.lane;
#pragma unroll
      for (int j = 0; j < 4; ++j) { nh[j] = hp[64 * j]; na[j] = y0[64 * j]; nb[j] = y1[64 * j]; mh[j] = hq[64 * j]; ma[j] = z0[64 * j]; mb[j] = z1[64 * j]; }
      s0n = F.toks[r2 * 2]; s1n = F.toks[r2 * 2 + 1]; }
    for (int row = gw; row < M; row += NGW) {
        u32x2 ch[4]; unsigned ca[4], cb[4];
#pragma unroll
        for (int j = 0; j < 4; ++j) { ch[j] = nh[j]; ca[j] = na[j]; cb[j] = nb[j]; nh[j] = mh[j]; na[j] = ma[j]; nb[j] = mb[j]; }
        if (row + 2 * NGW < M) { const int rn = row + 2 * NGW;
            const GAS u32x2* hp = (const GAS u32x2*)(F.H1B + (size_t)rn * D) + F.lane; const GAS unsigned* y0 = (const GAS unsigned*)(F.YP + (size_t)s0n * D) + F.lane; const GAS unsigned* y1 = (const GAS unsigned*)(F.YP + (size_t)s1n * D) + F.lane;
#pragma unroll
            for (int j = 0; j < 4; ++j) { mh[j] = hp[64 * j]; ma[j] = y0[64 * j]; mb[j] = y1[64 * j]; }
            const int r3 = rn + NGW < M ? rn + NGW : rn; s0n = F.toks[r3 * 2]; s1n = F.toks[r3 * 2 + 1]; }
        f32x4 v[4]; float s = 0.f;
#pragma unroll
        for (int j = 0; j < 4; ++j) { const u32x2 hb = ch[j];
            const f32x2 a0 = __builtin_amdgcn_cvt_pk_f32_fp8((int)ca[j], false), a1 = __builtin_amdgcn_cvt_pk_f32_fp8((int)ca[j], true);
            const f32x2 b0 = __builtin_amdgcn_cvt_pk_f32_fp8((int)cb[j], false), b1 = __builtin_amdgcn_cvt_pk_f32_fp8((int)cb[j], true);
            v[j].x = ALPHA * bflo(hb.x) + (a0.x + b0.x) * 0.015625f; v[j].y = ALPHA * bfhi(hb.x) + (a0.y + b0.y) * 0.015625f;
            v[j].z = ALPHA * bflo(hb.y) + (a1.x + b1.x) * 0.015625f; v[j].w = ALPHA * bfhi(hb.y) + (a1.y + b1.y) * 0.015625f;
            s += (v[j].x + v[j].y) + (v[j].z + v[j].w); }
        const float mean = wave_sum(s) * (1.f / D); float s2 = 0.f;
#pragma unroll
        for (int j = 0; j < 4; ++j) { v[j] = v[j] - mean; s2 += (v[j].x * v[j].x + v[j].y * v[j].y) + (v[j].z * v[j].z + v[j].w * v[j].w); }
        const float rstd = 1.f / sqrtf(wave_sum(s2) * (1.f / D) + LN_EPS);
        GAS f32x4* op = (GAS f32x4*)(F.out + (size_t)row * D) + F.lane;
#pragma unroll
        for (int j = 0; j < 4; ++j) op[64 * j] = v[j] * rstd * gv[j] + bv[j];
    }
}

struct Args { const float* in[20]; float* out; unsigned char* ws; int ph_lo, ph_hi; };
__global__ void __launch_bounds__(NWAVES * 64, 2) hrp_fwd(Args args) {
    extern __shared__ __attribute__((aligned(16))) unsigned char lds[];
    Frame F;
    F.lds = (LAS unsigned char*)lds;
    F.MISC = (volatile LAS unsigned*)(F.lds + MISC_OFF);
    F.tid = threadIdx.x; F.lane = F.tid & 63; F.wave = __builtin_amdgcn_readfirstlane(F.tid >> 6);
    F.G = gridDim.x; { const int bx = blockIdx.x; F.vcu = (F.G % 8 == 0) ? (bx % 8) * (F.G / 8) + bx / 8 : bx; }
    unsigned char* ws = args.ws;
    F.ctl = (gu32*)(ws + WS_CTL);
    F.x = args.in[0]; F.meta = args.in[1]; F.lne_g = args.in[2]; F.lne_b = args.in[3]; F.w_in = args.in[4]; F.pool_w = args.in[5]; F.pool_b = args.in[6]; F.pool_scale = args.in[7];
    F.w_out = args.in[8]; F.ln1_g = args.in[9]; F.ln1_b = args.in[10]; F.rg_w = args.in[11]; F.rg_b = args.in[12]; F.re_w = args.in[13]; F.re_b = args.in[14];
    F.w_gate = args.in[15]; F.w_up = args.in[16]; F.w_down = args.in[17]; F.ln2_g = args.in[18]; F.ln2_b = args.in[19]; F.out = args.out;
    F.Win_t = (bf16*)(ws + WS_WIN); F.Wout_t = (bf16*)(ws + WS_WOUT); F.Wpool_t = (bf16*)(ws + WS_WPOOL); F.Wgu_t = (bf16*)(ws + WS_WGU); F.Wd_t = (bf16*)(ws + WS_WD);
    F.RW = (float*)(ws + WS_RW); F.metak = (float*)(ws + WS_METAK); F.metav = (float*)(ws + WS_METAV); F.metau = (float*)(ws + WS_METAU); F.rope = (float*)(ws + WS_ROPE);
    F.T1 = (bf16*)(ws + WS_T1); F.PW = (float*)(ws + WS_PW);
    F.toke = (unsigned*)(ws + WS_TOKE); F.tokl = (unsigned*)(ws + WS_TOKL); F.tokw = (f32x2*)(ws + WS_TOKW); F.toks = (int*)(ws + WS_TOKS); F.cnt = (int*)(ws + WS_CNT); F.stok = (int*)(ws + WS_STOK);
    F.ST = (bf16*)(ws + WS_ST); F.H0 = (bf16*)(ws + WS_H0); F.Qb = (bf16*)(ws + WS_Q); F.Kb = (bf16*)(ws + WS_K); F.Vb = (bf16*)(ws + WS_V); F.Gb = (bf16*)(ws + WS_GATE); F.Ub = (bf16*)(ws + WS_U);
    F.MIXIN = (bf16*)(ws + WS_MIXIN); F.H1B = (bf16*)(ws + WS_H1B); F.HID = (bf16*)(ws + WS_HID); F.YP = (unsigned char*)(ws + WS_YP);
    for (int u = F.tid; u < (LDS_BYTES - LDSCTL_OFF) / 4; u += NWAVES * 64) ((LAS unsigned*)(F.lds + LDSCTL_OFF))[u] = 0u;
    __syncthreads();
    if (F.G != 256) return;
    XcdBarrier bar; bar.bar = (unsigned*)(F.ctl + CW_BAR); bar.x = 0; bar.st = nullptr;
    if (N_LAUNCHES != PER_PHASE) bar = xcd_barrier_post((unsigned*)(F.ctl + CW_BAR), F.MISC + 8);
#define GRID_BAR() do { if (N_LAUNCHES != PER_PHASE) xcd_barrier(bar); } while (0)
    const int lo = args.ph_lo, hi = args.ph_hi;
#define IN(k) (lo <= (k) && (k) < hi)
#define BOTH(k) (IN(k) && IN((k) + 1))

    if (IN(0)) { p0_prologue(F); if (BOTH(0)) GRID_BAR(); }
    if (IN(1)) {
        pg8::Gemm g{F.H0, F.Win_t, M, NPROJ, D}; pg8::StaticOrder S; S.init(M, NPROJ, F.G, (int)blockIdx.x);
        pg8::EpiProj E{F.Qb, F.Vb, F.rope};
        pg8::gemm_phase<pg8::EpiProj, pg8::StaticOrder, true, true>(F.lds + RING_OFF, g, S, E);
        if (BOTH(1)) GRID_BAR();
    }
    if (IN(2)) { p2_scan(F); if (BOTH(2)) GRID_BAR(); }
    if (IN(3)) { p3_mixer(F); VM_WAIT(); __syncthreads(); }
    if (IN(4)) {
        pg8::Gemm g{F.MIXIN, F.Wout_t, M, D, D}; pg8::OwnPanelOrder S{(int)blockIdx.x, 4};
        pg8::EpiRes E{F.H0, F.T1, ALPHA};
        pg8::gemm_phase<pg8::EpiRes, pg8::OwnPanelOrder, true, true>(F.lds + RING_OFF, g, S, E);
        VM_WAIT(); __syncthreads();
    }
    if (IN(5)) { p5_ln_router(F); if (BOTH(5)) GRID_BAR(); }
    if (IN(6)) { p6_assign(F); if (BOTH(6)) GRID_BAR(); }
    if (IN(7)) {
        if (!IN(6)) moe_layout(F);
        pg8::Gemm g{F.H1B, F.Wgu_t, SLOTS, 1024, D, F.stok}; pg8::GroupedOrder S; S.init((const LAS int*)(F.lds + PP_OFF), F.G, (int)blockIdx.x);
        pg8::EpiGateUp E{F.HID};
        pg8::gemm_phase<pg8::EpiGateUp, pg8::GroupedOrder, true, true, true>(F.lds + RING_OFF, g, S, E);
        if (BOTH(7)) GRID_BAR();
    }
    if (IN(8)) {
        if (!IN(6)) moe_layout(F);
        pg8::Gemm g{F.HID, F.Wd_t, SLOTS, 1024, DEXP}; pg8::GroupedOrder S; S.init((const LAS int*)(F.lds + PP_OFF), F.G, (int)blockIdx.x);
        pg8::EpiDown E{F.YP, F.PW};
        pg8::gemm_phase<pg8::EpiDown, pg8::GroupedOrder, true, true>(F.lds + RING_OFF, g, S, E);
        if (BOTH(8)) GRID_BAR();
    }
    if (IN(9)) p9_final(F);
#undef IN
#undef BOTH
#undef GRID_BAR
}

extern "C" void kernel_launch(void* const* d_in, const int* in_sizes, int n_in, void* d_out, int out_size, void* d_ws, size_t ws_size, hipStream_t stream) {
    static int grid = 0;
    if (grid == 0) {
        if (n_in != 20 || in_sizes[0] != M * D || out_size != M * D || ws_size < WS_END) { fprintf(stderr, "kernel_launch: built for 20 inputs, x and out of %d floats, >= %zu bytes of workspace; got n_in %d, in0 %d, out %d, ws %zu; nothing launched\n", M * D, (size_t)WS_END, n_in, n_in > 0 ? in_sizes[0] : -1, out_size, ws_size); grid = -1; return; }
        int dev = 0, cus = 0, per_cu = 0;
        if (hipGetDevice(&dev) != hipSuccess || hipDeviceGetAttribute(&cus, hipDeviceAttributeMultiprocessorCount, dev) != hipSuccess) { fprintf(stderr, "kernel_launch: hipGetDevice / hipDeviceGetAttribute failed; nothing launched\n"); grid = -1; return; }
        if (hipFuncSetAttribute((const void*)hrp_fwd, hipFuncAttributeMaxDynamicSharedMemorySize, LDS_BYTES) != hipSuccess) { fprintf(stderr, "kernel_launch: hipFuncSetAttribute failed (%d bytes of dynamic LDS); nothing launched\n", LDS_BYTES); grid = -1; return; }
        if (hipOccupancyMaxActiveBlocksPerMultiprocessor(&per_cu, (const void*)hrp_fwd, NWAVES * 64, LDS_BYTES) != hipSuccess || per_cu < 1)
            fprintf(stderr, "kernel_launch: note: the occupancy query reports %d workgroups per CU; the launch goes ahead with one per CU\n", per_cu);
        (void)hipGetLastError();
        grid = cus;
        if (grid != 256) fprintf(stderr, "kernel_launch: %d CUs; this kernel is built for 256 and will leave the output unwritten\n", grid);
    }
    if (grid < 0) return;
    if (hipMemsetAsync((char*)d_ws + WS_CTL, 0, CTL_ZERO_BYTES, stream) != hipSuccess) { fprintf(stderr, "kernel_launch: hipMemsetAsync of the control words failed; nothing launched\n"); return; }
    Args a{};
    for (int i = 0; i < 20; ++i) a.in[i] = (const float*)d_in[i];
    a.out = (float*)d_out; a.ws = (unsigned char*)d_ws;
    for (int li = 0; li < N_LAUNCHES; ++li) {
        a.ph_lo = (N_LAUNCHES == PER_PHASE) ? li : 0; a.ph_hi = (N_LAUNCHES == PER_PHASE) ? li + 1 : PER_PHASE;
        hipLaunchKernelGGL(hrp_fwd, dim3(grid), dim3(NWAVES * 64), LDS_BYTES, stream, a);
        const hipError_t le = hipPeekAtLastError();
        if (le != hipSuccess) { fprintf(stderr, "kernel_launch: launch %d failed: %s\n", li, hipGetErrorName(le)); break; }
    }
}
```

```cpp
#include <hip/hip_runtime.h>
#include <cstdio>
#include <cstdint>
#ifndef MK_N_LAUNCHES
#define MK_N_LAUNCHES 1
#endif
namespace pg8 {
#define PG8_LAS __attribute__((address_space(3)))
typedef unsigned short bf16_t;
typedef short bf16x8 __attribute__((ext_vector_type(8)));
typedef float f32x4 __attribute__((ext_vector_type(4)));
typedef unsigned u32x4 __attribute__((ext_vector_type(4)));
constexpr int BM = 256, BK = 64, HALF = 128, HTB = HALF * BK * 2  , STAGE_BYTES = 8 * HTB, NXCD = 8, WGM = 8;

__host__ __device__ __forceinline__ int lds_byte(int r, int c) { const int st = (r >> 4) * 2 + (c >> 5), rr = r & 15, cc = c & 31, ob = rr * 64 + cc * 2; return st * 1024 + (ob ^ (((ob >> 9) & 1) << 5)); }
__host__ __device__ __forceinline__ void stage_rc(int b, int& R, int& C) { const int st = b / 1024, sb = b % 1024, swz = sb ^ (((sb >> 9) & 1) << 5); R = (st >> 1) * 16 + swz / 64; C = (st & 1) * 32 + (swz % 64) / 2; }
__host__ __device__ __forceinline__ int perm32(int rho) { const int n = rho >> 4, i = rho & 15; return 8 * (i >> 2) + 4 * n + (i & 3); }

struct Unit { int pm, pn; };
struct Gemm { const bf16_t* A; const bf16_t* Bt; int M, N, K; const int* gidx; };

struct StaticOrder {
    int nM, nN, nwg, G, c;
    __host__ __device__ void init(int M, int N, int G_, int c_) { nM = M / BM; nN = N / BM; nwg = nM * nN; G = G_; c = c_; }
    __host__ __device__ bool next(int i, Unit& u) const {
        const long L = (long)i * G + c; if (L >= nwg) return false;
        int wgid = (int)L; { const int q = nwg / NXCD, r = nwg % NXCD, xcd = wgid % NXCD, off = wgid / NXCD; wgid = (xcd < r ? xcd * (q + 1) : r * (q + 1) + (xcd - r) * q) + off; }
        const int nig = WGM * nN, gid = wgid / nig, fm = gid * WGM, gsz = (nM - fm) < WGM ? (nM - fm) : WGM;
        u.pm = fm + ((wgid % nig) % gsz); u.pn = (wgid % nig) / gsz; return true;
    }
    __device__ __forceinline__ void a_ready(const Unit&) const {}
    __device__ __forceinline__ void done(const Unit&) const {}
};

__device__ __forceinline__ unsigned cvt_pk_bf16(float lo, float hi) { unsigned r; asm volatile("v_cvt_pk_bf16_f32 %0, %1, %2" : "=v"(r) : "v"(lo), "v"(hi)); return r; }
__device__ __forceinline__ float bf_lo(unsigned w) { return __uint_as_float(w << 16); }
__device__ __forceinline__ float bf_hi(unsigned w) { return __uint_as_float(w & 0xffff0000u); }

struct EpiProj {
    static constexpr bool PERM = true, AFTER_DRAIN = false;
    bf16_t *Q, *V; const float* rope;
    __device__ __forceinline__ void operator()(const f32x4 (&acc)[2][2][4][2], const Unit& u, int wr, int wc, int fr, int fq) const {
        const int row0 = u.pm * BM + wr * 64 + fr, lc0 = wc * 32 + 8 * fq;
        if (u.pn < 2) {
            bf16_t* base = Q + (size_t)u.pn * ((size_t)65536 * 256); const float sc = u.pn == 0 ? 1.0f : 0.125f;
#pragma unroll
            for (int ai = 0; ai < 2; ++ai)
#pragma unroll
                for (int m = 0; m < 4; ++m) { const int row = row0 + ai * HALF + m * 16; const int pos = 16 + (row & 4095);
#pragma unroll
                    for (int bj = 0; bj < 2; ++bj) { const int lc = lc0 + bj * HALF; const int i0 = (lc & 63) >> 1;
                        const f32x4* tp = (const f32x4*)(rope + ((size_t)pos * 32 + i0) * 2); const f32x4 t0 = tp[0], t1 = tp[1];
                        const f32x4 v0 = acc[ai][bj][m][0], v1 = acc[ai][bj][m][1];
                        const float o0 = (v0[0] * t0[0] - v0[1] * t0[1]) * sc, o1 = (v0[0] * t0[1] + v0[1] * t0[0]) * sc;
                        const float o2 = (v0[2] * t0[2] - v0[3] * t0[3]) * sc, o3 = (v0[2] * t0[3] + v0[3] * t0[2]) * sc;
                        const float o4 = (v1[0] * t1[0] - v1[1] * t1[1]) * sc, o5 = (v1[0] * t1[1] + v1[1] * t1[0]) * sc;
                        const float o6 = (v1[2] * t1[2] - v1[3] * t1[3]) * sc, o7 = (v1[2] * t1[3] + v1[3] * t1[2]) * sc;
                        u32x4 w; w.x = cvt_pk_bf16(o0, o1); w.y = cvt_pk_bf16(o2, o3); w.z = cvt_pk_bf16(o4, o5); w.w = cvt_pk_bf16(o6, o7);
                        *(u32x4*)(base + (size_t)row * 256 + lc) = w; } }
        } else {
            bf16_t* base = V + (size_t)((u.pn - 2) >> 1) * ((size_t)65536 * 512); const int colt = (u.pn & 1) * 256;
#pragma unroll
            for (int ai = 0; ai < 2; ++ai)
#pragma unroll
                for (int m = 0; m < 4; ++m) { bf16_t* rowp = base + (size_t)(row0 + ai * HALF + m * 16) * 512 + colt + lc0;
#pragma unroll
                    for (int bj = 0; bj < 2; ++bj) { const f32x4 v0 = acc[ai][bj][m][0], v1 = acc[ai][bj][m][1];
                        u32x4 w; w.x = cvt_pk_bf16(v0[0], v0[1]); w.y = cvt_pk_bf16(v0[2], v0[3]); w.z = cvt_pk_bf16(v1[0], v1[1]); w.w = cvt_pk_bf16(v1[2], v1[3]);
                        *(u32x4*)(rowp + bj * HALF) = w; } }
        }
    }
};
struct EpiRes {
    static constexpr bool PERM = true, AFTER_DRAIN = false;
    const bf16_t* H0; bf16_t* T; float alpha;
    __device__ __forceinline__ void operator()(const f32x4 (&acc)[2][2][4][2], const Unit& u, int wr, int wc, int fr, int fq) const {
        const int row0 = u.pm * BM + wr * 64 + fr, col0 = u.pn * BM + wc * 32 + 8 * fq;
        u32x4 hv[2][4][2];
#pragma unroll
        for (int ai = 0; ai < 2; ++ai)
#pragma unroll
            for (int m = 0; m < 4; ++m)
#pragma unroll
                for (int bj = 0; bj < 2; ++bj) hv[ai][m][bj] = *(const u32x4*)(H0 + (size_t)(row0 + ai * HALF + m * 16) * 1024 + col0 + bj * HALF);
        asm volatile("" ::: "memory");
#pragma unroll
        for (int ai = 0; ai < 2; ++ai)
#pragma unroll
            for (int m = 0; m < 4; ++m) { const size_t off = (size_t)(row0 + ai * HALF + m * 16) * 1024 + col0;
#pragma unroll
                for (int bj = 0; bj < 2; ++bj) { const u32x4 hb = hv[ai][m][bj]; const f32x4 a0 = acc[ai][bj][m][0], a1 = acc[ai][bj][m][1];
                    u32x4 w; w.x = cvt_pk_bf16(alpha * bf_lo(hb.x) + a0[0], alpha * bf_hi(hb.x) + a0[1]); w.y = cvt_pk_bf16(alpha * bf_lo(hb.y) + a0[2], alpha * bf_hi(hb.y) + a0[3]);
                    w.z = cvt_pk_bf16(alpha * bf_lo(hb.z) + a1[0], alpha * bf_hi(hb.z) + a1[1]); w.w = cvt_pk_bf16(alpha * bf_lo(hb.w) + a1[2], alpha * bf_hi(hb.w) + a1[3]);
                    *(u32x4*)(T + off + bj * HALF) = w; } }
    }
};
struct EpiGateUp {
    static constexpr bool PERM = true, AFTER_DRAIN = false;
    bf16_t* HID;
    __device__ __forceinline__ void operator()(const f32x4 (&acc)[2][2][4][2], const Unit& u, int wr, int wc, int fr, int fq) const {
        const int row0 = u.pm * BM + wr * 64 + fr, hc = (u.pn & 3) * 128 + wc * 32 + 8 * fq;
#pragma unroll
        for (int ai = 0; ai < 2; ++ai)
#pragma unroll
            for (int m = 0; m < 4; ++m) { float h[8];
#pragma unroll
                for (int n = 0; n < 2; ++n)
#pragma unroll
                    for (int j = 0; j < 4; ++j) { const float g = acc[ai][0][m][n][j], up = acc[ai][1][m][n][j]; h[4 * n + j] = g * up * __builtin_amdgcn_rcpf(1.0f + __expf(-g)); }
                u32x4 w; w.x = cvt_pk_bf16(h[0], h[1]); w.y = cvt_pk_bf16(h[2], h[3]); w.z = cvt_pk_bf16(h[4], h[5]); w.w = cvt_pk_bf16(h[6], h[7]);
                *(u32x4*)(HID + (size_t)(row0 + ai * HALF + m * 16) * 512 + hc) = w; }
    }
};
__device__ __forceinline__ unsigned pk4_fp8(const f32x4 v) { int w = __builtin_amdgcn_cvt_pk_fp8_f32(v[0], v[1], 0, false); w = __builtin_amdgcn_cvt_pk_fp8_f32(v[2], v[3], w, true); return (unsigned)w; }
struct EpiDown {
    static constexpr bool PERM = true, AFTER_DRAIN = false;
    unsigned char* YP; const float* PW;
    __device__ __forceinline__ void operator()(const f32x4 (&acc)[2][2][4][2], const Unit& u, int wr, int wc, int fr, int fq) const {
        const int row0 = u.pm * BM + wr * 64 + fr, col0 = (u.pn & 3) * BM + wc * 64 + 16 * fq;
        float pwv[8];
#pragma unroll
        for (int i = 0; i < 8; ++i) pwv[i] = PW[row0 + (i >> 2) * HALF + (i & 3) * 16];
        asm volatile("" ::: "memory");
#pragma unroll
        for (int ai = 0; ai < 2; ++ai)
#pragma unroll
            for (int m = 0; m < 4; ++m) { const int row = row0 + ai * HALF + m * 16; const float sc = pwv[ai * 4 + m] * 64.0f;
                u32x4 w; w.x = pk4_fp8(acc[ai][0][m][0] * sc); w.y = pk4_fp8(acc[ai][0][m][1] * sc); w.z = pk4_fp8(acc[ai][1][m][0] * sc); w.w = pk4_fp8(acc[ai][1][m][1] * sc);
                *(u32x4*)(YP + (size_t)row * 1024 + col0) = w; }
    }
};
struct OwnPanelOrder {
    int c, ntn;
    __device__ __forceinline__ bool next(int i, Unit& u) const { if (i >= ntn) return false; u.pm = c; u.pn = i; return true; }
    __device__ __forceinline__ void a_ready(const Unit&) const {}
    __device__ __forceinline__ void done(const Unit&) const {}
};
struct GroupedOrder {
    const PG8_LAS int* pp; int nwg, G, c;
    __device__ __forceinline__ void init(const PG8_LAS int* pp_, int G_, int c_) { pp = pp_; nwg = pp_[32] * 4; G = G_; c = c_; }
    __device__ __forceinline__ bool next(int i, Unit& u) const {
        const long L = (long)i * G + c; if (L >= nwg) return false;
        int wgid = (int)L; { const int q = nwg / NXCD, r = nwg % NXCD, xcd = wgid % NXCD, off = wgid / NXCD; wgid = (xcd < r ? xcd * (q + 1) : r * (q + 1) + (xcd - r) * q) + off; }
        const int panel = wgid >> 2; int e = 0;
#pragma unroll
        for (int k = 1; k < 32; ++k) e += (pp[k] <= panel) ? 1 : 0;
        u.pm = panel; u.pn = e * 4 + (wgid & 3); return true;
    }
    __device__ __forceinline__ void a_ready(const Unit&) const {}
    __device__ __forceinline__ void done(const Unit&) const {}
};
__device__ __forceinline__ void gather_off(const int* gidx, int pm, int K, int tid, unsigned (&v0)[2], unsigned (&v1)[2]) {
#pragma unroll
    for (int i = 0; i < 2; ++i) { int R, C; stage_rc(tid * 16 + i * 8192, R, C); v0[i] = (unsigned)(gidx[pm * 256 + R] * K + C) * 2u; v1[i] = (unsigned)(gidx[pm * 256 + 128 + R] * K + C) * 2u; }
}
template <class Epi, class Sched, bool ALIGN_EPI = false, bool SP2 = false, bool GATHER = false>
__device__ __forceinline__ void gemm_phase(PG8_LAS unsigned char* lds, const Gemm g, const Sched& S, const Epi& E) {
    const int tid = threadIdx.x, wid = __builtin_amdgcn_readfirstlane(tid >> 6), lane = tid & 63, wr = wid >> 2, wc = wid & 3, fr = lane & 15, fq = lane >> 4;
    const int K = g.K, nt = K / BK;
    unsigned voffA[2], voffB[2];
#pragma unroll
    for (int i = 0; i < 2; ++i) { int R, C; stage_rc(tid * 16 + i * 8192, R, C); const int Rb = Epi::PERM ? ((R & ~31) + perm32(R & 31)) : R;
        voffA[i] = (unsigned)(R * K + C) * 2u; voffB[i] = (unsigned)(Rb * K + C) * 2u; }
    static_assert(SP2 || !GATHER, "GATHER is written for the SP2 loop");
    unsigned cv0[2] = {0u, 0u}, cv1[2] = {0u, 0u}, nv0[2] = {0u, 0u}, nv1[2] = {0u, 0u};
    const size_t kstep = (size_t)(BK * 2);
    const size_t hstep = (size_t)HALF * K * 2;
    const size_t tstep = 2 * hstep;
    const unsigned ldsw = (unsigned)wid * 1024u;
    const int aoff = lds_byte(wr * 64 + fr, fq * 8), boff = lds_byte(wc * 32 + fr, fq * 8);
#define PG8_SA(b, h) (((b) * 2 + (h)) * HTB)
#define PG8_SB(b, h) ((4 + (b) * 2 + (h)) * HTB)
#define PG8_STAGE(bufoff, gbase, voff) do { _Pragma("unroll") for (int _i = 0; _i < 2; ++_i) \
        __builtin_amdgcn_global_load_lds((const unsigned*)((const char*)(gbase) + (voff)[_i]), (PG8_LAS unsigned*)(lds + (bufoff) + ldsw + _i * 8192), 16, 0, 0); } while (0)
#define PG8_STAGE_A0C(bufoff, gb) do { if constexpr (GATHER) PG8_STAGE(bufoff, gb, cv0); else PG8_STAGE(bufoff, gb, voffA); } while (0)
#define PG8_STAGE_A1C(bufoff, gb) do { if constexpr (GATHER) PG8_STAGE(bufoff, gb, cv1); else PG8_STAGE(bufoff, (gb) + hstep, voffA); } while (0)
#define PG8_STAGE_A0X(bufoff, gb) do { if constexpr (GATHER) PG8_STAGE(bufoff, gb, sv0); else PG8_STAGE(bufoff, gb, voffA); } while (0)
#define PG8_STAGE_A1X(bufoff, gb) do { if constexpr (GATHER) PG8_STAGE(bufoff, gb, sv1); else PG8_STAGE(bufoff, (gb) + hstep, voffA); } while (0)
#define PG8_LDA(dst, b, h) do { _Pragma("unroll") for (int m = 0; m < 4; ++m) _Pragma("unroll") for (int k = 0; k < 2; ++k) dst[m][k] = *(const PG8_LAS bf16x8*)(lds + PG8_SA(b, h) + aoff + m * 2048 + k * 1024); } while (0)
#define PG8_LDB(dst, b, h) do { _Pragma("unroll") for (int n = 0; n < 2; ++n) _Pragma("unroll") for (int k = 0; k < 2; ++k) dst[n][k] = *(const PG8_LAS bf16x8*)(lds + PG8_SB(b, h) + boff + n * 2048 + k * 1024); } while (0)
#define PG8_MMA(ai, bj, At, Bt) do { __builtin_amdgcn_s_setprio(1); _Pragma("unroll") for (int m = 0; m < 4; ++m) _Pragma("unroll") for (int n = 0; n < 2; ++n) _Pragma("unroll") for (int k = 0; k < 2; ++k) \
        acc[ai][bj][m][n] = __builtin_amdgcn_mfma_f32_16x16x32_bf16(Bt[n][k], At[m][k], acc[ai][bj][m][n], 0, 0, 0); __builtin_amdgcn_s_setprio(0); } while (0)
#define PG8_WAIT_V(n) asm volatile("s_waitcnt vmcnt(" #n ")" ::: "memory")
#define PG8_WAIT_L(n) asm volatile("s_waitcnt lgkmcnt(" #n ")" ::: "memory")
#define PG8_BAR __builtin_amdgcn_s_barrier()
#define PG8_SCHED __builtin_amdgcn_sched_barrier(0)
    Unit cur, nxt; int ui = 0;
    if (!S.next(0, cur)) return;
    f32x4 acc[2][2][4][2];
#pragma unroll
    for (int a = 0; a < 2; ++a)
#pragma unroll
        for (int b = 0; b < 2; ++b)
#pragma unroll
            for (int m = 0; m < 4; ++m)
#pragma unroll
                for (int n = 0; n < 2; ++n) acc[a][b][m][n] = (f32x4){0.f, 0.f, 0.f, 0.f};
    bf16x8 At[4][2], B0[2][2], B1[2][2];
    const char* cA = (const char*)g.A + (GATHER ? (size_t)0 : (size_t)cur.pm * tstep); const char* cB = (const char*)g.Bt + (size_t)cur.pn * tstep;
    if constexpr (GATHER) gather_off(g.gidx, cur.pm, K, tid, cv0, cv1);
    S.a_ready(cur);
    if constexpr (SP2) {
        PG8_STAGE(PG8_SB(0, 0), cB, voffB); PG8_STAGE(PG8_SB(0, 1), cB + hstep, voffB); PG8_STAGE_A0C(PG8_SA(0, 0), cA); PG8_STAGE_A1C(PG8_SA(0, 1), cA);
        if (wr == 1) PG8_BAR;
        PG8_WAIT_V(2); PG8_BAR;
        PG8_STAGE(PG8_SB(1, 0), cB + kstep, voffB); PG8_STAGE_A0C(PG8_SA(1, 0), cA + kstep); PG8_STAGE(PG8_SB(1, 1), cB + hstep + kstep, voffB);
        PG8_WAIT_V(6); PG8_BAR;
    } else {
        PG8_STAGE(PG8_SB(0, 0), cB, voffB); PG8_STAGE(PG8_SA(0, 0), cA, voffA); PG8_STAGE(PG8_SB(0, 1), cB + hstep, voffB); PG8_STAGE(PG8_SA(0, 1), cA + hstep, voffA);
        if (wr == 1) PG8_BAR;
        PG8_WAIT_V(4); PG8_BAR;
        PG8_STAGE(PG8_SB(1, 0), cB + kstep, voffB); PG8_STAGE(PG8_SA(1, 0), cA + kstep, voffA); PG8_STAGE(PG8_SB(1, 1), cB + hstep + kstep, voffB);
        PG8_WAIT_V(6); PG8_BAR;
    }
    for (;;) {
        const bool has_next = S.next(ui + 1, nxt);
        if constexpr (GATHER) { if (has_next) gather_off(g.gidx, nxt.pm, K, tid, nv0, nv1); else { nv0[0] = cv0[0]; nv0[1] = cv0[1]; nv1[0] = cv1[0]; nv1[1] = cv1[1]; } }
        const char* nA = GATHER ? cA : (has_next ? (const char*)g.A + (size_t)nxt.pm * tstep : cA); const char* nB = has_next ? (const char*)g.Bt + (size_t)nxt.pn * tstep : cB;
        for (int t = 0; t < nt; t += 2) {
            const bool last = (t == nt - 2);
            const char* a1 = cA + (size_t)(t + 1) * kstep;
            const char* a2 = last ? nA : cA + (size_t)(t + 2) * kstep; const char* b2 = last ? nB : cB + (size_t)(t + 2) * kstep;
            const char* a3 = a2 + kstep; const char* b3 = b2 + kstep;
            if (last && has_next) S.a_ready(nxt);
            unsigned sv0[2], sv1[2]; sv0[0] = last ? nv0[0] : cv0[0]; sv0[1] = last ? nv0[1] : cv0[1]; sv1[0] = last ? nv1[0] : cv1[0]; sv1[1] = last ? nv1[1] : cv1[1];
            if constexpr (SP2) {
            PG8_LDB(B0, 0, 0); PG8_LDB(B1, 0, 1); PG8_SCHED; PG8_LDA(At, 0, 0); PG8_STAGE_A1C(PG8_SA(1, 1), a1);
            PG8_WAIT_V(8); PG8_WAIT_L(0); PG8_BAR; PG8_MMA(0, 0, At, B0); PG8_MMA(0, 1, At, B1); PG8_BAR; PG8_SCHED;
            PG8_LDA(At, 0, 1); PG8_STAGE(PG8_SB(0, 0), b2, voffB); PG8_STAGE(PG8_SB(0, 1), b2 + hstep, voffB); PG8_STAGE_A0X(PG8_SA(0, 0), a2);
            PG8_WAIT_V(8); PG8_WAIT_L(0); PG8_BAR; PG8_MMA(1, 0, At, B0); PG8_MMA(1, 1, At, B1); PG8_BAR; PG8_SCHED;
            PG8_LDB(B0, 1, 0); PG8_LDB(B1, 1, 1); PG8_SCHED; PG8_LDA(At, 1, 0); PG8_STAGE_A1X(PG8_SA(0, 1), a2);
            PG8_WAIT_V(8); PG8_WAIT_L(0); PG8_BAR; PG8_MMA(0, 0, At, B0); PG8_MMA(0, 1, At, B1); PG8_BAR; PG8_SCHED;
            PG8_LDA(At, 1, 1); PG8_STAGE(PG8_SB(1, 0), b3, voffB); PG8_STAGE(PG8_SB(1, 1), b3 + hstep, voffB); PG8_STAGE_A0X(PG8_SA(1, 0), a3);
            PG8_WAIT_V(8); PG8_WAIT_L(0); PG8_BAR; PG8_MMA(1, 0, At, B0); PG8_MMA(1, 1, At, B1); PG8_BAR; PG8_SCHED;
            } else {
            PG8_LDB(B0, 0, 0); PG8_SCHED; PG8_LDA(At, 0, 0); PG8_STAGE(PG8_SA(1, 1), a1 + hstep, voffA);
            PG8_WAIT_L(8); PG8_BAR; PG8_WAIT_L(0); PG8_MMA(0, 0, At, B0); PG8_BAR; PG8_SCHED;
            PG8_LDB(B1, 0, 1); PG8_STAGE(PG8_SB(0, 0), b2, voffB);
            PG8_BAR; PG8_WAIT_L(0); PG8_MMA(0, 1, At, B1); PG8_BAR;
            PG8_LDA(At, 0, 1); PG8_STAGE(PG8_SA(0, 0), a2, voffA);
            PG8_BAR; PG8_WAIT_L(0); PG8_MMA(1, 0, At, B0); PG8_BAR; PG8_SCHED;
            PG8_STAGE(PG8_SB(0, 1), b2 + hstep, voffB);
            PG8_WAIT_V(6); PG8_BAR; PG8_MMA(1, 1, At, B1); PG8_BAR;
            PG8_LDB(B0, 1, 0); PG8_SCHED; PG8_LDA(At, 1, 0); PG8_STAGE(PG8_SA(0, 1), a2 + hstep, voffA);
            PG8_WAIT_L(8); PG8_BAR; PG8_WAIT_L(0); PG8_MMA(0, 0, At, B0); PG8_BAR; PG8_SCHED;
            PG8_LDB(B1, 1, 1); PG8_STAGE(PG8_SB(1, 0), b3, voffB);
            PG8_BAR; PG8_WAIT_L(0); PG8_MMA(0, 1, At, B1); PG8_BAR;
            PG8_LDA(At, 1, 1); PG8_STAGE(PG8_SA(1, 0), a3, voffA);
            PG8_BAR; PG8_WAIT_L(0); PG8_MMA(1, 0, At, B0); PG8_BAR; PG8_SCHED;
            PG8_STAGE(PG8_SB(1, 1), b3 + hstep, voffB);
            PG8_WAIT_V(6); PG8_BAR; PG8_MMA(1, 1, At, B1); PG8_BAR;
            }
        }
        if constexpr (ALIGN_EPI) { if (wr == 0) PG8_BAR; }
        if constexpr (!Epi::AFTER_DRAIN) { E(acc, cur, wr, wc, fr, fq); S.done(cur); }
        if (!has_next) break;
#pragma unroll
        for (int a = 0; a < 2; ++a)
#pragma unroll
            for (int b = 0; b < 2; ++b)
#pragma unroll
                for (int m = 0; m < 4; ++m)
#pragma unroll
                    for (int n = 0; n < 2; ++n) acc[a][b][m][n] = (f32x4){0.f, 0.f, 0.f, 0.f};
        cur = nxt; cA = nA; cB = nB; ++ui;
        if constexpr (GATHER) { cv0[0] = nv0[0]; cv0[1] = nv0[1]; cv1[0] = nv1[0]; cv1[1] = nv1[1]; }
        if constexpr (ALIGN_EPI) { if (wr == 1) PG8_BAR; }
    }
    PG8_WAIT_V(0);
    if constexpr (!ALIGN_EPI) { if (wr == 0) PG8_BAR; }
    PG8_BAR;
    if constexpr (Epi::AFTER_DRAIN) { E.fused(acc, cur, wr, wc, fr, fq, lds, wid, lane); S.done(cur); }
#undef PG8_SA
#undef PG8_SB
#undef PG8_STAGE
#undef PG8_LDA
#undef PG8_STAGE_A0C
#undef PG8_STAGE_A1C
#undef PG8_STAGE_A0X
#undef PG8_STAGE_A1X
#undef PG8_LDB
#undef PG8_MMA
#undef PG8_WAIT_V
#undef PG8_WAIT_L
#undef PG8_BAR
#undef PG8_SCHED
}
}

constexpr int NWAVES = 8;
constexpr int N_LAUNCHES = MK_N_LAUNCHES;
constexpr int PER_PHASE = 10;

constexpr int BATCH = 16, SEQ = 4096, D = 1024, NMETA = 16;
constexpr int M = BATCH * SEQ;
constexpr int NPROJ = 2048, NEXP = 32, DEXP = 512;
constexpr int NPANEL_MAX = 544, SLOTS = NPANEL_MAX * 256;
constexpr float LN_EPS = 1e-5f, GN_EPS = 1e-6f;
constexpr float ALPHA = 1.189207115002721f;

constexpr size_t MiB = 1u << 20;
constexpr size_t WS_CTL = 0, CTL_ZERO_BYTES = 1 * MiB;
constexpr size_t WS_WIN = 2 * MiB;
constexpr size_t WS_WOUT = 6 * MiB;
constexpr size_t WS_WPOOL = 8 * MiB;
constexpr size_t WS_RW = 8 * MiB + 256 * 1024;
constexpr size_t WS_METAK = 8 * MiB + 512 * 1024;
constexpr size_t WS_METAV = WS_METAK + 16 * 256 * 4;
constexpr size_t WS_METAU = WS_METAV + 16 * 512 * 4;
constexpr size_t WS_ROPE = 9 * MiB;
constexpr size_t WS_TOKE = 12 * MiB;
constexpr size_t WS_TOKL = WS_TOKE + (size_t)M * 4;
constexpr size_t WS_TOKW = WS_TOKL + (size_t)M * 4;
constexpr size_t WS_TOKS = WS_TOKW + (size_t)M * 8;
constexpr size_t WS_CNT = 14 * MiB;
constexpr size_t WS_PW = 15 * MiB;
constexpr size_t WS_STOK = 16 * MiB;
constexpr size_t WS_WGU = 32 * MiB;
constexpr size_t WS_WD = 96 * MiB;
constexpr size_t WS_ST = 128 * MiB;
constexpr size_t WS_H0 = 160 * MiB;
constexpr size_t WS_Q = 288 * MiB, WS_K = 320 * MiB;
constexpr size_t WS_V = 352 * MiB, WS_GATE = 416 * MiB, WS_U = 480 * MiB;
constexpr size_t WS_MIXIN = 544 * MiB;
constexpr size_t WS_T1 = 672 * MiB;
constexpr size_t WS_H1B = 288 * MiB;
constexpr size_t WS_HID = 688 * MiB;
constexpr size_t WS_YP = 416 * MiB;
constexpr size_t WS_END = 928 * MiB;
static_assert(WS_ROPE + (size_t)4112 * 32 * 8 <= WS_TOKE && WS_TOKS + (size_t)M * 8 <= WS_CNT && WS_PW + (size_t)SLOTS * 4 <= WS_WGU, "small tables");
static_assert(WS_K == WS_Q + (size_t)M * 256 * 2 && WS_GATE == WS_V + (size_t)M * 512 * 2 && WS_U == WS_GATE + (size_t)M * 512 * 2, "EpiProj addresses K, gate, u relative to Q, V");
static_assert(WS_STOK + (size_t)SLOTS * 4 <= WS_WGU && WS_YP + (size_t)SLOTS * 1024 <= WS_HID && WS_HID + (size_t)SLOTS * 512 * 2 <= WS_END && WS_T1 + (size_t)M * 1024 * 2 <= WS_END, "d_ws map");
constexpr int CW_BAR = 4096;

constexpr int RING_OFF = 0, RING_BYTES = 131072;
constexpr int LDSCTL_OFF = RING_BYTES;
constexpr int PP_OFF = LDSCTL_OFF, TOT_OFF = LDSCTL_OFF + 192, BEF_OFF = LDSCTL_OFF + 320, BASE_OFF = LDSCTL_OFF + 448, LCNT_OFF = LDSCTL_OFF + 576, MISC_OFF = LDSCTL_OFF + 768;
constexpr int LDS_BYTES = 147456;
static_assert(MISC_OFF + 128 <= LDS_BYTES, "LDS map");
#define GAS __attribute__((address_space(1)))
#define LAS __attribute__((address_space(3)))
typedef unsigned short bf16;
typedef unsigned v4u __attribute__((ext_vector_type(4)));
typedef float f32x4 __attribute__((ext_vector_type(4)));
typedef short bf16x8 __attribute__((ext_vector_type(8)));
typedef GAS unsigned gu32;
typedef GAS unsigned long long gu64;
#define RLX_AGENT __ATOMIC_RELAXED, __HIP_MEMORY_SCOPE_AGENT
#define LDS_WAIT() asm volatile("s_waitcnt lgkmcnt(0)" ::: "memory")
#define VM_WAIT() asm volatile("s_waitcnt vmcnt(0)" ::: "memory")
__device__ __forceinline__ unsigned long long rt() { return __builtin_amdgcn_s_memrealtime(); }
__device__ __forceinline__ unsigned f2bf(float f) { unsigned u = __builtin_bit_cast(unsigned, f); return (u + 0x7fffu + ((u >> 16) & 1u)) >> 16; }
__device__ __forceinline__ unsigned pk2(float lo, float hi) { return f2bf(lo) | (f2bf(hi) << 16); }

#define XB_TMO      128
#define XB_XCNT(j)  (256  + 64 * (j))
#define XB_XSUB(j)  (1280 + 64 * (j))
#define XB_XGEN(j)  (2304 + 64 * (j))
#define XB_TOP      3328
#define XB_TOPGEN   3392
#define XCD_BAR_WORDS 3456
#define XB_SPIN_CAP (1u << 18)

__device__ __forceinline__ unsigned xb_ld(unsigned* p)              { return __hip_atomic_load(p, __ATOMIC_RELAXED, __HIP_MEMORY_SCOPE_AGENT); }
__device__ __forceinline__ unsigned xb_add(unsigned* p, unsigned v) { return __hip_atomic_fetch_add(p, v, __ATOMIC_RELAXED, __HIP_MEMORY_SCOPE_AGENT); }
__device__ __forceinline__ unsigned xb_xcc_id() { return (unsigned)__builtin_amdgcn_s_getreg((3 << 11) | 20) & 0xFu; }
#define XB_SPIN(cond, bar) do { unsigned _sp = 0; while (cond) { __builtin_amdgcn_s_sleep(1); \
    if ((++_sp & 255u) == 0u) { if (xb_ld(&(bar)[XB_TMO])) break; if (_sp > XB_SPIN_CAP) { atomicAdd(&(bar)[XB_TMO], 1u); break; } } } } while (0)

struct XcdBarrier {
    unsigned* bar; unsigned x;
    volatile LAS unsigned* st;
};

__device__ __forceinline__ XcdBarrier xcd_barrier_post(unsigned* bar, volatile LAS unsigned* st) {
    XcdBarrier b; b.bar = bar; b.x = xb_xcc_id(); b.st = st;
    if (threadIdx.x == 0) (void)xb_add(&bar[XB_XCNT(b.x)], 1u);
    return b;
}
__device__ __forceinline__ void xcd_barrier_complete(unsigned* bar, unsigned x, unsigned& nloc, unsigned& nx) {
    const unsigned G = gridDim.x * gridDim.y * gridDim.z;
    unsigned sum, cnt, mine, sp = 0u;
    for (;;) {
        sum = 0u; cnt = 0u; mine = 0u;
#pragma unroll
        for (unsigned j = 0; j < 16; ++j) { const unsigned c = xb_ld(&bar[XB_XCNT(j)]); sum += c; cnt += (c > 0u) ? 1u : 0u; mine = (j == x) ? c : mine; }
        if (sum == G) break;
        __builtin_amdgcn_s_sleep(1);
        if ((++sp & 255u) == 0u) { if (xb_ld(&bar[XB_TMO])) break; if (sp > XB_SPIN_CAP) { atomicAdd(&bar[XB_TMO], 1u); break; } }
    }
    nloc = mine > 0u ? mine : 1u; nx = cnt > 0u ? cnt : 1u;
}

__device__ __forceinline__ void xcd_barrier(const XcdBarrier& b) {
    asm volatile("s_waitcnt vmcnt(0)" ::: "memory");
    __syncthreads();
    if (threadIdx.x == 0) {
        unsigned* bar = b.bar;
        __builtin_amdgcn_s_waitcnt(0);
        unsigned nloc = b.st[0], nx = b.st[1];
        if (nloc == 0u) { xcd_barrier_complete(bar, b.x, nloc, nx); b.st[0] = nloc; b.st[1] = nx; }
        const unsigned old = xb_add(&bar[XB_XSUB(b.x)], 1u);
        const unsigned gen = old / nloc;
        if (old + 1u == (gen + 1u) * nloc) {
            __builtin_amdgcn_fence(__ATOMIC_RELEASE, "agent");
            asm volatile("s_waitcnt vmcnt(0)" ::: "memory");
            const unsigned og = xb_add(&bar[XB_TOP], 1u);
            const unsigned tg = og / nx;
            if (og + 1u == (tg + 1u) * nx) xb_add(&bar[XB_TOPGEN], 1u);
            else XB_SPIN(xb_ld(&bar[XB_TOPGEN]) == tg, bar);
            __builtin_amdgcn_fence(__ATOMIC_ACQUIRE, "agent");
            xb_add(&bar[XB_XGEN(b.x)], 1u);
            asm volatile("s_waitcnt vmcnt(0)" ::: "memory");
        } else {
            XB_SPIN(xb_ld(&bar[XB_XGEN(b.x)]) == gen, bar);
            __builtin_amdgcn_fence(__ATOMIC_ACQUIRE, "agent");
            asm volatile("s_waitcnt vmcnt(0)" ::: "memory");
        }
    }
    __syncthreads();
}

#define DI __device__ __forceinline__
typedef short v4i16_t __attribute__((ext_vector_type(4)));
typedef unsigned u32x2 __attribute__((ext_vector_type(2)));
typedef float f32x2 __attribute__((ext_vector_type(2)));
struct Frame {
    LAS unsigned char* lds;
    volatile LAS unsigned* MISC;
    gu32* ctl;
    int tid, lane, wave;
    int vcu, G;
    const float *x, *meta, *lne_g, *lne_b, *w_in, *pool_w, *pool_b, *pool_scale, *w_out, *ln1_g, *ln1_b, *rg_w, *rg_b, *re_w, *re_b, *w_gate, *w_up, *w_down, *ln2_g, *ln2_b;
    float* out;
    bf16 *Win_t, *Wout_t, *Wpool_t, *Wgu_t, *Wd_t;
    float *RW, *metak, *metav, *metau, *rope, *PW; bf16* T1;
    unsigned *toke, *tokl; f32x2* tokw; int* toks; int* cnt; int* stok;
    bf16 *ST, *H0, *Qb, *Kb, *Vb, *Gb, *Ub, *MIXIN, *H1B, *HID; unsigned char* YP;
};
DI float wave_sum(float v) {
#pragma unroll
    for (int o = 1; o < 64; o <<= 1) v += __shfl_xor(v, o);
    return v;
}
DI float bf2f(bf16 v) { return __uint_as_float(((unsigned)v) << 16); }
DI float bflo(unsigned w) { return __uint_as_float(w << 16); }
DI float bfhi(unsigned w) { return __uint_as_float(w & 0xffff0000u); }
DI unsigned cvtpk(float lo, float hi) { return pg8::cvt_pk_bf16(lo, hi); }

template <int MODE> DI int rowmap(int n) {
    if (MODE == 1) { if (n < 512) { const int i = n & 63; return (n & ~63) + (i < 32 ? 2 * i : 2 * (i - 32) + 1); } return n; }
    if (MODE == 2) return 256 * (n >> 7) + (n & 127);
    if (MODE == 3) return 256 * (n >> 7) + 128 + (n & 127);
    if (MODE == 4) { const int o = n & 255; return (n & ~255) + 128 * ((o >> 3) & 1) + 32 * (o >> 6) + 8 * ((o >> 4) & 3) + (o & 7); }
    return n;
}
template <int MODE> DI void p0_transpose_item(const float* W, int K, int N, bf16* WT, LAS float* scr, int item, int lane) {
    const int nblk = N / 32, kb = item / nblk, nb = item % nblk, k0 = 64 * kb, n0 = 32 * nb;
    f32x4 tv[8];
#pragma unroll
    for (int i = 0; i < 8; ++i) tv[i] = *(const GAS f32x4*)(W + (size_t)(k0 + i * 8 + (lane >> 3)) * N + n0 + 4 * (lane & 7));
#pragma unroll
    for (int i = 0; i < 8; ++i) { LAS float* d = scr + (i * 8 + (lane >> 3)) * 33 + 4 * (lane & 7); d[0] = tv[i].x; d[1] = tv[i].y; d[2] = tv[i].z; d[3] = tv[i].w; }
    LDS_WAIT(); asm volatile("" ::: "memory");
    const int c = lane & 7;
#pragma unroll
    for (int j = 0; j < 4; ++j) { const int n = (lane >> 3) + 8 * j; const LAS float* s = scr + (8 * c) * 33 + n;
        v4u o; o.x = pk2(s[0 * 33], s[1 * 33]); o.y = pk2(s[2 * 33], s[3 * 33]); o.z = pk2(s[4 * 33], s[5 * 33]); o.w = pk2(s[6 * 33], s[7 * 33]);
        *(GAS v4u*)(WT + (size_t)rowmap<MODE>(n0 + n) * K + k0 + 8 * c) = o; }
    LDS_WAIT(); asm volatile("" ::: "memory");
}
DI void ld_row(const float* xrow, f32x4 (&v)[4], int lane) {
    const GAS f32x4* xr = (const GAS f32x4*)xrow + lane;
#pragma unroll
    for (int j = 0; j < 4; ++j) v[j] = xr[64 * j];
}
DI void ln_regs(const f32x4 (&gv)[4], const f32x4 (&bv)[4], f32x4 (&v)[4], float eps) {
    float s = 0.f;
#pragma unroll
    for (int j = 0; j < 4; ++j) s += (v[j].x + v[j].y) + (v[j].z + v[j].w);
    const float mean = wave_sum(s) * (1.f / D); float s2 = 0.f;
#pragma unroll
    for (int j = 0; j < 4; ++j) { v[j] = v[j] - mean; s2 += (v[j].x * v[j].x + v[j].y * v[j].y) + (v[j].z * v[j].z + v[j].w * v[j].w); }
    const float rstd = 1.f / sqrtf(wave_sum(s2) * (1.f / D) + eps);
#pragma unroll
    for (int j = 0; j < 4; ++j) v[j] = v[j] * rstd * gv[j] + bv[j];
}
DI void ln_row(const float* xrow, const f32x4 (&gv)[4], const f32x4 (&bv)[4], f32x4 (&v)[4], int lane, float eps) { ld_row(xrow, v, lane); ln_regs(gv, bv, v, eps); }
DI void store_row_bf16(bf16* orow, const f32x4 (&v)[4], int lane) {
    GAS unsigned long long* o8 = (GAS unsigned long long*)orow + lane;
#pragma unroll
    for (int j = 0; j < 4; ++j) o8[64 * j] = (unsigned long long)pk2(v[j].x, v[j].y) | ((unsigned long long)pk2(v[j].z, v[j].w) << 32);
}
DI void p0_prologue(Frame& F) {
    LAS float* scr = (LAS float*)(F.lds + RING_OFF + F.wave * 16384);
    const int gw = F.vcu * NWAVES + F.wave, NGW = F.G * NWAVES;
    constexpr int I_IN = 16 * 64, I_OUT = 16 * 32, I_POOL = 4 * 8, I_G = 32 * 256, I_U = 32 * 256, I_D = 32 * 256;
    constexpr int NITEMS = I_IN + I_OUT + I_POOL + I_G + I_U + I_D;
    for (int it = gw; it < NITEMS; it += NGW) {
        int r = it;
        if (r < I_IN) { p0_transpose_item<1>(F.w_in, 1024, 2048, F.Win_t, scr, r, F.lane); continue; } r -= I_IN;
        if (r < I_OUT) { p0_transpose_item<0>(F.w_out, 1024, 1024, F.Wout_t, scr, r, F.lane); continue; } r -= I_OUT;
        if (r < I_POOL) { const int g = r >> 3; p0_transpose_item<0>(F.pool_w + g * 16384, 128, 128, F.Wpool_t + g * 16384, scr, r & 7, F.lane); continue; } r -= I_POOL;
        if (r < I_G) { const int e = r >> 8; p0_transpose_item<2>(F.w_gate + (size_t)e * 524288, 1024, 512, F.Wgu_t + (size_t)e * 1048576, scr, r & 255, F.lane); continue; } r -= I_G;
        if (r < I_U) { const int e = r >> 8; p0_transpose_item<3>(F.w_up + (size_t)e * 524288, 1024, 512, F.Wgu_t + (size_t)e * 1048576, scr, r & 255, F.lane); continue; } r -= I_U;
        { const int e = r >> 8; p0_transpose_item<4>(F.w_down + (size_t)e * 524288, 512, 1024, F.Wd_t + (size_t)e * 524288, scr, r & 255, F.lane); }
    }
    { f32x4 gv[4], bv[4];
#pragma unroll
      for (int j = 0; j < 4; ++j) { gv[j] = *(const f32x4*)(F.lne_g + 4 * F.lane + 256 * j); bv[j] = *(const f32x4*)(F.lne_b + 4 * F.lane + 256 * j); }
      f32x4 nx[4], ny[4]; ld_row(F.x + (size_t)gw * D, nx, F.lane); ld_row(F.x + (size_t)(gw + NGW) * D, ny, F.lane);
      for (int m = gw; m < M; m += NGW) { f32x4 v[4];
#pragma unroll
          for (int j = 0; j < 4; ++j) { v[j] = nx[j]; nx[j] = ny[j]; }
          if (m + 2 * NGW < M) ld_row(F.x + (size_t)(m + 2 * NGW) * D, ny, F.lane);
          ln_regs(gv, bv, v, LN_EPS); store_row_bf16(F.H0 + (size_t)m * D, v, F.lane); }
    }
    { const int gt = gw * 64 + F.lane, NT = NGW * 64;
      for (int idx = gt; idx < 4112 * 32; idx += NT) { const int pos = idx >> 5, i = idx & 31;
          const float inv = exp2f(-(float)i * 0.415241011860920f);
          const float ang = (float)pos * inv;
          const double a = (double)ang; const double k = __builtin_rint(a * 0.15915494309189535); const float rr = (float)__builtin_fma(-k, 6.283185307179586, a);
          F.rope[(size_t)idx * 2] = cosf(rr); F.rope[(size_t)idx * 2 + 1] = sinf(rr); }
      for (int idx = gt; idx < 36 * 1024; idx += NT) { const int c = idx >> 10, k = idx & 1023; F.RW[idx] = c < 4 ? F.rg_w[k * 4 + c] : F.re_w[k * 32 + (c - 4)]; }
    }
    if (blockIdx.x < 20) {
        __syncthreads();
        LAS float* ML = (LAS float*)(F.lds);
        LAS float* RED = (LAS float*)(F.lds + 65536);
        LAS float* OUTM = (LAS float*)(F.lds + 98304);
        { f32x4 gv[4], bv[4];
#pragma unroll
          for (int j = 0; j < 4; ++j) { gv[j] = *(const f32x4*)(F.lne_g + 4 * F.lane + 256 * j); bv[j] = *(const f32x4*)(F.lne_b + 4 * F.lane + 256 * j); }
          for (int rr = 0; rr < 2; ++rr) { const int m = F.wave * 2 + rr; f32x4 v[4]; ln_row(F.meta + (size_t)m * D, gv, bv, v, F.lane, LN_EPS);
#pragma unroll
              for (int j = 0; j < 4; ++j) *(LAS f32x4*)(ML + m * 1024 + 4 * F.lane + 256 * j) = v[j]; } }
        __syncthreads();
        const int item = blockIdx.x;
        const int col0 = item < 4 ? 256 + 64 * item : (item < 12 ? 512 + 64 * (item - 4) : 1536 + 64 * (item - 12));
        float acc[16];
#pragma unroll
        for (int m = 0; m < 16; ++m) acc[m] = 0.f;
        for (int kk = 0; kk < 128; ++kk) { const int k = F.wave * 128 + kk; const float wv = F.w_in[(size_t)k * 2048 + col0 + F.lane];
#pragma unroll
            for (int m = 0; m < 16; ++m) acc[m] += ML[m * 1024 + k] * wv; }
#pragma unroll
        for (int m = 0; m < 16; ++m) RED[(F.wave * 16 + m) * 64 + F.lane] = acc[m];
        __syncthreads();
        for (int o = F.tid; o < 1024; o += 512) { float s = 0.f;
#pragma unroll
            for (int w = 0; w < 8; ++w) s += RED[w * 1024 + o];
            OUTM[o] = s; }
        __syncthreads();
        for (int o = F.tid; o < 1024; o += 512) { const int m = o >> 6, ii = o & 63;
            if (item < 4) {
                const int i = ii >> 1; const float x1 = OUTM[m * 64 + i], x2 = OUTM[m * 64 + 32 + i];
                const float inv = exp2f(-(float)i * 0.415241011860920f); const float ang = (float)m * inv;
                const double a = (double)ang; const double kq = __builtin_rint(a * 0.15915494309189535); const float rr = (float)__builtin_fma(-kq, 6.283185307179586, a);
                const float cs = cosf(rr), sn = sinf(rr);
                F.metak[m * 256 + item * 64 + ii] = ((ii & 1) ? (x1 * sn + x2 * cs) : (x1 * cs - x2 * sn)) * 0.125f;
            } else if (item < 12) F.metav[m * 512 + (item - 4) * 64 + ii] = OUTM[o];
            else F.metau[m * 512 + (item - 12) * 64 + ii] = OUTM[o];
        }
        __syncthreads();
    }
}

DI f32x4 mma(bf16x8 xf, bf16x8 yf, f32x4 acc) { return __builtin_amdgcn_mfma_f32_16x16x32_bf16(xf, yf, acc, 0, 0, 0); }
DI bf16x8 frag_row(const LAS unsigned char* base, int stride, int row0, int k0, int lane) {
    return *(const LAS bf16x8*)(base + (row0 + (lane & 15)) * stride + (k0 + 8 * (lane >> 4)) * 2);
}
DI bf16x8 frag_tr(const LAS unsigned char* base, int stride, int k0, int x0, int lane) {
    const int g = lane >> 4, q = (lane & 15) >> 2, p = lane & 3;
    const LAS unsigned char* a = base + (k0 + 8 * g + q) * stride + (x0 + 4 * p) * 2;
    const v4i16_t lo = __builtin_amdgcn_ds_read_tr16_b64_v4i16((LAS v4i16_t*)a);
    const v4i16_t hi = __builtin_amdgcn_ds_read_tr16_b64_v4i16((LAS v4i16_t*)(a + 4 * stride));
    return __builtin_shufflevector(lo, hi, 0, 1, 2, 3, 4, 5, 6, 7);
}
constexpr int SQ = 144, SV = 272;
DI v4u scale8(v4u x, float z) { v4u o;
#pragma unroll
    for (int p = 0; p < 4; ++p) o[p] = cvtpk(bflo(x[p]) * z, bfhi(x[p]) * z);
    return o; }
DI void p2_scan(Frame& F) {
    constexpr int SVS = 80;
    LAS unsigned char* KS = F.lds; LAS unsigned char* VSL = F.lds + 18432;
    const int w = F.wave, lane = F.lane, fr = lane & 15, fq = lane >> 4, dt = w >> 1, vt = w & 1;
    for (int unit = blockIdx.x; unit < 256; unit += F.G) {
        const int b = unit >> 4, h = (unit >> 2) & 3, vs = unit & 3;
        const float lg = log2f(1.0f - exp2f(-5.0f - (float)h));
        const float cd = exp2f(128.0f * lg);
        const int kr0 = F.tid >> 3, kc8 = F.tid & 7, vr = F.tid >> 2, vc4 = F.tid & 3;
        const float z0 = exp2f((float)(127 - kr0) * lg), z1 = exp2f((float)(63 - kr0) * lg);
        const int d0 = 16 * dt + 4 * fq, vcol = vs * 32 + 16 * vt + fr;
        f32x4 st = {0.f, 0.f, 0.f, 0.f};
        for (int m = 0; m < 16; ++m) { const float zm = exp2f((float)(15 - m) * lg) * F.metav[m * 512 + h * 128 + vcol]; const f32x4 kk = *(const f32x4*)(F.metak + m * 256 + h * 64 + d0); st = st + kk * zm; }
        bf16* STb = F.ST + (size_t)((b * 4 + h) * 32) * 8192 + vcol * 64 + d0;
        const bf16* kp = F.Kb + ((size_t)b * 4096 + kr0) * 256 + h * 64 + kc8 * 8; const bf16* vp = F.Vb + ((size_t)b * 4096 + vr) * 512 + h * 128 + vs * 32 + vc4 * 8;
        v4u rk0[4], rk1[4], rvv[4];
#pragma unroll
        for (int u = 0; u < 4; ++u) { const size_t o = (size_t)u * 128; rk0[u] = *(const GAS v4u*)(kp + o * 256); rk1[u] = *(const GAS v4u*)(kp + (o + 64) * 256); rvv[u] = *(const GAS v4u*)(vp + o * 512); }
        for (int n0 = 0; n0 < 32; n0 += 4) {
#pragma unroll
            for (int u = 0; u < 4; ++u) { const int n = n0 + u;
                { u32x2 pk; pk.x = cvtpk(st[0], st[1]); pk.y = cvtpk(st[2], st[3]); *(GAS u32x2*)(STb + (size_t)n * 8192) = pk; }
                if (n < 31) {
                    __syncthreads();
                    *(LAS v4u*)(KS + kr0 * SQ + kc8 * 16) = scale8(rk0[u], z0); *(LAS v4u*)(KS + (kr0 + 64) * SQ + kc8 * 16) = scale8(rk1[u], z1);
                    *(LAS v4u*)(VSL + vr * SVS + vc4 * 16) = rvv[u];
                    __syncthreads();
                    if (n + 4 < 31) { const size_t o = (size_t)(n + 4) * 128; rk0[u] = *(const GAS v4u*)(kp + o * 256); rk1[u] = *(const GAS v4u*)(kp + (o + 64) * 256); rvv[u] = *(const GAS v4u*)(vp + o * 512); }
                    f32x4 a = {0.f, 0.f, 0.f, 0.f};
#pragma unroll
                    for (int kk = 0; kk < 4; ++kk) a = mma(frag_tr(KS, SQ, 32 * kk, 16 * dt, lane), frag_tr(VSL, SVS, 32 * kk, 16 * vt, lane), a);
                    st = st * cd + a;
                }
            }
        }
    }
    __syncthreads();
}

struct RetRegs { v4u q[2], k[2], s[2], v[4]; u32x2 g[8]; };
DI void ret_fetch(const Frame& F, RetRegs& r, int b, int h, int nn) {
    const size_t R0 = (size_t)b * 4096 + (size_t)nn * 128;
#pragma unroll
    for (int i = 0; i < 2; ++i) { const int ch = F.tid + 512 * i, rw = ch >> 3, c8 = ch & 7;
        r.q[i] = *(const GAS v4u*)(F.Qb + (R0 + rw) * 256 + h * 64 + c8 * 8); r.k[i] = *(const GAS v4u*)(F.Kb + (R0 + rw) * 256 + h * 64 + c8 * 8);
        r.s[i] = *(const GAS v4u*)(F.ST + (size_t)((b * 4 + h) * 32 + nn) * 8192 + rw * 64 + c8 * 8); }
#pragma unroll
    for (int i = 0; i < 4; ++i) { const int ch = F.tid + 512 * i, rw = ch >> 4, c16 = ch & 15; r.v[i] = *(const GAS v4u*)(F.Vb + (R0 + rw) * 512 + h * 128 + c16 * 8); }
    { const bf16* grow = F.Gb + (R0 + 16 * F.wave + (F.lane & 15)) * 512 + h * 128 + 4 * (F.lane >> 4);
#pragma unroll
      for (int vt = 0; vt < 8; ++vt) r.g[vt] = *(const GAS u32x2*)(grow + 16 * vt); }
}
DI void ret_compute(Frame& F, int b, int h, int nn, float lg, const u32x2 (&gb)[8]) {
    LAS unsigned char* QS = F.lds; LAS unsigned char* KS = F.lds + 18432; LAS unsigned char* VS = F.lds + 36864; LAS unsigned char* SS = F.lds + 71680; LAS unsigned char* CS = F.lds + 90112;
    const size_t R0 = (size_t)b * 4096 + (size_t)nn * 128;
    const int w = F.wave, lane = F.lane, fr = lane & 15, fq = lane >> 4;
    const int il = 16 * w + fr;
    const bf16x8 qf0 = frag_row(QS, SQ, 16 * w, 0, lane), qf1 = frag_row(QS, SQ, 16 * w, 32, lane);
    const int jtmax = w | 1;
    for (int jt = 0; jt <= jtmax; ++jt) {
        f32x4 a = {0.f, 0.f, 0.f, 0.f};
        a = mma(frag_row(KS, SQ, 16 * jt, 0, lane), qf0, a); a = mma(frag_row(KS, SQ, 16 * jt, 32, lane), qf1, a);
        float o[4];
#pragma unroll
        for (int r = 0; r < 4; ++r) { const int dl = il - (16 * jt + 4 * fq + r); o[r] = dl >= 0 ? a[r] * exp2f((float)dl * lg) : 0.f; }
        u32x2 pk; pk.x = cvtpk(o[0], o[1]); pk.y = cvtpk(o[2], o[3]);
        *(LAS u32x2*)(CS + il * SV + (16 * jt + 4 * fq) * 2) = pk;
    }
    asm volatile("s_waitcnt lgkmcnt(0)" ::: "memory");
    f32x4 accI[8], accC[8];
#pragma unroll
    for (int vt = 0; vt < 8; ++vt) { accI[vt] = (f32x4){0.f, 0.f, 0.f, 0.f}; accC[vt] = (f32x4){0.f, 0.f, 0.f, 0.f}; }
    const int kkmax = w >> 1;
    for (int kk = 0; kk <= kkmax; ++kk) { const bf16x8 cf = frag_row(CS, SV, 16 * w, 32 * kk, lane);
#pragma unroll
        for (int vt = 0; vt < 8; ++vt) accI[vt] = mma(frag_tr(VS, SV, 32 * kk, 16 * vt, lane), cf, accI[vt]); }
#pragma unroll
    for (int vt = 0; vt < 8; ++vt) { accC[vt] = mma(frag_row(SS, SQ, 16 * vt, 0, lane), qf0, accC[vt]); accC[vt] = mma(frag_row(SS, SQ, 16 * vt, 32, lane), qf1, accC[vt]); }
    const float xi = exp2f((float)(il + 1) * lg);
    float s = 0.f;
#pragma unroll
    for (int vt = 0; vt < 8; ++vt) { accI[vt] = accI[vt] + accC[vt] * xi; s += (accI[vt][0] + accI[vt][1]) + (accI[vt][2] + accI[vt][3]); }
    s += __shfl_xor(s, 16); s += __shfl_xor(s, 32);
    const float mean = s * (1.0f / 128.0f); float q = 0.f;
#pragma unroll
    for (int vt = 0; vt < 8; ++vt) { accI[vt] = accI[vt] - mean; q += (accI[vt][0] * accI[vt][0] + accI[vt][1] * accI[vt][1]) + (accI[vt][2] * accI[vt][2] + accI[vt][3] * accI[vt][3]); }
    q += __shfl_xor(q, 16); q += __shfl_xor(q, 32);
    const float rstd = 1.0f / sqrtf(q * (1.0f / 128.0f) + GN_EPS);
    bf16* orow = F.MIXIN + (R0 + il) * 1024 + h * 128 + 4 * fq;
#pragma unroll
    for (int vt = 0; vt < 8; ++vt) {
        const float g0 = bflo(gb[vt].x), g1 = bfhi(gb[vt].x), g2 = bflo(gb[vt].y), g3 = bfhi(gb[vt].y);
        const float y0 = accI[vt][0] * rstd * g0 / (1.0f + __expf(-g0)), y1 = accI[vt][1] * rstd * g1 / (1.0f + __expf(-g1));
        const float y2 = accI[vt][2] * rstd * g2 / (1.0f + __expf(-g2)), y3 = accI[vt][3] * rstd * g3 / (1.0f + __expf(-g3));
        u32x2 pk; pk.x = cvtpk(y0, y1); pk.y = cvtpk(y2, y3); *(GAS u32x2*)(orow + 16 * vt) = pk; }
}
DI void pool_fetch(const Frame& F, v4u (&ru)[5], int b, int g, int nn) {
#pragma unroll
    for (int i = 0; i < 5; ++i) { const int ch = F.tid + 512 * i; ru[i] = (v4u){0u, 0u, 0u, 0u};
        if (ch < 144 * 16) { const int rr = ch >> 4, c16 = ch & 15, t = nn * 128 - 16 + rr;
            if (t >= 0) ru[i] = *(const GAS v4u*)(F.Ub + ((size_t)b * 4096 + t) * 512 + g * 128 + c16 * 8);
            else { const float* mu = F.metau + (16 + t) * 512 + g * 128 + c16 * 8; ru[i].x = pk2(mu[0], mu[1]); ru[i].y = pk2(mu[2], mu[3]); ru[i].z = pk2(mu[4], mu[5]); ru[i].w = pk2(mu[6], mu[7]); } } }
}
DI void p3_mixer(Frame& F) {
    const int c = blockIdx.x;
    {
        LAS unsigned char* QS = F.lds; LAS unsigned char* KS = F.lds + 18432; LAS unsigned char* VS = F.lds + 36864; LAS unsigned char* SS = F.lds + 71680;
        RetRegs rg; { const int tile = 2 * c; ret_fetch(F, rg, tile >> 5, 0, tile & 31); }
        for (int i = 0; i < 8; ++i) {
            const int tile = 2 * c + (i >> 2), hg = i & 3, b = tile >> 5, nn = tile & 31;
            const float lg = log2f(1.0f - exp2f(-5.0f - (float)hg));
            __syncthreads();
#pragma unroll
            for (int k = 0; k < 2; ++k) { const int ch = F.tid + 512 * k, rw = ch >> 3, c8 = ch & 7;
                *(LAS v4u*)(QS + rw * SQ + c8 * 16) = rg.q[k]; *(LAS v4u*)(KS + rw * SQ + c8 * 16) = rg.k[k]; *(LAS v4u*)(SS + rw * SQ + c8 * 16) = rg.s[k]; }
#pragma unroll
            for (int k = 0; k < 4; ++k) { const int ch = F.tid + 512 * k, rw = ch >> 4, c16 = ch & 15; *(LAS v4u*)(VS + rw * SV + c16 * 16) = rg.v[k]; }
            __syncthreads();
            u32x2 gcur[8];
#pragma unroll
            for (int vt = 0; vt < 8; ++vt) gcur[vt] = rg.g[vt];
            if (i < 7) { const int t2 = 2 * c + ((i + 1) >> 2); ret_fetch(F, rg, t2 >> 5, (i + 1) & 3, t2 & 31); }
            ret_compute(F, b, hg, nn, lg, gcur);
        }
    }
    {
        LAS unsigned char* US = F.lds; LAS unsigned char* PS = F.lds + 40960; LAS unsigned char* WSM = F.lds + 77824;
        const int w = F.wave, lane = F.lane, fr = lane & 15, fq = lane >> 4;
        f32x4 pb[8], psc[8]; v4u wreg[4];
        v4u ru[5]; { const int tile = 2 * c; pool_fetch(F, ru, tile >> 5, 0, tile & 31); }
#pragma unroll
        for (int k = 0; k < 4; ++k) { const int ch = F.tid + 512 * k; wreg[k] = *(const GAS v4u*)(F.Wpool_t + (ch >> 4) * 128 + (ch & 15) * 8); }
        for (int i = 0; i < 8; ++i) {
            const int g = i >> 1, tile = 2 * c + (i & 1), b = tile >> 5, nn = tile & 31, win = 2 << g; const float invw = 1.0f / (float)win;
            const size_t R0 = (size_t)b * 4096 + (size_t)nn * 128;
            __syncthreads();
            if ((i & 1) == 0) {
#pragma unroll
                for (int k = 0; k < 4; ++k) { const int ch = F.tid + 512 * k; *(LAS v4u*)(WSM + (ch >> 4) * SV + (ch & 15) * 16) = wreg[k]; }
#pragma unroll
                for (int dt = 0; dt < 8; ++dt) { pb[dt] = *(const f32x4*)(F.pool_b + g * 128 + 16 * dt + 4 * fq); psc[dt] = *(const f32x4*)(F.pool_scale + g * 128 + 16 * dt + 4 * fq); } }
#pragma unroll
            for (int k = 0; k < 5; ++k) { const int ch = F.tid + 512 * k; if (ch < 144 * 16) *(LAS v4u*)(US + (ch >> 4) * SV + (ch & 15) * 16) = ru[k]; }
            __syncthreads();
            if (i < 7) { const int t2 = 2 * c + ((i + 1) & 1), g2 = (i + 1) >> 1; pool_fetch(F, ru, t2 >> 5, g2, t2 & 31);
                if ((i & 1) == 1) {
#pragma unroll
                    for (int k = 0; k < 4; ++k) { const int ch = F.tid + 512 * k; wreg[k] = *(const GAS v4u*)(F.Wpool_t + g2 * 16384 + (ch >> 4) * 128 + (ch & 15) * 8); } } }
            { const int c2 = F.tid & 63, ib = F.tid >> 6; float run0 = 0.f, run1 = 0.f;
              for (int sI = 0; sI < win; ++sI) { const unsigned xw = *(const LAS unsigned*)(US + (16 + 16 * ib - sI) * SV + c2 * 4); run0 += bflo(xw); run1 += bfhi(xw); }
              for (int ii = 0; ii < 16; ++ii) { const int ir = 16 * ib + ii; const unsigned cur = *(const LAS unsigned*)(US + (16 + ir) * SV + c2 * 4);
                  if (ii > 0) { const unsigned old = *(const LAS unsigned*)(US + (16 + ir - win) * SV + c2 * 4); run0 += bflo(cur) - bflo(old); run1 += bfhi(cur) - bfhi(old); }
                  *(LAS unsigned*)(PS + ir * SV + c2 * 4) = cvtpk(run0 * invw - bflo(cur), run1 * invw - bfhi(cur)); } }
            __syncthreads();
            bf16x8 pf[4];
#pragma unroll
            for (int kk = 0; kk < 4; ++kk) pf[kk] = frag_row(PS, SV, 16 * w, 32 * kk, lane);
            bf16* orow = F.MIXIN + (R0 + 16 * w + fr) * 1024 + 512 + g * 128 + 4 * fq;
#pragma unroll
            for (int dt = 0; dt < 8; ++dt) { f32x4 a = {0.f, 0.f, 0.f, 0.f};
#pragma unroll
                for (int kk = 0; kk < 4; ++kk) a = mma(frag_row(WSM, SV, 16 * dt, 32 * kk, lane), pf[kk], a);
                a = (a + pb[dt]) * psc[dt];
                u32x2 pk; pk.x = cvtpk(a[0], a[1]); pk.y = cvtpk(a[2], a[3]); *(GAS u32x2*)(orow + 16 * dt) = pk; }
        }
    }
    __syncthreads();
}

DI void split8(const float (&h)[8], bf16x8& hi, bf16x8& lo) {
    v4u a, b;
#pragma unroll
    for (int p = 0; p < 4; ++p) { const unsigned wd = cvtpk(h[2 * p], h[2 * p + 1]); a[p] = wd; b[p] = cvtpk(h[2 * p] - bflo(wd), h[2 * p + 1] - bfhi(wd)); }
    hi = __builtin_bit_cast(bf16x8, a); lo = __builtin_bit_cast(bf16x8, b);
}
DI void p5_ln_router(Frame& F) {
    LAS int* LCNT = (LAS int*)(F.lds + LCNT_OFF);
    LAS f32x2* SP = (LAS f32x2*)(F.lds);
    LAS float* LP = (LAS float*)(F.lds + 1024);
    LAS float* LG = (LAS float*)(F.lds + 1024 + 24576);
    LAS float* GB = (LAS float*)(F.lds + 32768);
    for (int i = F.tid; i < 256; i += 512) { *(LAS f32x4*)(GB + 4 * i) = *(const f32x4*)(F.ln1_g + 4 * i); *(LAS f32x4*)(GB + 1024 + 4 * i) = *(const f32x4*)(F.ln1_b + 4 * i); }
    if (F.tid < 32) LCNT[F.tid] = 0;
    const int w = F.wave, lane = F.lane, fr = lane & 15, fq = lane >> 4;
    const int kb = 128 * w + 8 * fq;
    bf16x8 wh[3][4], wl[3][4];
#pragma unroll
    for (int ct = 0; ct < 3; ++ct)
#pragma unroll
        for (int ks = 0; ks < 4; ++ks) { const int cc = 16 * ct + fr; float f[8];
            if (cc < 36) { const f32x4 a = *(const f32x4*)(F.RW + cc * 1024 + kb + 32 * ks), b = *(const f32x4*)(F.RW + cc * 1024 + kb + 32 * ks + 4);
                f[0] = a[0]; f[1] = a[1]; f[2] = a[2]; f[3] = a[3]; f[4] = b[0]; f[5] = b[1]; f[6] = b[2]; f[7] = b[3]; }
            else {
#pragma unroll
                for (int j = 0; j < 8; ++j) f[j] = 0.f; }
            split8(f, wh[ct][ks], wl[ct][ks]); }
    const int c = blockIdx.x;
    const float rbias = lane < 4 ? F.rg_b[lane] : (lane < 36 ? F.re_b[lane - 4] : 0.f);
    const bf16* tbase = F.T1 + (size_t)(c * 256 + fr) * D + kb;
    v4u tn[4], tm[4];
#pragma unroll
    for (int ks = 0; ks < 4; ++ks) { tn[ks] = *(const GAS v4u*)(tbase + 32 * ks); tm[ks] = *(const GAS v4u*)(tbase + (size_t)16 * D + 32 * ks); }
    __syncthreads();
    for (int grp = 0; grp < 16; ++grp) {
        f32x4 t[8];
#pragma unroll
        for (int i = 0; i < 4; ++i) { t[2 * i] = (f32x4){bflo(tn[i].x), bfhi(tn[i].x), bflo(tn[i].y), bfhi(tn[i].y)}; t[2 * i + 1] = (f32x4){bflo(tn[i].z), bfhi(tn[i].z), bflo(tn[i].w), bfhi(tn[i].w)}; }
#pragma unroll
        for (int ks = 0; ks < 4; ++ks) tn[ks] = tm[ks];
        if (grp < 14) { const bf16* nb = tbase + (size_t)(grp + 2) * 16 * D;
#pragma unroll
            for (int ks = 0; ks < 4; ++ks) tm[ks] = *(const GAS v4u*)(nb + 32 * ks); }
        float s = 0.f, s2 = 0.f;
#pragma unroll
        for (int i = 0; i < 8; ++i) { s += (t[i][0] + t[i][1]) + (t[i][2] + t[i][3]); s2 += (t[i][0] * t[i][0] + t[i][1] * t[i][1]) + (t[i][2] * t[i][2] + t[i][3] * t[i][3]); }
        s += __shfl_xor(s, 16); s += __shfl_xor(s, 32); s2 += __shfl_xor(s2, 16); s2 += __shfl_xor(s2, 32);
        if (fq == 0) SP[fr * 8 + w] = (f32x2){s, s2};
        __syncthreads();
        float ts = 0.f, ts2 = 0.f;
#pragma unroll
        for (int k = 0; k < 8; ++k) { const f32x2 p = SP[fr * 8 + k]; ts += p.x; ts2 += p.y; }
        const float mean = ts * (1.f / D); const float rstd = 1.f / sqrtf(ts2 * (1.f / D) - mean * mean + LN_EPS);
        f32x4 acc[3];
#pragma unroll
        for (int ct = 0; ct < 3; ++ct) acc[ct] = (f32x4){0.f, 0.f, 0.f, 0.f};
        bf16* hrow = F.H1B + (size_t)(c * 256 + grp * 16 + fr) * D + kb;
#pragma unroll
        for (int ks = 0; ks < 4; ++ks) { const int col = kb + 32 * ks;
            const f32x4 g0 = *(const LAS f32x4*)(GB + col), g1 = *(const LAS f32x4*)(GB + col + 4), b0 = *(const LAS f32x4*)(GB + 1024 + col), b1 = *(const LAS f32x4*)(GB + 1024 + col + 4);
            const f32x4 h0 = (t[2 * ks] - mean) * rstd * g0 + b0, h1 = (t[2 * ks + 1] - mean) * rstd * g1 + b1;
            const float h[8] = {h0[0], h0[1], h0[2], h0[3], h1[0], h1[1], h1[2], h1[3]};
            bf16x8 hh, hl; split8(h, hh, hl);
            *(GAS bf16x8*)(hrow + 32 * ks) = hh;
#pragma unroll
            for (int ct = 0; ct < 3; ++ct) { acc[ct] = mma(wh[ct][ks], hh, acc[ct]); acc[ct] = mma(wh[ct][ks], hl, acc[ct]); acc[ct] = mma(wl[ct][ks], hh, acc[ct]); } }
#pragma unroll
        for (int ct = 0; ct < 3; ++ct) *(LAS f32x4*)(LP + ((w * 16 + fr) * 48 + 16 * ct + 4 * fq)) = acc[ct];
        __syncthreads();
#pragma unroll
        for (int rr = 0; rr < 2; ++rr) { const int rl = 2 * w + rr;
            if (lane < 36) { float sg = 0.f;
#pragma unroll
                for (int k = 0; k < 8; ++k) sg += LP[(k * 16 + rl) * 48 + lane];
                LG[rl * 40 + lane] = sg + rbias; } }
        asm volatile("s_waitcnt lgkmcnt(0)" ::: "memory");
        if (lane < 2) { const int rl = 2 * w + lane, row = c * 256 + grp * 16 + rl; const LAS float* lg = LG + rl * 40;
            const float l0 = lg[0], l1 = lg[1], l2 = lg[2], l3 = lg[3];
            const float gmax = fmaxf(fmaxf(l0, l1), fmaxf(l2, l3));
            const int gi = l0 == gmax ? 0 : (l1 == gmax ? 1 : (l2 == gmax ? 2 : 3));
            const float gp = 1.0f / ((expf(l0 - gmax) + expf(l1 - gmax)) + (expf(l2 - gmax) + expf(l3 - gmax)));
            float sel[8];
#pragma unroll
            for (int k = 0; k < 8; ++k) sel[k] = lg[4 + gi * 8 + k];
            float m1 = sel[0];
#pragma unroll
            for (int k = 1; k < 8; ++k) m1 = fmaxf(m1, sel[k]);
            int i1 = 7;
#pragma unroll
            for (int k = 6; k >= 0; --k) i1 = sel[k] == m1 ? k : i1;
            float m2 = -3.0e38f;
#pragma unroll
            for (int k = 0; k < 8; ++k) m2 = (k != i1) ? fmaxf(m2, sel[k]) : m2;
            int i2 = -1;
#pragma unroll
            for (int k = 7; k >= 0; --k) i2 = (k != i1 && sel[k] == m2) ? k : i2;
            const float tt = expf(m2 - m1); const float w0 = gp / (1.0f + tt), w1 = gp * tt / (1.0f + tt);
            const int e0 = gi * 8 + i1, e1 = gi * 8 + i2;
            const int li0 = __hip_atomic_fetch_add(LCNT + e0, 1, __ATOMIC_RELAXED, __HIP_MEMORY_SCOPE_WORKGROUP), li1 = __hip_atomic_fetch_add(LCNT + e1, 1, __ATOMIC_RELAXED, __HIP_MEMORY_SCOPE_WORKGROUP);
            F.toke[row] = (unsigned)e0 | ((unsigned)e1 << 8); F.tokl[row] = (unsigned)li0 | ((unsigned)li1 << 16); F.tokw[row] = (f32x2){w0, w1}; }
    }
    __syncthreads();
    if (F.tid < 32) F.cnt[c * 32 + F.tid] = LCNT[F.tid];
}
DI void moe_layout(Frame& F) {
    LAS int* red = (LAS int*)(F.lds);
    LAS int* PP = (LAS int*)(F.lds + PP_OFF); LAS int* TOT = (LAS int*)(F.lds + TOT_OFF); LAS int* BEF = (LAS int*)(F.lds + BEF_OFF); LAS int* BASE = (LAS int*)(F.lds + BASE_OFF);
    __syncthreads();
    { const int e = F.tid & 31, part = F.tid >> 5; int tot = 0, bef = 0;
      for (int k = 0; k < 16; ++k) { const int c2 = part * 16 + k; const int v = F.cnt[c2 * 32 + e]; tot += v; bef += (c2 < (int)blockIdx.x) ? v : 0; }
      red[(part * 32 + e) * 2] = tot; red[(part * 32 + e) * 2 + 1] = bef; }
    __syncthreads();
    if (F.tid < 32) { int t = 0, bf = 0;
        for (int p = 0; p < 16; ++p) { t += red[(p * 32 + F.tid) * 2]; bf += red[(p * 32 + F.tid) * 2 + 1]; }
        TOT[F.tid] = t; BEF[F.tid] = bf; }
    __syncthreads();
    if (F.tid == 0) { int acc = 0; for (int e = 0; e < 32; ++e) { PP[e] = acc; acc += (TOT[e] + 255) >> 8; } PP[32] = acc; }
    __syncthreads();
    if (F.tid < 32) BASE[F.tid] = PP[F.tid] * 256 + BEF[F.tid];
    __syncthreads();
}
DI void p6_assign(Frame& F) {
    moe_layout(F);
    const LAS int* BASE = (const LAS int*)(F.lds + BASE_OFF); const LAS int* PP = (const LAS int*)(F.lds + PP_OFF); const LAS int* TOT = (const LAS int*)(F.lds + TOT_OFF);
    const int c = blockIdx.x;
    if (F.tid < 256) { const int row = c * 256 + F.tid; const unsigned te = F.toke[row], tl = F.tokl[row];
        const int s0 = BASE[te & 255u] + (int)(tl & 0xffffu), s1 = BASE[(te >> 8) & 255u] + (int)(tl >> 16);
        F.stok[s0] = row; F.stok[s1] = row; F.toks[row * 2] = s0; F.toks[row * 2 + 1] = s1; const f32x2 wv = F.tokw[row]; F.PW[s0] = wv.x; F.PW[s1] = wv.y; }
    if (c < 32) { const int lo = PP[c] * 256 + TOT[c], hi = PP[c + 1] * 256; for (int sl = lo + F.tid; sl < hi; sl += 512) { F.stok[sl] = 0; F.PW[sl] = 0.f; } }
}
DI void p9_final(Frame& F) {
    const int gw = F.vcu * NWAVES + F.wave, NGW = F.G * NWAVES;
    f32x4 gv[4], bv[4];
#pragma unroll
    for (int j = 0; j < 4; ++j) { gv[j] = *(const f32x4*)(F.ln2_g + 4 * F.lane + 256 * j); bv[j] = *(const f32x4*)(F.ln2_b + 4 * F.lane + 256 * j); }
    u32x2 nh[4], mh[4]; unsigned na[4], nb[4], ma[4], mb[4]; int s0n, s1n;
    { const int r0 = gw, r1 = gw + NGW, r2 = gw + 2 * NGW;
      const int a0 = F.toks[r0 * 2], a1 = F.toks[r0 * 2 + 1], b0 = F.toks[r1 * 2], b1 = F.toks[r1 * 2 + 1];
      const GAS u32x2* hp = (const GAS u32x2*)(F.H1B + (size_t)r0 * D) + F.lane; const GAS unsigned* y0 = (const GAS unsigned*)(F.YP + (size_t)a0 * D) + F.lane; const GAS unsigned* y1 = (const GAS unsigned*)(F.YP + (size_t)a1 * D) + F.lane;
      const GAS u32x2* hq = (const GAS u32x2*)(F.H1B + (size_t)r1 * D) + F.lane; const GAS unsigned* z0 = (const GAS unsigned*)(F.YP + (size_t)b0 * D) + F.lane; const GAS unsigned* z1 = (const GAS unsigned*)(F.YP + (size_t)b1 * D) + F.lane;
#pragma unroll
      for (int j = 0; j < 4; ++j) { nh[j] = hp[64 * j]; na[j] = y0[64 * j]; nb[j] = y1[64 * j]; mh[j] = hq[64 * j]; ma[j] = z0[64 * j]; mb[j] = z1[64 * j]; }
      s0n = F.toks[r2 * 2]; s1n = F.toks[r2 * 2 + 1]; }
    for (int row = gw; row < M; row += NGW) {
        u32x2 ch[4]; unsigned ca[4], cb[4];
#pragma unroll
        for (int j = 0; j < 4; ++j) { ch[j] = nh[j]; ca[j] = na[j]; cb[j] = nb[j]; nh[j] = mh[j]; na[j] = ma[j]; nb[j] = mb[j]; }
        if (row + 2 * NGW < M) { const int rn = row + 2 * NGW;
            const GAS u32x2* hp = (const GAS u32x2*)(F.H1B + (size_t)rn * D) + F.lane; const GAS unsigned* y0 = (const GAS unsigned*)(F.YP + (size_t)s0n * D) + F.lane; const GAS unsigned* y1 = (const GAS unsigned*)(F.YP + (size_t)s1n * D) + F.lane;
#pragma unroll
            for (int j = 0; j < 4; ++j) { mh[j] = hp[64 * j]; ma[j] = y0[64 * j]; mb[j] = y1[64 * j]; }
            const int r3 = rn + NGW < M ? rn + NGW : rn; s0n = F.toks[r3 * 2]; s1n = F.toks[r3 * 2 + 1]; }
        f32x4 v[4]; float s = 0.f;
#pragma unroll
        for (int j = 0; j < 4; ++j) { const u32x2 hb = ch[j];
            const f32x2 a0 = __builtin_amdgcn_cvt_pk_f32_fp8((int)ca[j], false), a1 = __builtin_amdgcn_cvt_pk_f32_fp8((int)ca[j], true);
            const f32x2 b0 = __builtin_amdgcn_cvt_pk_f32_fp8((int)cb[j], false), b1 = __builtin_amdgcn_cvt_pk_f32_fp8((int)cb[j], true);
            v[j].x = ALPHA * bflo(hb.x) + (a0.x + b0.x) * 0.015625f; v[j].y = ALPHA * bfhi(hb.x) + (a0.y + b0.y) * 0.015625f;
            v[j].z = ALPHA * bflo(hb.y) + (a1.x + b1.x) * 0.015625f; v[j].w = ALPHA * bfhi(hb.y) + (a1.y + b1.y) * 0.015625f;
            s += (v[j].x + v[j].y) + (v[j].z + v[j].w); }
        const float mean = wave_sum(s) * (1.f / D); float s2 = 0.f;
#pragma unroll
        for (int j = 0; j < 4; ++j) { v[j] = v[j] - mean; s2 += (v[j].x * v[j].x + v[j].y * v[j].y) + (v[j].z * v[j].z + v[j].w * v[j].w); }
        const float rstd = 1.f / sqrtf(wave_sum(s2) * (1.f / D) + LN_EPS);
        GAS f32x4* op = (GAS f32x4*)(F.out + (size_t)row * D) + F.lane;
#pragma unroll
        for (int j = 0; j < 4; ++j) op[64 * j] = v[j] * rstd * gv[j] + bv[j];
    }
}

struct Args { const float* in[20]; float* out; unsigned char* ws; int ph_lo, ph_hi; };
__global__ void __launch_bounds__(NWAVES * 64, 2) hrp_fwd(Args args) {
    extern __shared__ __attribute__((aligned(16))) unsigned char lds[];
    Frame F;
    F.lds = (LAS unsigned char*)lds;
    F.MISC = (volatile LAS unsigned*)(F.lds + MISC_OFF);
    F.tid = threadIdx.x; F.lane = F.tid & 63; F.wave = __builtin_amdgcn_readfirstlane(F.tid >> 6);
    F.G = gridDim.x; { const int bx = blockIdx.x; F.vcu = (F.G % 8 == 0) ? (bx % 8) * (F.G / 8) + bx / 8 : bx; }
    unsigned char* ws = args.ws;
    F.ctl = (gu32*)(ws + WS_CTL);
    F.x = args.in[0]; F.meta = args.in[1]; F.lne_g = args.in[2]; F.lne_b = args.in[3]; F.w_in = args.in[4]; F.pool_w = args.in[5]; F.pool_b = args.in[6]; F.pool_scale = args.in[7];
    F.w_out = args.in[8]; F.ln1_g = args.in[9]; F.ln1_b = args.in[10]; F.rg_w = args.in[11]; F.rg_b = args.in[12]; F.re_w = args.in[13]; F.re_b = args.in[14];
    F.w_gate = args.in[15]; F.w_up = args.in[16]; F.w_down = args.in[17]; F.ln2_g = args.in[18]; F.ln2_b = args.in[19]; F.out = args.out;
    F.Win_t = (bf16*)(ws + WS_WIN); F.Wout_t = (bf16*)(ws + WS_WOUT); F.Wpool_t = (bf16*)(ws + WS_WPOOL); F.Wgu_t = (bf16*)(ws + WS_WGU); F.Wd_t = (bf16*)(ws + WS_WD);
    F.RW = (float*)(ws + WS_RW); F.metak = (float*)(ws + WS_METAK); F.metav = (float*)(ws + WS_METAV); F.metau = (float*)(ws + WS_METAU); F.rope = (float*)(ws + WS_ROPE);
    F.T1 = (bf16*)(ws + WS_T1); F.PW = (float*)(ws + WS_PW);
    F.toke = (unsigned*)(ws + WS_TOKE); F.tokl = (unsigned*)(ws + WS_TOKL); F.tokw = (f32x2*)(ws + WS_TOKW); F.toks = (int*)(ws + WS_TOKS); F.cnt = (int*)(ws + WS_CNT); F.stok = (int*)(ws + WS_STOK);
    F.ST = (bf16*)(ws + WS_ST); F.H0 = (bf16*)(ws + WS_H0); F.Qb = (bf16*)(ws + WS_Q); F.Kb = (bf16*)(ws + WS_K); F.Vb = (bf16*)(ws + WS_V); F.Gb = (bf16*)(ws + WS_GATE); F.Ub = (bf16*)(ws + WS_U);
    F.MIXIN = (bf16*)(ws + WS_MIXIN); F.H1B = (bf16*)(ws + WS_H1B); F.HID = (bf16*)(ws + WS_HID); F.YP = (unsigned char*)(ws + WS_YP);
    for (int u = F.tid; u < (LDS_BYTES - LDSCTL_OFF) / 4; u += NWAVES * 64) ((LAS unsigned*)(F.lds + LDSCTL_OFF))[u] = 0u;
    __syncthreads();
    if (F.G != 256) return;
    XcdBarrier bar; bar.bar = (unsigned*)(F.ctl + CW_BAR); bar.x = 0; bar.st = nullptr;
    if (N_LAUNCHES != PER_PHASE) bar = xcd_barrier_post((unsigned*)(F.ctl + CW_BAR), F.MISC + 8);
#define GRID_BAR() do { if (N_LAUNCHES != PER_PHASE) xcd_barrier(bar); } while (0)
    const int lo = args.ph_lo, hi = args.ph_hi;
#define IN(k) (lo <= (k) && (k) < hi)
#define BOTH(k) (IN(k) && IN((k) + 1))

    if (IN(0)) { p0_prologue(F); if (BOTH(0)) GRID_BAR(); }
    if (IN(1)) {
        pg8::Gemm g{F.H0, F.Win_t, M, NPROJ, D}; pg8::StaticOrder S; S.init(M, NPROJ, F.G, (int)blockIdx.x);
        pg8::EpiProj E{F.Qb, F.Vb, F.rope};
        pg8::gemm_phase<pg8::EpiProj, pg8::StaticOrder, true, true>(F.lds + RING_OFF, g, S, E);
        if (BOTH(1)) GRID_BAR();
    }
    if (IN(2)) { p2_scan(F); if (BOTH(2)) GRID_BAR(); }
    if (IN(3)) { p3_mixer(F); VM_WAIT(); __syncthreads(); }
    if (IN(4)) {
        pg8::Gemm g{F.MIXIN, F.Wout_t, M, D, D}; pg8::OwnPanelOrder S{(int)blockIdx.x, 4};
        pg8::EpiRes E{F.H0, F.T1, ALPHA};
        pg8::gemm_phase<pg8::EpiRes, pg8::OwnPanelOrder, true, true>(F.lds + RING_OFF, g, S, E);
        VM_WAIT(); __syncthreads();
    }
    if (IN(5)) { p5_ln_router(F); if (BOTH(5)) GRID_BAR(); }
    if (IN(6)) { p6_assign(F); if (BOTH(6)) GRID_BAR(); }
    if (IN(7)) {
        if (!IN(6)) moe_layout(F);
        pg8::Gemm g{F.H1B, F.Wgu_t, SLOTS, 1024, D, F.stok}; pg8::GroupedOrder S; S.init((const LAS int*)(F.lds + PP_OFF), F.G, (int)blockIdx.x);
        pg8::EpiGateUp E{F.HID};
        pg8::gemm_phase<pg8::EpiGateUp, pg8::GroupedOrder, true, true, true>(F.lds + RING_OFF, g, S, E);
        if (BOTH(7)) GRID_BAR();
    }
    if (IN(8)) {
        if (!IN(6)) moe_layout(F);
        pg8::Gemm g{F.HID, F.Wd_t, SLOTS, 1024, DEXP}; pg8::GroupedOrder S; S.init((const LAS int*)(F.lds + PP_OFF), F.G, (int)blockIdx.x);
        pg8::EpiDown E{F.YP, F.PW};
        pg8::gemm_phase<pg8::EpiDown, pg8::GroupedOrder, true, true>(F.lds + RING_OFF, g, S, E);
        if (BOTH(8)) GRID_BAR();
    }
    if (IN(9)) p9_final(F);
#undef IN
#undef BOTH
#undef GRID_BAR
}

extern "C" void kernel_launch(void* const* d_in, const int* in_sizes, int n_in, void* d_out, int out_size, void* d_ws, size_t ws_size, hipStream_t stream) {
    static int grid = 0;
    if (grid == 0) {
        if (n_in != 20 || in_sizes[0] != M * D || out_size != M * D || ws_size < WS_END) { fprintf(stderr, "kernel_launch: built for 20 inputs, x and out of %d floats, >= %zu bytes of workspace; got n_in %d, in0 %d, out %d, ws %zu; nothing launched\n", M * D, (size_t)WS_END, n_in, n_in > 0 ? in_sizes[0] : -1, out_size, ws_size); grid = -1; return; }
        int dev = 0, cus = 0, per_cu = 0;
        if (hipGetDevice(&dev) != hipSuccess || hipDeviceGetAttribute(&cus, hipDeviceAttributeMultiprocessorCount, dev) != hipSuccess) { fprintf(stderr, "kernel_launch: hipGetDevice / hipDeviceGetAttribute failed; nothing launched\n"); grid = -1; return; }
        if (hipFuncSetAttribute((const void*)hrp_fwd, hipFuncAttributeMaxDynamicSharedMemorySize, LDS_BYTES) != hipSuccess) { fprintf(stderr, "kernel_launch: hipFuncSetAttribute failed (%d bytes of dynamic LDS); nothing launched\n", LDS_BYTES); grid = -1; return; }
        if (hipOccupancyMaxActiveBlocksPerMultiprocessor(&per_cu, (const void*)hrp_fwd, NWAVES * 64, LDS_BYTES) != hipSuccess || per_cu < 1)
            fprintf(stderr, "kernel_launch: note: the occupancy query reports %d workgroups per CU; the launch goes ahead with one per CU\n", per_cu);
        (void)hipGetLastError();
        grid = cus;
        if (grid != 256) fprintf(stderr, "kernel_launch: %d CUs; this kernel is built for 256 and will leave the output unwritten\n", grid);
    }
    if (grid < 0) return;
    if (hipMemsetAsync((char*)d_ws + WS_CTL, 0, CTL_ZERO_BYTES, stream) != hipSuccess) { fprintf(stderr, "kernel_launch: hipMemsetAsync of the control words failed; nothing launched\n"); return; }
    Args a{};
    for (int i = 0; i < 20; ++i) a.in[i] = (const float*)d_in[i];
    a.out = (float*)d_out; a.ws = (unsigned char*)d_ws;
    for (int li = 0; li < N_LAUNCHES; ++li) {
        a.ph_lo = (N_LAUNCHES == PER_PHASE) ? li : 0; a.ph_hi = (N_LAUNCHES == PER_PHASE) ? li + 1 : PER_PHASE;
        hipLaunchKernelGGL(hrp_fwd, dim3(grid), dim3(NWAVES * 64), LDS_BYTES, stream, a);
        const hipError_t le = hipPeekAtLastError();
        if (le != hipSuccess) { fprintf(stderr, "kernel_launch: launch %d failed: %s\n", li, hipGetErrorName(le)); break; }
    }
}
```

```cpp
#include <hip/hip_runtime.h>
#include <cstdio>
#include <cstdint>
#ifndef MK_N_LAUNCHES
#define MK_N_LAUNCHES 1
#endif
namespace pg8 {
#define PG8_LAS __attribute__((address_space(3)))
typedef unsigned short bf16_t;
typedef short bf16x8 __attribute__((ext_vector_type(8)));
typedef float f32x4 __attribute__((ext_vector_type(4)));
typedef unsigned u32x4 __attribute__((ext_vector_type(4)));
constexpr int BM = 256, BK = 64, HALF = 128, HTB = HALF * BK * 2  , STAGE_BYTES = 8 * HTB, NXCD = 8, WGM = 8;

__host__ __device__ __forceinline__ int lds_byte(int r, int c) { const int st = (r >> 4) * 2 + (c >> 5), rr = r & 15, cc = c & 31, ob = rr * 64 + cc * 2; return st * 1024 + (ob ^ (((ob >> 9) & 1) << 5)); }
__host__ __device__ __forceinline__ void stage_rc(int b, int& R, int& C) { const int st = b / 1024, sb = b % 1024, swz = sb ^ (((sb >> 9) & 1) << 5); R = (st >> 1) * 16 + swz / 64; C = (st & 1) * 32 + (swz % 64) / 2; }
__host__ __device__ __forceinline__ int perm32(int rho) { const int n = rho >> 4, i = rho & 15; return 8 * (i >> 2) + 4 * n + (i & 3); }

struct Unit { int pm, pn; };
struct Gemm { const bf16_t* A; const bf16_t* Bt; int M, N, K; const int* gidx; };

struct StaticOrder {
    int nM, nN, nwg, G, c;
    __host__ __device__ void init(int M, int N, int G_, int c_) { nM = M / BM; nN = N / BM; nwg = nM * nN; G = G_; c = c_; }
    __host__ __device__ bool next(int i, Unit& u) const {
        const long L = (long)i * G + c; if (L >= nwg) return false;
        int wgid = (int)L; { const int q = nwg / NXCD, r = nwg % NXCD, xcd = wgid % NXCD, off = wgid / NXCD; wgid = (xcd < r ? xcd * (q + 1) : r * (q + 1) + (xcd - r) * q) + off; }
        const int nig = WGM * nN, gid = wgid / nig, fm = gid * WGM, gsz = (nM - fm) < WGM ? (nM - fm) : WGM;
        u.pm = fm + ((wgid % nig) % gsz); u.pn = (wgid % nig) / gsz; return true;
    }
    __device__ __forceinline__ void a_ready(const Unit&) const {}
    __device__ __forceinline__ void done(const Unit&) const {}
};

__device__ __forceinline__ unsigned cvt_pk_bf16(float lo, float hi) { unsigned r; asm volatile("v_cvt_pk_bf16_f32 %0, %1, %2" : "=v"(r) : "v"(lo), "v"(hi)); return r; }
__device__ __forceinline__ float bf_lo(unsigned w) { return __uint_as_float(w << 16); }
__device__ __forceinline__ float bf_hi(unsigned w) { return __uint_as_float(w & 0xffff0000u); }
__device__ __forceinline__ unsigned pk4_fp8(const f32x4 v) { int w = __builtin_amdgcn_cvt_pk_fp8_f32(v[0], v[1], 0, false); w = __builtin_amdgcn_cvt_pk_fp8_f32(v[2], v[3], w, true); return (unsigned)w; }

struct EpiProj {
    static constexpr bool PERM = true, AFTER_DRAIN = false;
    bf16_t *Q, *V; const float* rope;
    __device__ __forceinline__ void operator()(const f32x4 (&acc)[2][2][4][2], const Unit& u, int wr, int wc, int fr, int fq) const {
        const int row0 = u.pm * BM + wr * 64 + fr, lc0 = wc * 32 + 8 * fq;
        if (u.pn < 2) {
            bf16_t* base = Q + (size_t)u.pn * ((size_t)65536 * 256); const float sc = u.pn == 0 ? 1.0f : 0.125f;
#pragma unroll
            for (int ai = 0; ai < 2; ++ai)
#pragma unroll
                for (int m = 0; m < 4; ++m) { const int row = row0 + ai * HALF + m * 16; const int pos = 16 + (row & 4095);
#pragma unroll
                    for (int bj = 0; bj < 2; ++bj) { const int lc = lc0 + bj * HALF; const int i0 = (lc & 63) >> 1;
                        const f32x4* tp = (const f32x4*)(rope + ((size_t)pos * 32 + i0) * 2); const f32x4 t0 = tp[0], t1 = tp[1];
                        const f32x4 v0 = acc[ai][bj][m][0], v1 = acc[ai][bj][m][1];
                        const float o0 = (v0[0] * t0[0] - v0[1] * t0[1]) * sc, o1 = (v0[0] * t0[1] + v0[1] * t0[0]) * sc;
                        const float o2 = (v0[2] * t0[2] - v0[3] * t0[3]) * sc, o3 = (v0[2] * t0[3] + v0[3] * t0[2]) * sc;
                        const float o4 = (v1[0] * t1[0] - v1[1] * t1[1]) * sc, o5 = (v1[0] * t1[1] + v1[1] * t1[0]) * sc;
                        const float o6 = (v1[2] * t1[2] - v1[3] * t1[3]) * sc, o7 = (v1[2] * t1[3] + v1[3] * t1[2]) * sc;
                        u32x4 w; w.x = cvt_pk_bf16(o0, o1); w.y = cvt_pk_bf16(o2, o3); w.z = cvt_pk_bf16(o4, o5); w.w = cvt_pk_bf16(o6, o7);
                        *(u32x4*)(base + (size_t)row * 256 + lc) = w; } }
        } else {
            bf16_t* base = V + (size_t)((u.pn - 2) >> 1) * ((size_t)65536 * 512); const int colt = (u.pn & 1) * 256;
#pragma unroll
            for (int ai = 0; ai < 2; ++ai)
#pragma unroll
                for (int m = 0; m < 4; ++m) { bf16_t* rowp = base + (size_t)(row0 + ai * HALF + m * 16) * 512 + colt + lc0;
#pragma unroll
                    for (int bj = 0; bj < 2; ++bj) { const f32x4 v0 = acc[ai][bj][m][0], v1 = acc[ai][bj][m][1];
                        u32x4 w; w.x = cvt_pk_bf16(v0[0], v0[1]); w.y = cvt_pk_bf16(v0[2], v0[3]); w.z = cvt_pk_bf16(v1[0], v1[1]); w.w = cvt_pk_bf16(v1[2], v1[3]);
                        *(u32x4*)(rowp + bj * HALF) = w; } }
        }
    }
};
struct EpiRes {
    static constexpr bool PERM = true, AFTER_DRAIN = false;
    const bf16_t* H0; bf16_t* T; float alpha;
    __device__ __forceinline__ void operator()(const f32x4 (&acc)[2][2][4][2], const Unit& u, int wr, int wc, int fr, int fq) const {
        const int row0 = u.pm * BM + wr * 64 + fr, col0 = u.pn * BM + wc * 32 + 8 * fq;
        u32x4 hv[2][4][2];
#pragma unroll
        for (int ai = 0; ai < 2; ++ai)
#pragma unroll
            for (int m = 0; m < 4; ++m)
#pragma unroll
                for (int bj = 0; bj < 2; ++bj) hv[ai][m][bj] = *(const u32x4*)(H0 + (size_t)(row0 + ai * HALF + m * 16) * 1024 + col0 + bj * HALF);
        asm volatile("" ::: "memory");
#pragma unroll
        for (int ai = 0; ai < 2; ++ai)
#pragma unroll
            for (int m = 0; m < 4; ++m) { const size_t off = (size_t)(row0 + ai * HALF + m * 16) * 1024 + col0;
#pragma unroll
                for (int bj = 0; bj < 2; ++bj) { const u32x4 hb = hv[ai][m][bj]; const f32x4 a0 = acc[ai][bj][m][0], a1 = acc[ai][bj][m][1];
                    u32x4 w; w.x = cvt_pk_bf16(alpha * bf_lo(hb.x) + a0[0], alpha * bf_hi(hb.x) + a0[1]); w.y = cvt_pk_bf16(alpha * bf_lo(hb.y) + a0[2], alpha * bf_hi(hb.y) + a0[3]);
                    w.z = cvt_pk_bf16(alpha * bf_lo(hb.z) + a1[0], alpha * bf_hi(hb.z) + a1[1]); w.w = cvt_pk_bf16(alpha * bf_lo(hb.w) + a1[2], alpha * bf_hi(hb.w) + a1[3]);
                    *(u32x4*)(T + off + bj * HALF) = w; } }
    }
};
struct EpiGateUp {
    static constexpr bool PERM = true, AFTER_DRAIN = false;
    unsigned char* HID;
    __device__ __forceinline__ void operator()(const f32x4 (&acc)[2][2][4][2], const Unit& u, int wr, int wc, int fr, int fq) const {
        const int row0 = u.pm * BM + wr * 64 + fr, hc = (u.pn & 3) * 128 + wc * 32 + 8 * fq;
#pragma unroll
        for (int ai = 0; ai < 2; ++ai)
#pragma unroll
            for (int m = 0; m < 4; ++m) { float h[8];
#pragma unroll
                for (int n = 0; n < 2; ++n)
#pragma unroll
                    for (int j = 0; j < 4; ++j) { const float g = acc[ai][0][m][n][j] * 0.03125f, up = acc[ai][1][m][n][j] * 0.03125f; h[4 * n + j] = g * up * __builtin_amdgcn_rcpf(1.0f + __expf(-g)); }
                typedef unsigned u32x2e __attribute__((ext_vector_type(2))); u32x2e w; w.x = pk4_fp8((f32x4){h[0], h[1], h[2], h[3]}); w.y = pk4_fp8((f32x4){h[4], h[5], h[6], h[7]});
                *(u32x2e*)(HID + (size_t)(row0 + ai * HALF + m * 16) * 512 + hc) = w; }
    }
};
struct EpiDown {
    static constexpr bool PERM = true, AFTER_DRAIN = false;
    unsigned char* YP; const float* PW;
    __device__ __forceinline__ void operator()(const f32x4 (&acc)[2][2][4][2], const Unit& u, int wr, int wc, int fr, int fq) const {
        const int row0 = u.pm * BM + wr * 64 + fr, col0 = (u.pn & 3) * BM + wc * 64 + 16 * fq;
        float pwv[8];
#pragma unroll
        for (int i = 0; i < 8; ++i) pwv[i] = PW[row0 + (i >> 2) * HALF + (i & 3) * 16];
        asm volatile("" ::: "memory");
#pragma unroll
        for (int ai = 0; ai < 2; ++ai)
#pragma unroll
            for (int m = 0; m < 4; ++m) { const int row = row0 + ai * HALF + m * 16; const float sc = pwv[ai * 4 + m] * 2.0f;
                u32x4 w; w.x = pk4_fp8(acc[ai][0][m][0] * sc); w.y = pk4_fp8(acc[ai][0][m][1] * sc); w.z = pk4_fp8(acc[ai][1][m][0] * sc); w.w = pk4_fp8(acc[ai][1][m][1] * sc);
                *(u32x4*)(YP + (size_t)row * 1024 + col0) = w; }
    }
};
struct OwnPanelOrder {
    int c, ntn;
    __device__ __forceinline__ bool next(int i, Unit& u) const { if (i >= ntn) return false; u.pm = c; u.pn = i; return true; }
    __device__ __forceinline__ void a_ready(const Unit&) const {}
    __device__ __forceinline__ void done(const Unit&) const {}
};
struct GroupedOrder {
    const PG8_LAS int* pp; int nwg, G, c;
    __device__ __forceinline__ void init(const PG8_LAS int* pp_, int G_, int c_) { pp = pp_; nwg = pp_[32] * 4; G = G_; c = c_; }
    __device__ __forceinline__ bool next(int i, Unit& u) const {
        const long L = (long)i * G + c; if (L >= nwg) return false;
        int wgid = (int)L; { const int q = nwg / NXCD, r = nwg % NXCD, xcd = wgid % NXCD, off = wgid / NXCD; wgid = (xcd < r ? xcd * (q + 1) : r * (q + 1) + (xcd - r) * q) + off; }
        const int panel = wgid >> 2; int e = 0;
#pragma unroll
        for (int k = 1; k < 32; ++k) e += (pp[k] <= panel) ? 1 : 0;
        u.pm = panel; u.pn = e * 4 + (wgid & 3); return true;
    }
    __device__ __forceinline__ void a_ready(const Unit&) const {}
    __device__ __forceinline__ void done(const Unit&) const {}
};
__device__ __forceinline__ void gather_off(const int* gidx, int pm, int K, int tid, unsigned (&v0)[2], unsigned (&v1)[2]) {
#pragma unroll
    for (int i = 0; i < 2; ++i) { int R, C; stage_rc(tid * 16 + i * 8192, R, C); v0[i] = (unsigned)(gidx[pm * 256 + R] * K + C) * 2u; v1[i] = (unsigned)(gidx[pm * 256 + 128 + R] * K + C) * 2u; }
}
typedef int v8i32 __attribute__((ext_vector_type(8))); typedef int v4i32 __attribute__((ext_vector_type(4)));
__device__ __forceinline__ v8i32 cat16(const bf16x8 lo, const bf16x8 hi) { return __builtin_shufflevector(__builtin_bit_cast(v4i32, lo), __builtin_bit_cast(v4i32, hi), 0, 1, 2, 3, 4, 5, 6, 7); }
template <class Epi, class Sched, bool ALIGN_EPI = false, bool SP2 = false, bool GATHER = false, bool FP8 = false>
__device__ __forceinline__ void gemm_phase(PG8_LAS unsigned char* lds, const Gemm g, const Sched& S, const Epi& E, const int wid) {
    int lane; asm volatile("v_mbcnt_lo_u32_b32 %0, -1, 0\n\tv_mbcnt_hi_u32_b32 %0, -1, %0" : "=v"(lane));
    const int tid = wid * 64 + lane, wr = wid >> 2, wc = wid & 3, fr = lane & 15, fq = lane >> 4;
    const int K = g.K, nt = K / BK;
    unsigned voffA[2], voffB[2];
#pragma unroll
    for (int i = 0; i < 2; ++i) { int R, C; stage_rc(tid * 16 + i * 8192, R, C); const int Rb = Epi::PERM ? ((R & ~31) + perm32(R & 31)) : R;
        voffA[i] = (unsigned)(R * K + C) * 2u; voffB[i] = (unsigned)(Rb * K + C) * 2u; }
    static_assert(SP2 || !GATHER, "GATHER is written for the SP2 loop");
    unsigned cv0[2] = {0u, 0u}, cv1[2] = {0u, 0u}, nv0[2] = {0u, 0u}, nv1[2] = {0u, 0u};
    const size_t kstep = (size_t)(BK * 2);
    const size_t hstep = (size_t)HALF * K * 2;
    const size_t tstep = 2 * hstep;
    const unsigned ldsw = (unsigned)wid * 1024u;
    const int aoff = lds_byte(wr * 64 + fr, fq * 8), boff = lds_byte(wc * 32 + fr, fq * 8);
#define PG8_SA(b, h) (((b) * 2 + (h)) * HTB)
#define PG8_SB(b, h) ((4 + (b) * 2 + (h)) * HTB)
#define PG8_STAGE(bufoff, gbase, voff) do { _Pragma("unroll") for (int _i = 0; _i < 2; ++_i) \
        __builtin_amdgcn_global_load_lds((const unsigned*)((const char*)(gbase) + (voff)[_i]), (PG8_LAS unsigned*)(lds + (bufoff) + ldsw + _i * 8192), 16, 0, 0); } while (0)
#define PG8_STAGE_A0C(bufoff, gb) do { if constexpr (GATHER) PG8_STAGE(bufoff, gb, cv0); else PG8_STAGE(bufoff, gb, voffA); } while (0)
#define PG8_STAGE_A1C(bufoff, gb) do { if constexpr (GATHER) PG8_STAGE(bufoff, gb, cv1); else PG8_STAGE(bufoff, (gb) + hstep, voffA); } while (0)
#define PG8_STAGE_A0X(bufoff, gb) do { if constexpr (GATHER) PG8_STAGE(bufoff, gb, sv0); else PG8_STAGE(bufoff, gb, voffA); } while (0)
#define PG8_STAGE_A1X(bufoff, gb) do { if constexpr (GATHER) PG8_STAGE(bufoff, gb, sv1); else PG8_STAGE(bufoff, (gb) + hstep, voffA); } while (0)
#define PG8_LDA(dst, b, h) do { _Pragma("unroll") for (int m = 0; m < 4; ++m) _Pragma("unroll") for (int k = 0; k < 2; ++k) dst[m][k] = *(const PG8_LAS bf16x8*)(lds + PG8_SA(b, h) + aoff + m * 2048 + k * 1024); } while (0)
#define PG8_LDB(dst, b, h) do { _Pragma("unroll") for (int n = 0; n < 2; ++n) _Pragma("unroll") for (int k = 0; k < 2; ++k) dst[n][k] = *(const PG8_LAS bf16x8*)(lds + PG8_SB(b, h) + boff + n * 2048 + k * 1024); } while (0)
#define PG8_MMA(ai, bj, At, Bt) do { __builtin_amdgcn_s_setprio(1); if constexpr (FP8) { _Pragma("unroll") for (int m = 0; m < 4; ++m) _Pragma("unroll") for (int n = 0; n < 2; ++n) \
        { const v8i32 a8_ = cat16(Bt[n][0], Bt[n][1]), b8_ = cat16(At[m][0], At[m][1]); asm volatile("v_mfma_scale_f32_16x16x128_f8f6f4 %0, %1, %2, %0, %3, %3 op_sel_hi:[0,0,0]" : "+v"(acc[ai][bj][m][n]) : "v"(a8_), "v"(b8_), "v"(mx_unit)); } } else { \
        _Pragma("unroll") for (int m = 0; m < 4; ++m) _Pragma("unroll") for (int n = 0; n < 2; ++n) _Pragma("unroll") for (int k = 0; k < 2; ++k) \
        acc[ai][bj][m][n] = __builtin_amdgcn_mfma_f32_16x16x32_bf16(Bt[n][k], At[m][k], acc[ai][bj][m][n], 0, 0, 0); } __builtin_amdgcn_s_setprio(0); } while (0)
#define PG8_WAIT_V(n) asm volatile("s_waitcnt vmcnt(" #n ")" ::: "memory")
#define PG8_WAIT_L(n) asm volatile("s_waitcnt lgkmcnt(" #n ")" ::: "memory")
#define PG8_BAR __builtin_amdgcn_s_barrier()
#define PG8_SCHED __builtin_amdgcn_sched_barrier(0)
    const int mx_unit = 0x7f7f7f7f;
    Unit cur, nxt; int ui = 0;
    if (!S.next(0, cur)) return;
    f32x4 acc[2][2][4][2];
#pragma unroll
    for (int a = 0; a < 2; ++a)
#pragma unroll
        for (int b = 0; b < 2; ++b)
#pragma unroll
            for (int m = 0; m < 4; ++m)
#pragma unroll
                for (int n = 0; n < 2; ++n) acc[a][b][m][n] = (f32x4){0.f, 0.f, 0.f, 0.f};
    bf16x8 At[4][2], B0[2][2], B1[2][2];
    const char* cA = (const char*)g.A + (GATHER ? (size_t)0 : (size_t)cur.pm * tstep); const char* cB = (const char*)g.Bt + (size_t)cur.pn * tstep;
    if constexpr (GATHER) gather_off(g.gidx, cur.pm, K, tid, cv0, cv1);
    S.a_ready(cur);
    if constexpr (SP2) {
        PG8_STAGE(PG8_SB(0, 0), cB, voffB); PG8_STAGE(PG8_SB(0, 1), cB + hstep, voffB); PG8_STAGE_A0C(PG8_SA(0, 0), cA); PG8_STAGE_A1C(PG8_SA(0, 1), cA);
        if (wr == 1) PG8_BAR;
        PG8_WAIT_V(2); PG8_BAR;
        PG8_STAGE(PG8_SB(1, 0), cB + kstep, voffB); PG8_STAGE_A0C(PG8_SA(1, 0), cA + kstep); PG8_STAGE(PG8_SB(1, 1), cB + hstep + kstep, voffB);
        PG8_WAIT_V(6); PG8_BAR;
    } else {
        PG8_STAGE(PG8_SB(0, 0), cB, voffB); PG8_STAGE(PG8_SA(0, 0), cA, voffA); PG8_STAGE(PG8_SB(0, 1), cB + hstep, voffB); PG8_STAGE(PG8_SA(0, 1), cA + hstep, voffA);
        if (wr == 1) PG8_BAR;
        PG8_WAIT_V(4); PG8_BAR;
        PG8_STAGE(PG8_SB(1, 0), cB + kstep, voffB); PG8_STAGE(PG8_SA(1, 0), cA + kstep, voffA); PG8_STAGE(PG8_SB(1, 1), cB + hstep + kstep, voffB);
        PG8_WAIT_V(6); PG8_BAR;
    }
    for (;;) {
        const bool has_next = S.next(ui + 1, nxt);
        if constexpr (GATHER) { if (has_next) gather_off(g.gidx, nxt.pm, K, tid, nv0, nv1); else { nv0[0] = cv0[0]; nv0[1] = cv0[1]; nv1[0] = cv1[0]; nv1[1] = cv1[1]; } }
        const char* nA = GATHER ? cA : (has_next ? (const char*)g.A + (size_t)nxt.pm * tstep : cA); const char* nB = has_next ? (const char*)g.Bt + (size_t)nxt.pn * tstep : cB;
#pragma unroll 1
        for (int t = 0; t < nt; t += 2) {
            const bool last = (t == nt - 2);
            const char* a1 = cA + (size_t)(t + 1) * kstep;
            const char* a2 = last ? nA : cA + (size_t)(t + 2) * kstep; const char* b2 = last ? nB : cB + (size_t)(t + 2) * kstep;
            const char* a3 = a2 + kstep; const char* b3 = b2 + kstep;
            if (last && has_next) S.a_ready(nxt);
            unsigned sv0[2], sv1[2]; sv0[0] = last ? nv0[0] : cv0[0]; sv0[1] = last ? nv0[1] : cv0[1]; sv1[0] = last ? nv1[0] : cv1[0]; sv1[1] = last ? nv1[1] : cv1[1];
            if constexpr (SP2) {
            PG8_LDB(B0, 0, 0); PG8_LDB(B1, 0, 1); PG8_SCHED; PG8_LDA(At, 0, 0); PG8_STAGE_A1C(PG8_SA(1, 1), a1);
            PG8_WAIT_V(8); PG8_WAIT_L(0); PG8_BAR; PG8_MMA(0, 0, At, B0); PG8_MMA(0, 1, At, B1); PG8_BAR; PG8_SCHED;
            PG8_LDA(At, 0, 1); PG8_STAGE(PG8_SB(0, 0), b2, voffB); PG8_STAGE(PG8_SB(0, 1), b2 + hstep, voffB); PG8_STAGE_A0X(PG8_SA(0, 0), a2);
            PG8_WAIT_V(8); PG8_WAIT_L(0); PG8_BAR; PG8_MMA(1, 0, At, B0); PG8_MMA(1, 1, At, B1); PG8_BAR; PG8_SCHED;
            PG8_LDB(B0, 1, 0); PG8_LDB(B1, 1, 1); PG8_SCHED; PG8_LDA(At, 1, 0); PG8_STAGE_A1X(PG8_SA(0, 1), a2);
            PG8_WAIT_V(8); PG8_WAIT_L(0); PG8_BAR; PG8_MMA(0, 0, At, B0); PG8_MMA(0, 1, At, B1); PG8_BAR; PG8_SCHED;
            PG8_LDA(At, 1, 1); PG8_STAGE(PG8_SB(1, 0), b3, voffB); PG8_STAGE(PG8_SB(1, 1), b3 + hstep, voffB); PG8_STAGE_A0X(PG8_SA(1, 0), a3);
            PG8_WAIT_V(8); PG8_WAIT_L(0); PG8_BAR; PG8_MMA(1, 0, At, B0); PG8_MMA(1, 1, At, B1); PG8_BAR; PG8_SCHED;
            } else {
            PG8_LDB(B0, 0, 0); PG8_SCHED; PG8_LDA(At, 0, 0); PG8_STAGE(PG8_SA(1, 1), a1 + hstep, voffA);
            PG8_WAIT_L(8); PG8_BAR; PG8_WAIT_L(0); PG8_MMA(0, 0, At, B0); PG8_BAR; PG8_SCHED;
            PG8_LDB(B1, 0, 1); PG8_STAGE(PG8_SB(0, 0), b2, voffB);
            PG8_BAR; PG8_WAIT_L(0); PG8_MMA(0, 1, At, B1); PG8_BAR;
            PG8_LDA(At, 0, 1); PG8_STAGE(PG8_SA(0, 0), a2, voffA);
            PG8_BAR; PG8_WAIT_L(0); PG8_MMA(1, 0, At, B0); PG8_BAR; PG8_SCHED;
            PG8_STAGE(PG8_SB(0, 1), b2 + hstep, voffB);
            PG8_WAIT_V(6); PG8_BAR; PG8_MMA(1, 1, At, B1); PG8_BAR;
            PG8_LDB(B0, 1, 0); PG8_SCHED; PG8_LDA(At, 1, 0); PG8_STAGE(PG8_SA(0, 1), a2 + hstep, voffA);
            PG8_WAIT_L(8); PG8_BAR; PG8_WAIT_L(0); PG8_MMA(0, 0, At, B0); PG8_BAR; PG8_SCHED;
            PG8_LDB(B1, 1, 1); PG8_STAGE(PG8_SB(1, 0), b3, voffB);
            PG8_BAR; PG8_WAIT_L(0); PG8_MMA(0, 1, At, B1); PG8_BAR;
            PG8_LDA(At, 1, 1); PG8_STAGE(PG8_SA(1, 0), a3, voffA);
            PG8_BAR; PG8_WAIT_L(0); PG8_MMA(1, 0, At, B0); PG8_BAR; PG8_SCHED;
            PG8_STAGE(PG8_SB(1, 1), b3 + hstep, voffB);
            PG8_WAIT_V(6); PG8_BAR; PG8_MMA(1, 1, At, B1); PG8_BAR;
            }
        }
        if constexpr (ALIGN_EPI) { if (wr == 0) PG8_BAR; }
        if constexpr (FP8) asm volatile("s_nop 15\n\ts_nop 15" ::: "memory");
        if constexpr (!Epi::AFTER_DRAIN) { E(acc, cur, wr, wc, fr, fq); S.done(cur); }
        if (!has_next) break;
#pragma unroll
        for (int a = 0; a < 2; ++a)
#pragma unroll
            for (int b = 0; b < 2; ++b)
#pragma unroll
                for (int m = 0; m < 4; ++m)
#pragma unroll
                    for (int n = 0; n < 2; ++n) acc[a][b][m][n] = (f32x4){0.f, 0.f, 0.f, 0.f};
        cur = nxt; cA = nA; cB = nB; ++ui;
        if constexpr (GATHER) { cv0[0] = nv0[0]; cv0[1] = nv0[1]; cv1[0] = nv1[0]; cv1[1] = nv1[1]; }
        if constexpr (ALIGN_EPI) { if (wr == 1) PG8_BAR; }
    }
    PG8_WAIT_V(0);
    if constexpr (!ALIGN_EPI) { if (wr == 0) PG8_BAR; }
    PG8_BAR;
    if constexpr (Epi::AFTER_DRAIN) { E.fused(acc, cur, wr, wc, fr, fq, lds, wid, lane); S.done(cur); }
#undef PG8_SA
#undef PG8_SB
#undef PG8_STAGE
#undef PG8_LDA
#undef PG8_STAGE_A0C
#undef PG8_STAGE_A1C
#undef PG8_STAGE_A0X
#undef PG8_STAGE_A1X
#undef PG8_LDB
#undef PG8_MMA
#undef PG8_WAIT_V
#undef PG8_WAIT_L
#undef PG8_BAR
#undef PG8_SCHED
}
}

constexpr int NWAVES = 8;
constexpr int N_LAUNCHES = MK_N_LAUNCHES;
constexpr int PER_PHASE = 10;

constexpr int BATCH = 16, SEQ = 4096, D = 1024, NMETA = 16;
constexpr int M = BATCH * SEQ;
constexpr int NPROJ = 2048, NEXP = 32, DEXP = 512;
constexpr int NPANEL_MAX = 544, SLOTS = NPANEL_MAX * 256;
constexpr float LN_EPS = 1e-5f, GN_EPS = 1e-6f;
constexpr float ALPHA = 1.189207115002721f;

constexpr size_t MiB = 1u << 20;
constexpr size_t WS_CTL = 0, CTL_ZERO_BYTES = 1 * MiB;
constexpr size_t WS_WIN = 2 * MiB;
constexpr size_t WS_WOUT = 6 * MiB;
constexpr size_t WS_WPOOL = 8 * MiB;
constexpr size_t WS_RW = 8 * MiB + 256 * 1024;
constexpr size_t WS_METAK = 8 * MiB + 512 * 1024;
constexpr size_t WS_METAV = WS_METAK + 16 * 256 * 4;
constexpr size_t WS_METAU = WS_METAV + 16 * 512 * 4;
constexpr size_t WS_ROPE = 9 * MiB;
constexpr size_t WS_TOKE = 12 * MiB;
constexpr size_t WS_TOKL = WS_TOKE + (size_t)M * 4;
constexpr size_t WS_TOKW = WS_TOKL + (size_t)M * 4;
constexpr size_t WS_TOKS = WS_TOKW + (size_t)M * 8;
constexpr size_t WS_CNT = 14 * MiB;
constexpr size_t WS_PW = 15 * MiB;
constexpr size_t WS_STOK = 16 * MiB;
constexpr size_t WS_WGU = 32 * MiB;
constexpr size_t WS_WD = 96 * MiB;
constexpr size_t WS_ST = 128 * MiB;
constexpr size_t WS_H0 = 160 * MiB;
constexpr size_t WS_Q = 288 * MiB, WS_K = 320 * MiB;
constexpr size_t WS_V = 352 * MiB, WS_GATE = 416 * MiB, WS_U = 480 * MiB;
constexpr size_t WS_MIXIN = 544 * MiB;
constexpr size_t WS_T1 = 672 * MiB;
constexpr size_t WS_H1B = 288 * MiB;
constexpr size_t WS_HID = 688 * MiB;
constexpr size_t WS_H1F8 = 928 * MiB;
constexpr size_t WS_YP = 416 * MiB;
constexpr size_t WS_END = 992 * MiB;
static_assert(WS_ROPE + (size_t)4112 * 32 * 8 <= WS_TOKE && WS_TOKS + (size_t)M * 8 <= WS_CNT && WS_PW + (size_t)SLOTS * 4 <= WS_WGU, "small tables");
static_assert(WS_K == WS_Q + (size_t)M * 256 * 2 && WS_GATE == WS_V + (size_t)M * 512 * 2 && WS_U == WS_GATE + (size_t)M * 512 * 2, "EpiProj addresses K, gate, u relative to Q, V");
static_assert(WS_STOK + (size_t)SLOTS * 4 <= WS_WGU && WS_YP + (size_t)SLOTS * 1024 <= WS_HID && WS_HID + (size_t)SLOTS * 512 <= WS_H1F8 && WS_H1F8 + (size_t)M * 1024 <= WS_END && WS_WGU + (size_t)32 * 1024 * 1024 <= WS_WD && WS_WD + (size_t)32 * 1024 * 512 <= WS_ST && WS_T1 + (size_t)M * 1024 * 2 <= WS_END, "d_ws map");
constexpr int CW_BAR = 4096;

constexpr int RING_OFF = 0, RING_BYTES = 131072;
constexpr int LDSCTL_OFF = RING_BYTES;
constexpr int PP_OFF = LDSCTL_OFF, TOT_OFF = LDSCTL_OFF + 192, BEF_OFF = LDSCTL_OFF + 320, BASE_OFF = LDSCTL_OFF + 448, LCNT_OFF = LDSCTL_OFF + 576, MISC_OFF = LDSCTL_OFF + 768;
constexpr int LDS_BYTES = 147456;
static_assert(MISC_OFF + 128 <= LDS_BYTES, "LDS map");
#define GAS __attribute__((address_space(1)))
#define LAS __attribute__((address_space(3)))
typedef unsigned short bf16;
typedef unsigned v4u __attribute__((ext_vector_type(4)));
typedef float f32x4 __attribute__((ext_vector_type(4)));
typedef short bf16x8 __attribute__((ext_vector_type(8)));
typedef GAS unsigned gu32;
typedef GAS unsigned long long gu64;
#define RLX_AGENT __ATOMIC_RELAXED, __HIP_MEMORY_SCOPE_AGENT
#define LDS_WAIT() asm volatile("s_waitcnt lgkmcnt(0)" ::: "memory")
#define VM_WAIT() asm volatile("s_waitcnt vmcnt(0)" ::: "memory")
__device__ __forceinline__ unsigned long long rt() { return __builtin_amdgcn_s_memrealtime(); }
__device__ __forceinline__ unsigned f2bf(float f) { unsigned u = __builtin_bit_cast(unsigned, f); return (u + 0x7fffu + ((u >> 16) & 1u)) >> 16; }
__device__ __forceinline__ unsigned pk2(float lo, float hi) { return f2bf(lo) | (f2bf(hi) << 16); }

#define XB_TMO      128
#define XB_XCNT(j)  (256  + 64 * (j))
#define XB_XSUB(j)  (1280 + 64 * (j))
#define XB_XGEN(j)  (2304 + 64 * (j))
#define XB_TOP      3328
#define XB_TOPGEN   3392
#define XCD_BAR_WORDS 3456
#define XB_SPIN_CAP (1u << 18)

__device__ __forceinline__ unsigned xb_ld(unsigned* p)              { return __hip_atomic_load(p, __ATOMIC_RELAXED, __HIP_MEMORY_SCOPE_AGENT); }
__device__ __forceinline__ unsigned xb_add(unsigned* p, unsigned v) { return __hip_atomic_fetch_add(p, v, __ATOMIC_RELAXED, __HIP_MEMORY_SCOPE_AGENT); }
__device__ __forceinline__ unsigned xb_xcc_id() { return (unsigned)__builtin_amdgcn_s_getreg((3 << 11) | 20) & 0xFu; }
#define XB_SPIN(cond, bar) do { unsigned _sp = 0; while (cond) { __builtin_amdgcn_s_sleep(1); \
    if ((++_sp & 255u) == 0u) { if (xb_ld(&(bar)[XB_TMO])) break; if (_sp > XB_SPIN_CAP) { atomicAdd(&(bar)[XB_TMO], 1u); break; } } } } while (0)

struct XcdBarrier {
    unsigned* bar; unsigned x;
    volatile LAS unsigned* st;
};

__device__ __forceinline__ XcdBarrier xcd_barrier_post(unsigned* bar, volatile LAS unsigned* st) {
    XcdBarrier b; b.bar = bar; b.x = xb_xcc_id(); b.st = st;
    if (threadIdx.x == 0) (void)xb_add(&bar[XB_XCNT(b.x)], 1u);
    return b;
}
__device__ __forceinline__ void xcd_barrier_complete(unsigned* bar, unsigned x, unsigned& nloc, unsigned& nx) {
    const unsigned G = gridDim.x * gridDim.y * gridDim.z;
    unsigned sum, cnt, mine, sp = 0u;
    for (;;) {
        sum = 0u; cnt = 0u; mine = 0u;
#pragma unroll
        for (unsigned j = 0; j < 16; ++j) { const unsigned c = xb_ld(&bar[XB_XCNT(j)]); sum += c; cnt += (c > 0u) ? 1u : 0u; mine = (j == x) ? c : mine; }
        if (sum == G) break;
        __builtin_amdgcn_s_sleep(1);
        if ((++sp & 255u) == 0u) { if (xb_ld(&bar[XB_TMO])) break; if (sp > XB_SPIN_CAP) { atomicAdd(&bar[XB_TMO], 1u); break; } }
    }
    nloc = mine > 0u ? mine : 1u; nx = cnt > 0u ? cnt : 1u;
}

__device__ __forceinline__ void xcd_barrier(const XcdBarrier& b) {
    asm volatile("s_waitcnt vmcnt(0)" ::: "memory");
    __syncthreads();
    if (threadIdx.x == 0) {
        unsigned* bar = b.bar;
        __builtin_amdgcn_s_waitcnt(0);
        unsigned nloc = b.st[0], nx = b.st[1];
        if (nloc == 0u) { xcd_barrier_complete(bar, b.x, nloc, nx); b.st[0] = nloc; b.st[1] = nx; }
        const unsigned old = xb_add(&bar[XB_XSUB(b.x)], 1u);
        const unsigned gen = old / nloc;
        if (old + 1u == (gen + 1u) * nloc) {
            __builtin_amdgcn_fence(__ATOMIC_RELEASE, "agent");
            asm volatile("s_waitcnt vmcnt(0)" ::: "memory");
            const unsigned og = xb_add(&bar[XB_TOP], 1u);
            const unsigned tg = og / nx;
            if (og + 1u == (tg + 1u) * nx) xb_add(&bar[XB_TOPGEN], 1u);
            else XB_SPIN(xb_ld(&bar[XB_TOPGEN]) == tg, bar);
            __builtin_amdgcn_fence(__ATOMIC_ACQUIRE, "agent");
            xb_add(&bar[XB_XGEN(b.x)], 1u);
            asm volatile("s_waitcnt vmcnt(0)" ::: "memory");
        } else {
            XB_SPIN(xb_ld(&bar[XB_XGEN(b.x)]) == gen, bar);
            __builtin_amdgcn_fence(__ATOMIC_ACQUIRE, "agent");
            asm volatile("s_waitcnt vmcnt(0)" ::: "memory");
        }
    }
    __syncthreads();
}

#define DI __device__ __forceinline__
typedef short v4i16_t __attribute__((ext_vector_type(4)));
typedef unsigned u32x2 __attribute__((ext_vector_type(2)));
typedef float f32x2 __attribute__((ext_vector_type(2)));
struct Frame {
    LAS unsigned char* lds;
    volatile LAS unsigned* MISC;
    gu32* ctl;
    int tid, lane, wave;
    int vcu, G;
    const float *x, *meta, *lne_g, *lne_b, *w_in, *pool_w, *pool_b, *pool_scale, *w_out, *ln1_g, *ln1_b, *rg_w, *rg_b, *re_w, *re_b, *w_gate, *w_up, *w_down, *ln2_g, *ln2_b;
    float* out;
    bf16 *Win_t, *Wout_t, *Wpool_t;
    unsigned char *Wgu8, *Wd8, *H1F8, *HID;
    float *RW, *metak, *metav, *metau, *rope, *PW; bf16* T1;
    unsigned *toke, *tokl; f32x2* tokw; int* toks; int* cnt; int* stok;
    bf16 *ST, *H0, *Qb, *Kb, *Vb, *Gb, *Ub, *MIXIN, *H1B; unsigned char* YP;
};
DI float wave_sum(float v) {
#pragma unroll
    for (int o = 1; o < 64; o <<= 1) v += __shfl_xor(v, o);
    return v;
}
DI float bf2f(bf16 v) { return __uint_as_float(((unsigned)v) << 16); }
DI float bflo(unsigned w) { return __uint_as_float(w << 16); }
DI float bfhi(unsigned w) { return __uint_as_float(w & 0xffff0000u); }
DI unsigned cvtpk(float lo, float hi) { return pg8::cvt_pk_bf16(lo, hi); }
DI unsigned pk4f8(float a, float b, float c, float d) { int w = __builtin_amdgcn_cvt_pk_fp8_f32(a, b, 0, false); w = __builtin_amdgcn_cvt_pk_fp8_f32(c, d, w, true); return (unsigned)w; }

template <int MODE> DI int rowmap(int n) {
    if (MODE == 1) { if (n < 512) { const int i = n & 63; return (n & ~63) + (i < 32 ? 2 * i : 2 * (i - 32) + 1); } return n; }
    if (MODE == 2) return 256 * (n >> 7) + (n & 127);
    if (MODE == 3) return 256 * (n >> 7) + 128 + (n & 127);
    if (MODE == 4) { const int o = n & 255; return (n & ~255) + 128 * ((o >> 3) & 1) + 32 * (o >> 6) + 8 * ((o >> 4) & 3) + (o & 7); }
    return n;
}
template <int MODE, bool F8 = false> DI void p0_transpose_item(const float* W, int K, int N, void* WTv, LAS float* scr, int item, int lane) {
    const int nblk = N / 32, kb = item / nblk, nb = item % nblk, k0 = 64 * kb, n0 = 32 * nb;
    f32x4 tv[8];
#pragma unroll
    for (int i = 0; i < 8; ++i) tv[i] = *(const GAS f32x4*)(W + (size_t)(k0 + i * 8 + (lane >> 3)) * N + n0 + 4 * (lane & 7));
#pragma unroll
    for (int i = 0; i < 8; ++i) { LAS float* d = scr + (i * 8 + (lane >> 3)) * 33 + 4 * (lane & 7); d[0] = tv[i].x; d[1] = tv[i].y; d[2] = tv[i].z; d[3] = tv[i].w; }
    LDS_WAIT(); asm volatile("" ::: "memory");
    const int c = lane & 7;
#pragma unroll
    for (int j = 0; j < 4; ++j) { const int n = (lane >> 3) + 8 * j; const LAS float* s = scr + (8 * c) * 33 + n;
        if constexpr (F8) { u32x2 o; o.x = pk4f8(32.f * s[0 * 33], 32.f * s[1 * 33], 32.f * s[2 * 33], 32.f * s[3 * 33]); o.y = pk4f8(32.f * s[4 * 33], 32.f * s[5 * 33], 32.f * s[6 * 33], 32.f * s[7 * 33]);
            *(GAS u32x2*)((unsigned char*)WTv + (size_t)rowmap<MODE>(n0 + n) * K + k0 + 8 * c) = o; }
        else { bf16* WT = (bf16*)WTv; v4u o; o.x = pk2(s[0 * 33], s[1 * 33]); o.y = pk2(s[2 * 33], s[3 * 33]); o.z = pk2(s[4 * 33], s[5 * 33]); o.w = pk2(s[6 * 33], s[7 * 33]);
            *(GAS v4u*)(WT + (size_t)rowmap<MODE>(n0 + n) * K + k0 + 8 * c) = o; } }
    LDS_WAIT(); asm volatile("" ::: "memory");
}
DI void ld_row(const float* xrow, f32x4 (&v)[4], int lane) {
    const GAS f32x4* xr = (const GAS f32x4*)xrow + lane;
#pragma unroll
    for (int j = 0; j < 4; ++j) v[j] = xr[64 * j];
}
DI void ln_regs(const f32x4 (&gv)[4], const f32x4 (&bv)[4], f32x4 (&v)[4], float eps) {
    float s = 0.f;
#pragma unroll
    for (int j = 0; j < 4; ++j) s += (v[j].x + v[j].y) + (v[j].z + v[j].w);
    const float mean = wave_sum(s) * (1.f / D); float s2 = 0.f;
#pragma unroll
    for (int j = 0; j < 4; ++j) { v[j] = v[j] - mean; s2 += (v[j].x * v[j].x + v[j].y * v[j].y) + (v[j].z * v[j].z + v[j].w * v[j].w); }
    const float rstd = 1.f / sqrtf(wave_sum(s2) * (1.f / D) + eps);
#pragma unroll
    for (int j = 0; j < 4; ++j) v[j] = v[j] * rstd * gv[j] + bv[j];
}
DI void ln_row(const float* xrow, const f32x4 (&gv)[4], const f32x4 (&bv)[4], f32x4 (&v)[4], int lane, float eps) { ld_row(xrow, v, lane); ln_regs(gv, bv, v, eps); }
DI void store_row_bf16(bf16* orow, const f32x4 (&v)[4], int lane) {
    GAS unsigned long long* o8 = (GAS unsigned long long*)orow + lane;
#pragma unroll
    for (int j = 0; j < 4; ++j) o8[64 * j] = (unsigned long long)pk2(v[j].x, v[j].y) | ((unsigned long long)pk2(v[j].z, v[j].w) << 32);
}
DI void p0_prologue(Frame& F) {
    LAS float* scr = (LAS float*)(F.lds + RING_OFF + F.wave * 16384);
    const int gw = F.vcu * NWAVES + F.wave, NGW = F.G * NWAVES;
    constexpr int I_IN = 16 * 64, I_OUT = 16 * 32, I_POOL = 4 * 8, I_G = 32 * 256, I_U = 32 * 256, I_D = 32 * 256;
    constexpr int NITEMS = I_IN + I_OUT + I_POOL + I_G + I_U + I_D;
    for (int it = gw; it < NITEMS; it += NGW) {
        int r = it;
        if (r < I_IN) { p0_transpose_item<1>(F.w_in, 1024, 2048, F.Win_t, scr, r, F.lane); continue; } r -= I_IN;
        if (r < I_OUT) { p0_transpose_item<0>(F.w_out, 1024, 1024, F.Wout_t, scr, r, F.lane); continue; } r -= I_OUT;
        if (r < I_POOL) { const int g = r >> 3; p0_transpose_item<0>(F.pool_w + g * 16384, 128, 128, F.Wpool_t + g * 16384, scr, r & 7, F.lane); continue; } r -= I_POOL;
        if (r < I_G) { const int e = r >> 8; p0_transpose_item<2, true>(F.w_gate + (size_t)e * 524288, 1024, 512, F.Wgu8 + (size_t)e * 1048576, scr, r & 255, F.lane); continue; } r -= I_G;
        if (r < I_U) { const int e = r >> 8; p0_transpose_item<3, true>(F.w_up + (size_t)e * 524288, 1024, 512, F.Wgu8 + (size_t)e * 1048576, scr, r & 255, F.lane); continue; } r -= I_U;
        { const int e = r >> 8; p0_transpose_item<4, true>(F.w_down + (size_t)e * 524288, 512, 1024, F.Wd8 + (size_t)e * 524288, scr, r & 255, F.lane); }
    }
    { f32x4 gv[4], bv[4];
#pragma unroll
      for (int j = 0; j < 4; ++j) { gv[j] = *(const f32x4*)(F.lne_g + 4 * F.lane + 256 * j); bv[j] = *(const f32x4*)(F.lne_b + 4 * F.lane + 256 * j); }
      f32x4 nx[4], ny[4]; ld_row(F.x + (size_t)gw * D, nx, F.lane); ld_row(F.x + (size_t)(gw + NGW) * D, ny, F.lane);
      for (int m = gw; m < M; m += NGW) { f32x4 v[4];
#pragma unroll
          for (int j = 0; j < 4; ++j) { v[j] = nx[j]; nx[j] = ny[j]; }
          if (m + 2 * NGW < M) ld_row(F.x + (size_t)(m + 2 * NGW) * D, ny, F.lane);
          ln_regs(gv, bv, v, LN_EPS); store_row_bf16(F.H0 + (size_t)m * D, v, F.lane); }
    }
    { const int gt = gw * 64 + F.lane, NT = NGW * 64;
      for (int idx = gt; idx < 4112 * 32; idx += NT) { const int pos = idx >> 5, i = idx & 31;
          const float inv = exp2f(-(float)i * 0.415241011860920f);
          const float ang = (float)pos * inv;
          const double a = (double)ang; const double k = __builtin_rint(a * 0.15915494309189535); const float rr = (float)__builtin_fma(-k, 6.283185307179586, a);
          F.rope[(size_t)idx * 2] = cosf(rr); F.rope[(size_t)idx * 2 + 1] = sinf(rr); }
      for (int idx = gt; idx < 36 * 1024; idx += NT) { const int c = idx >> 10, k = idx & 1023; F.RW[idx] = c < 4 ? F.rg_w[k * 4 + c] : F.re_w[k * 32 + (c - 4)]; }
    }
    if (blockIdx.x < 20) {
        __syncthreads();
        LAS float* ML = (LAS float*)(F.lds);
        LAS float* RED = (LAS float*)(F.lds + 65536);
        LAS float* OUTM = (LAS float*)(F.lds + 98304);
        { f32x4 gv[4], bv[4];
#pragma unroll
          for (int j = 0; j < 4; ++j) { gv[j] = *(const f32x4*)(F.lne_g + 4 * F.lane + 256 * j); bv[j] = *(const f32x4*)(F.lne_b + 4 * F.lane + 256 * j); }
          for (int rr = 0; rr < 2; ++rr) { const int m = F.wave * 2 + rr; f32x4 v[4]; ln_row(F.meta + (size_t)m * D, gv, bv, v, F.lane, LN_EPS);
#pragma unroll
              for (int j = 0; j < 4; ++j) *(LAS f32x4*)(ML + m * 1024 + 4 * F.lane + 256 * j) = v[j]; } }
        __syncthreads();
        const int item = blockIdx.x;
        const int col0 = item < 4 ? 256 + 64 * item : (item < 12 ? 512 + 64 * (item - 4) : 1536 + 64 * (item - 12));
        float acc[16];
#pragma unroll
        for (int m = 0; m < 16; ++m) acc[m] = 0.f;
        for (int kk = 0; kk < 128; ++kk) { const int k = F.wave * 128 + kk; const float wv = F.w_in[(size_t)k * 2048 + col0 + F.lane];
#pragma unroll
            for (int m = 0; m < 16; ++m) acc[m] += ML[m * 1024 + k] * wv; }
#pragma unroll
        for (int m = 0; m < 16; ++m) RED[(F.wave * 16 + m) * 64 + F.lane] = acc[m];
        __syncthreads();
        for (int o = F.tid; o < 1024; o += 512) { float s = 0.f;
#pragma unroll
            for (int w = 0; w < 8; ++w) s += RED[w * 1024 + o];
            OUTM[o] = s; }
        __syncthreads();
        for (int o = F.tid; o < 1024; o += 512) { const int m = o >> 6, ii = o & 63;
            if (item < 4) {
                const int i = ii >> 1; const float x1 = OUTM[m * 64 + i], x2 = OUTM[m * 64 + 32 + i];
                const float inv = exp2f(-(float)i * 0.415241011860920f); const float ang = (float)m * inv;
                const double a = (double)ang; const double kq = __builtin_rint(a * 0.15915494309189535); const float rr = (float)__builtin_fma(-kq, 6.283185307179586, a);
                const float cs = cosf(rr), sn = sinf(rr);
                F.metak[m * 256 + item * 64 + ii] = ((ii & 1) ? (x1 * sn + x2 * cs) : (x1 * cs - x2 * sn)) * 0.125f;
            } else if (item < 12) F.metav[m * 512 + (item - 4) * 64 + ii] = OUTM[o];
            else F.metau[m * 512 + (item - 12) * 64 + ii] = OUTM[o];
        }
        __syncthreads();
    }
}

DI f32x4 mma(bf16x8 xf, bf16x8 yf, f32x4 acc) { return __builtin_amdgcn_mfma_f32_16x16x32_bf16(xf, yf, acc, 0, 0, 0); }
DI bf16x8 frag_row(const LAS unsigned char* base, int stride, int row0, int k0, int lane) {
    return *(const LAS bf16x8*)(base + (row0 + (lane & 15)) * stride + (k0 + 8 * (lane >> 4)) * 2);
}
DI bf16x8 frag_tr(const LAS unsigned char* base, int stride, int k0, int x0, int lane) {
    const int g = lane >> 4, q = (lane & 15) >> 2, p = lane & 3;
    const LAS unsigned char* a = base + (k0 + 8 * g + q) * stride + (x0 + 4 * p) * 2;
    const v4i16_t lo = __builtin_amdgcn_ds_read_tr16_b64_v4i16((LAS v4i16_t*)a);
    const v4i16_t hi = __builtin_amdgcn_ds_read_tr16_b64_v4i16((LAS v4i16_t*)(a + 4 * stride));
    return __builtin_shufflevector(lo, hi, 0, 1, 2, 3, 4, 5, 6, 7);
}
constexpr int SQ = 144, SV = 272;
DI v4u scale8(v4u x, float z) { v4u o;
#pragma unroll
    for (int p = 0; p < 4; ++p) o[p] = cvtpk(bflo(x[p]) * z, bfhi(x[p]) * z);
    return o; }
DI void p2_scan(Frame& F) {
    constexpr int SVS = 80;
    LAS unsigned char* KS = F.lds; LAS unsigned char* VSL = F.lds + 18432;
    const int w = F.wave, lane = F.lane, fr = lane & 15, fq = lane >> 4, dt = w >> 1, vt = w & 1;
    for (int unit = blockIdx.x; unit < 256; unit += F.G) {
        const int b = unit >> 4, h = (unit >> 2) & 3, vs = unit & 3;
        const float lg = log2f(1.0f - exp2f(-5.0f - (float)h));
        const float cd = exp2f(128.0f * lg);
        const int kr0 = F.tid >> 3, kc8 = F.tid & 7, vr = F.tid >> 2, vc4 = F.tid & 3;
        const float z0 = exp2f((float)(127 - kr0) * lg), z1 = exp2f((float)(63 - kr0) * lg);
        const int d0 = 16 * dt + 4 * fq, vcol = vs * 32 + 16 * vt + fr;
        f32x4 st = {0.f, 0.f, 0.f, 0.f};
        for (int m = 0; m < 16; ++m) { const float zm = exp2f((float)(15 - m) * lg) * F.metav[m * 512 + h * 128 + vcol]; const f32x4 kk = *(const f32x4*)(F.metak + m * 256 + h * 64 + d0); st = st + kk * zm; }
        bf16* STb = F.ST + (size_t)((b * 4 + h) * 32) * 8192 + vcol * 64 + d0;
        const bf16* kp = F.Kb + ((size_t)b * 4096 + kr0) * 256 + h * 64 + kc8 * 8; const bf16* vp = F.Vb + ((size_t)b * 4096 + vr) * 512 + h * 128 + vs * 32 + vc4 * 8;
        v4u rk0[4], rk1[4], rvv[4];
#pragma unroll
        for (int u = 0; u < 4; ++u) { const size_t o = (size_t)u * 128; rk0[u] = *(const GAS v4u*)(kp + o * 256); rk1[u] = *(const GAS v4u*)(kp + (o + 64) * 256); rvv[u] = *(const GAS v4u*)(vp + o * 512); }
        for (int n0 = 0; n0 < 32; n0 += 4) {
#pragma unroll
            for (int u = 0; u < 4; ++u) { const int n = n0 + u;
                { u32x2 pk; pk.x = cvtpk(st[0], st[1]); pk.y = cvtpk(st[2], st[3]); *(GAS u32x2*)(STb + (size_t)n * 8192) = pk; }
                if (n < 31) {
                    __syncthreads();
                    *(LAS v4u*)(KS + kr0 * SQ + kc8 * 16) = scale8(rk0[u], z0); *(LAS v4u*)(KS + (kr0 + 64) * SQ + kc8 * 16) = scale8(rk1[u], z1);
                    *(LAS v4u*)(VSL + vr * SVS + vc4 * 16) = rvv[u];
                    __syncthreads();
                    if (n + 4 < 31) { const size_t o = (size_t)(n + 4) * 128; rk0[u] = *(const GAS v4u*)(kp + o * 256); rk1[u] = *(const GAS v4u*)(kp + (o + 64) * 256); rvv[u] = *(const GAS v4u*)(vp + o * 512); }
                    f32x4 a = {0.f, 0.f, 0.f, 0.f};
#pragma unroll
                    for (int kk = 0; kk < 4; ++kk) a = mma(frag_tr(KS, SQ, 32 * kk, 16 * dt, lane), frag_tr(VSL, SVS, 32 * kk, 16 * vt, lane), a);
                    st = st * cd + a;
                }
            }
        }
    }
    __syncthreads();
}

struct RetRegs { v4u q[2], k[2], s[2], v[4]; u32x2 g[8]; };
DI void ret_fetch(const Frame& F, RetRegs& r, int b, int h, int nn) {
    const size_t R0 = (size_t)b * 4096 + (size_t)nn * 128;
#pragma unroll
    for (int i = 0; i < 2; ++i) { const int ch = F.tid + 512 * i, rw = ch >> 3, c8 = ch & 7;
        r.q[i] = *(const GAS v4u*)(F.Qb + (R0 + rw) * 256 + h * 64 + c8 * 8); r.k[i] = *(const GAS v4u*)(F.Kb + (R0 + rw) * 256 + h * 64 + c8 * 8);
        r.s[i] = *(const GAS v4u*)(F.ST + (size_t)((b * 4 + h) * 32 + nn) * 8192 + rw * 64 + c8 * 8); }
#pragma unroll
    for (int i = 0; i < 4; ++i) { const int ch = F.tid + 512 * i, rw = ch >> 4, c16 = ch & 15; r.v[i] = *(const GAS v4u*)(F.Vb + (R0 + rw) * 512 + h * 128 + c16 * 8); }
    { const bf16* grow = F.Gb + (R0 + 16 * F.wave + (F.lane & 15)) * 512 + h * 128 + 4 * (F.lane >> 4);
#pragma unroll
      for (int vt = 0; vt < 8; ++vt) r.g[vt] = *(const GAS u32x2*)(grow + 16 * vt); }
}
DI void ret_compute(Frame& F, int b, int h, int nn, float lg, const u32x2 (&gb)[8]) {
    LAS unsigned char* QS = F.lds; LAS unsigned char* KS = F.lds + 18432; LAS unsigned char* VS = F.lds + 36864; LAS unsigned char* SS = F.lds + 71680; LAS unsigned char* CS = F.lds + 90112;
    const size_t R0 = (size_t)b * 4096 + (size_t)nn * 128;
    const int w = F.wave, lane = F.lane, fr = lane & 15, fq = lane >> 4;
    const int il = 16 * w + fr;
    const bf16x8 qf0 = frag_row(QS, SQ, 16 * w, 0, lane), qf1 = frag_row(QS, SQ, 16 * w, 32, lane);
    const int jtmax = w | 1;
    for (int jt = 0; jt <= jtmax; ++jt) {
        f32x4 a = {0.f, 0.f, 0.f, 0.f};
        a = mma(frag_row(KS, SQ, 16 * jt, 0, lane), qf0, a); a = mma(frag_row(KS, SQ, 16 * jt, 32, lane), qf1, a);
        float o[4];
#pragma unroll
        for (int r = 0; r < 4; ++r) { const int dl = il - (16 * jt + 4 * fq + r); o[r] = dl >= 0 ? a[r] * exp2f((float)dl * lg) : 0.f; }
        u32x2 pk; pk.x = cvtpk(o[0], o[1]); pk.y = cvtpk(o[2], o[3]);
        *(LAS u32x2*)(CS + il * SV + (16 * jt + 4 * fq) * 2) = pk;
    }
    asm volatile("s_waitcnt lgkmcnt(0)" ::: "memory");
    f32x4 accI[8], accC[8];
#pragma unroll
    for (int vt = 0; vt < 8; ++vt) { accI[vt] = (f32x4){0.f, 0.f, 0.f, 0.f}; accC[vt] = (f32x4){0.f, 0.f, 0.f, 0.f}; }
    const int kkmax = w >> 1;
    for (int kk = 0; kk <= kkmax; ++kk) { const bf16x8 cf = frag_row(CS, SV, 16 * w, 32 * kk, lane);
#pragma unroll
        for (int vt = 0; vt < 8; ++vt) accI[vt] = mma(frag_tr(VS, SV, 32 * kk, 16 * vt, lane), cf, accI[vt]); }
#pragma unroll
    for (int vt = 0; vt < 8; ++vt) { accC[vt] = mma(frag_row(SS, SQ, 16 * vt, 0, lane), qf0, accC[vt]); accC[vt] = mma(frag_row(SS, SQ, 16 * vt, 32, lane), qf1, accC[vt]); }
    const float xi = exp2f((float)(il + 1) * lg);
    float s = 0.f;
#pragma unroll
    for (int vt = 0; vt < 8; ++vt) { accI[vt] = accI[vt] + accC[vt] * xi; s += (accI[vt][0] + accI[vt][1]) + (accI[vt][2] + accI[vt][3]); }
    s += __shfl_xor(s, 16); s += __shfl_xor(s, 32);
    const float mean = s * (1.0f / 128.0f); float q = 0.f;
#pragma unroll
    for (int vt = 0; vt < 8; ++vt) { accI[vt] = accI[vt] - mean; q += (accI[vt][0] * accI[vt][0] + accI[vt][1] * accI[vt][1]) + (accI[vt][2] * accI[vt][2] + accI[vt][3] * accI[vt][3]); }
    q += __shfl_xor(q, 16); q += __shfl_xor(q, 32);
    const float rstd = 1.0f / sqrtf(q * (1.0f / 128.0f) + GN_EPS);
    bf16* orow = F.MIXIN + (R0 + il) * 1024 + h * 128 + 4 * fq;
#pragma unroll
    for (int vt = 0; vt < 8; ++vt) {
        const float g0 = bflo(gb[vt].x), g1 = bfhi(gb[vt].x), g2 = bflo(gb[vt].y), g3 = bfhi(gb[vt].y);
        const float y0 = accI[vt][0] * rstd * g0 / (1.0f + __expf(-g0)), y1 = accI[vt][1] * rstd * g1 / (1.0f + __expf(-g1));
        const float y2 = accI[vt][2] * rstd * g2 / (1.0f + __expf(-g2)), y3 = accI[vt][3] * rstd * g3 / (1.0f + __expf(-g3));
        u32x2 pk; pk.x = cvtpk(y0, y1); pk.y = cvtpk(y2, y3); *(GAS u32x2*)(orow + 16 * vt) = pk; }
}
DI void pool_fetch(const Frame& F, v4u (&ru)[5], int b, int g, int nn) {
#pragma unroll
    for (int i = 0; i < 5; ++i) { const int ch = F.tid + 512 * i; ru[i] = (v4u){0u, 0u, 0u, 0u};
        if (ch < 144 * 16) { const int rr = ch >> 4, c16 = ch & 15, t = nn * 128 - 16 + rr;
            if (t >= 0) ru[i] = *(const GAS v4u*)(F.Ub + ((size_t)b * 4096 + t) * 512 + g * 128 + c16 * 8);
            else { const float* mu = F.metau + (16 + t) * 512 + g * 128 + c16 * 8; ru[i].x = pk2(mu[0], mu[1]); ru[i].y = pk2(mu[2], mu[3]); ru[i].z = pk2(mu[4], mu[5]); ru[i].w = pk2(mu[6], mu[7]); } } }
}
DI void p3_mixer(Frame& F) {
    const int c = blockIdx.x;
    {
        LAS unsigned char* QS = F.lds; LAS unsigned char* KS = F.lds + 18432; LAS unsigned char* VS = F.lds + 36864; LAS unsigned char* SS = F.lds + 71680;
        RetRegs rg; { const int tile = 2 * c; ret_fetch(F, rg, tile >> 5, 0, tile & 31); }
        for (int i = 0; i < 8; ++i) {
            const int tile = 2 * c + (i >> 2), hg = i & 3, b = tile >> 5, nn = tile & 31;
            const float lg = log2f(1.0f - exp2f(-5.0f - (float)hg));
            __syncthreads();
#pragma unroll
            for (int k = 0; k < 2; ++k) { const int ch = F.tid + 512 * k, rw = ch >> 3, c8 = ch & 7;
                *(LAS v4u*)(QS + rw * SQ + c8 * 16) = rg.q[k]; *(LAS v4u*)(KS + rw * SQ + c8 * 16) = rg.k[k]; *(LAS v4u*)(SS + rw * SQ + c8 * 16) = rg.s[k]; }
#pragma unroll
            for (int k = 0; k < 4; ++k) { const int ch = F.tid + 512 * k, rw = ch >> 4, c16 = ch & 15; *(LAS v4u*)(VS + rw * SV + c16 * 16) = rg.v[k]; }
            __syncthreads();
            u32x2 gcur[8];
#pragma unroll
            for (int vt = 0; vt < 8; ++vt) gcur[vt] = rg.g[vt];
            if (i < 7) { const int t2 = 2 * c + ((i + 1) >> 2); ret_fetch(F, rg, t2 >> 5, (i + 1) & 3, t2 & 31); }
            ret_compute(F, b, hg, nn, lg, gcur);
        }
    }
    {
        LAS unsigned char* US = F.lds; LAS unsigned char* PS = F.lds + 40960; LAS unsigned char* WSM = F.lds + 77824;
        const int w = F.wave, lane = F.lane, fr = lane & 15, fq = lane >> 4;
        f32x4 pb[8], psc[8]; v4u wreg[4];
        v4u ru[5]; { const int tile = 2 * c; pool_fetch(F, ru, tile >> 5, 0, tile & 31); }
#pragma unroll
        for (int k = 0; k < 4; ++k) { const int ch = F.tid + 512 * k; wreg[k] = *(const GAS v4u*)(F.Wpool_t + (ch >> 4) * 128 + (ch & 15) * 8); }
        for (int i = 0; i < 8; ++i) {
            const int g = i >> 1, tile = 2 * c + (i & 1), b = tile >> 5, nn = tile & 31, win = 2 << g; const float invw = 1.0f / (float)win;
            const size_t R0 = (size_t)b * 4096 + (size_t)nn * 128;
            __syncthreads();
            if ((i & 1) == 0) {
#pragma unroll
                for (int k = 0; k < 4; ++k) { const int ch = F.tid + 512 * k; *(LAS v4u*)(WSM + (ch >> 4) * SV + (ch & 15) * 16) = wreg[k]; }
#pragma unroll
                for (int dt = 0; dt < 8; ++dt) { pb[dt] = *(const f32x4*)(F.pool_b + g * 128 + 16 * dt + 4 * fq); psc[dt] = *(const f32x4*)(F.pool_scale + g * 128 + 16 * dt + 4 * fq); } }
#pragma unroll
            for (int k = 0; k < 5; ++k) { const int ch = F.tid + 512 * k; if (ch < 144 * 16) *(LAS v4u*)(US + (ch >> 4) * SV + (ch & 15) * 16) = ru[k]; }
            __syncthreads();
            if (i < 7) { const int t2 = 2 * c + ((i + 1) & 1), g2 = (i + 1) >> 1; pool_fetch(F, ru, t2 >> 5, g2, t2 & 31);
                if ((i & 1) == 1) {
#pragma unroll
                    for (int k = 0; k < 4; ++k) { const int ch = F.tid + 512 * k; wreg[k] = *(const GAS v4u*)(F.Wpool_t + g2 * 16384 + (ch >> 4) * 128 + (ch & 15) * 8); } } }
            { const int c2 = F.tid & 63, ib = F.tid >> 6; float run0 = 0.f, run1 = 0.f;
              for (int sI = 0; sI < win; ++sI) { const unsigned xw = *(const LAS unsigned*)(US + (16 + 16 * ib - sI) * SV + c2 * 4); run0 += bflo(xw); run1 += bfhi(xw); }
              for (int ii = 0; ii < 16; ++ii) { const int ir = 16 * ib + ii; const unsigned cur = *(const LAS unsigned*)(US + (16 + ir) * SV + c2 * 4);
                  if (ii > 0) { const unsigned old = *(const LAS unsigned*)(US + (16 + ir - win) * SV + c2 * 4); run0 += bflo(cur) - bflo(old); run1 += bfhi(cur) - bfhi(old); }
                  *(LAS unsigned*)(PS + ir * SV + c2 * 4) = cvtpk(run0 * invw - bflo(cur), run1 * invw - bfhi(cur)); } }
            __syncthreads();
            bf16x8 pf[4];
#pragma unroll
            for (int kk = 0; kk < 4; ++kk) pf[kk] = frag_row(PS, SV, 16 * w, 32 * kk, lane);
            bf16* orow = F.MIXIN + (R0 + 16 * w + fr) * 1024 + 512 + g * 128 + 4 * fq;
#pragma unroll
            for (int dt = 0; dt < 8; ++dt) { f32x4 a = {0.f, 0.f, 0.f, 0.f};
#pragma unroll
                for (int kk = 0; kk < 4; ++kk) a = mma(frag_row(WSM, SV, 16 * dt, 32 * kk, lane), pf[kk], a);
                a = (a + pb[dt]) * psc[dt];
                u32x2 pk; pk.x = cvtpk(a[0], a[1]); pk.y = cvtpk(a[2], a[3]); *(GAS u32x2*)(orow + 16 * dt) = pk; }
        }
    }
    __syncthreads();
}

DI void split8(const float (&h)[8], bf16x8& hi, bf16x8& lo) {
    v4u a, b;
#pragma unroll
    for (int p = 0; p < 4; ++p) { const unsigned wd = cvtpk(h[2 * p], h[2 * p + 1]); a[p] = wd; b[p] = cvtpk(h[2 * p] - bflo(wd), h[2 * p + 1] - bfhi(wd)); }
    hi = __builtin_bit_cast(bf16x8, a); lo = __builtin_bit_cast(bf16x8, b);
}
DI void p5_ln_router(Frame& F) {
    LAS int* LCNT = (LAS int*)(F.lds + LCNT_OFF);
    LAS f32x2* SP = (LAS f32x2*)(F.lds);
    LAS float* LP = (LAS float*)(F.lds + 1024);
    LAS float* LG = (LAS float*)(F.lds + 1024 + 24576);
    LAS float* GB = (LAS float*)(F.lds + 32768);
    for (int i = F.tid; i < 256; i += 512) { *(LAS f32x4*)(GB + 4 * i) = *(const f32x4*)(F.ln1_g + 4 * i); *(LAS f32x4*)(GB + 1024 + 4 * i) = *(const f32x4*)(F.ln1_b + 4 * i); }
    if (F.tid < 32) LCNT[F.tid] = 0;
    const int w = F.wave, lane = F.lane, fr = lane & 15, fq = lane >> 4;
    const int kb = 128 * w + 8 * fq;
    bf16x8 wh[3][4], wl[3][4];
#pragma unroll
    for (int ct = 0; ct < 3; ++ct)
#pragma unroll
        for (int ks = 0; ks < 4; ++ks) { const int cc = 16 * ct + fr; float f[8];
            if (cc < 36) { const f32x4 a = *(const f32x4*)(F.RW + cc * 1024 + kb + 32 * ks), b = *(const f32x4*)(F.RW + cc * 1024 + kb + 32 * ks + 4);
                f[0] = a[0]; f[1] = a[1]; f[2] = a[2]; f[3] = a[3]; f[4] = b[0]; f[5] = b[1]; f[6] = b[2]; f[7] = b[3]; }
            else {
#pragma unroll
                for (int j = 0; j < 8; ++j) f[j] = 0.f; }
            split8(f, wh[ct][ks], wl[ct][ks]); }
    const int c = blockIdx.x;
    const float rbias = lane < 4 ? F.rg_b[lane] : (lane < 36 ? F.re_b[lane - 4] : 0.f);
    const bf16* tbase = F.T1 + (size_t)(c * 256 + fr) * D + kb;
    v4u tn[4], tm[4];
#pragma unroll
    for (int ks = 0; ks < 4; ++ks) { tn[ks] = *(const GAS v4u*)(tbase + 32 * ks); tm[ks] = *(const GAS v4u*)(tbase + (size_t)16 * D + 32 * ks); }
    __syncthreads();
    for (int grp = 0; grp < 16; ++grp) {
        f32x4 t[8];
#pragma unroll
        for (int i = 0; i < 4; ++i) { t[2 * i] = (f32x4){bflo(tn[i].x), bfhi(tn[i].x), bflo(tn[i].y), bfhi(tn[i].y)}; t[2 * i + 1] = (f32x4){bflo(tn[i].z), bfhi(tn[i].z), bflo(tn[i].w), bfhi(tn[i].w)}; }
#pragma unroll
        for (int ks = 0; ks < 4; ++ks) tn[ks] = tm[ks];
        if (grp < 14) { const bf16* nb = tbase + (size_t)(grp + 2) * 16 * D;
#pragma unroll
            for (int ks = 0; ks < 4; ++ks) tm[ks] = *(const GAS v4u*)(nb + 32 * ks); }
        float s = 0.f, s2 = 0.f;
#pragma unroll
        for (int i = 0; i < 8; ++i) { s += (t[i][0] + t[i][1]) + (t[i][2] + t[i][3]); s2 += (t[i][0] * t[i][0] + t[i][1] * t[i][1]) + (t[i][2] * t[i][2] + t[i][3] * t[i][3]); }
        s += __shfl_xor(s, 16); s += __shfl_xor(s, 32); s2 += __shfl_xor(s2, 16); s2 += __shfl_xor(s2, 32);
        if (fq == 0) SP[fr * 8 + w] = (f32x2){s, s2};
        __syncthreads();
        float ts = 0.f, ts2 = 0.f;
#pragma unroll
        for (int k = 0; k < 8; ++k) { const f32x2 p = SP[fr * 8 + k]; ts += p.x; ts2 += p.y; }
        const float mean = ts * (1.f / D); const float rstd = 1.f / sqrtf(ts2 * (1.f / D) - mean * mean + LN_EPS);
        f32x4 acc[3];
#pragma unroll
        for (int ct = 0; ct < 3; ++ct) acc[ct] = (f32x4){0.f, 0.f, 0.f, 0.f};
        bf16* hrow = F.H1B + (size_t)(c * 256 + grp * 16 + fr) * D + kb; unsigned char* frow = F.H1F8 + (size_t)(c * 256 + grp * 16 + fr) * D + kb;
#pragma unroll
        for (int ks = 0; ks < 4; ++ks) { const int col = kb + 32 * ks;
            const f32x4 g0 = *(const LAS f32x4*)(GB + col), g1 = *(const LAS f32x4*)(GB + col + 4), b0 = *(const LAS f32x4*)(GB + 1024 + col), b1 = *(const LAS f32x4*)(GB + 1024 + col + 4);
            const f32x4 h0 = (t[2 * ks] - mean) * rstd * g0 + b0, h1 = (t[2 * ks + 1] - mean) * rstd * g1 + b1;
            const float h[8] = {h0[0], h0[1], h0[2], h0[3], h1[0], h1[1], h1[2], h1[3]};
            bf16x8 hh, hl; split8(h, hh, hl);
            *(GAS bf16x8*)(hrow + 32 * ks) = hh;
            { u32x2 f8; f8.x = pk4f8(h[0], h[1], h[2], h[3]); f8.y = pk4f8(h[4], h[5], h[6], h[7]); *(GAS u32x2*)(frow + 32 * ks) = f8; }
#pragma unroll
            for (int ct = 0; ct < 3; ++ct) { acc[ct] = mma(wh[ct][ks], hh, acc[ct]); acc[ct] = mma(wh[ct][ks], hl, acc[ct]); acc[ct] = mma(wl[ct][ks], hh, acc[ct]); } }
#pragma unroll
        for (int ct = 0; ct < 3; ++ct) *(LAS f32x4*)(LP + ((w * 16 + fr) * 48 + 16 * ct + 4 * fq)) = acc[ct];
        __syncthreads();
#pragma unroll
        for (int rr = 0; rr < 2; ++rr) { const int rl = 2 * w + rr;
            if (lane < 36) { float sg = 0.f;
#pragma unroll
                for (int k = 0; k < 8; ++k) sg += LP[(k * 16 + rl) * 48 + lane];
                LG[rl * 40 + lane] = sg + rbias; } }
        asm volatile("s_waitcnt lgkmcnt(0)" ::: "memory");
        if (lane < 2) { const int rl = 2 * w + lane, row = c * 256 + grp * 16 + rl; const LAS float* lg = LG + rl * 40;
            const float l0 = lg[0], l1 = lg[1], l2 = lg[2], l3 = lg[3];
            const float gmax = fmaxf(fmaxf(l0, l1), fmaxf(l2, l3));
            const int gi = l0 == gmax ? 0 : (l1 == gmax ? 1 : (l2 == gmax ? 2 : 3));
            const float gp = 1.0f / ((expf(l0 - gmax) + expf(l1 - gmax)) + (expf(l2 - gmax) + expf(l3 - gmax)));
            float sel[8];
#pragma unroll
            for (int k = 0; k < 8; ++k) sel[k] = lg[4 + gi * 8 + k];
            float m1 = sel[0];
#pragma unroll
            for (int k = 1; k < 8; ++k) m1 = fmaxf(m1, sel[k]);
            int i1 = 7;
#pragma unroll
            for (int k = 6; k >= 0; --k) i1 = sel[k] == m1 ? k : i1;
            float m2 = -3.0e38f;
#pragma unroll
            for (int k = 0; k < 8; ++k) m2 = (k != i1) ? fmaxf(m2, sel[k]) : m2;
            int i2 = -1;
#pragma unroll
            for (int k = 7; k >= 0; --k) i2 = (k != i1 && sel[k] == m2) ? k : i2;
            const float tt = expf(m2 - m1); const float w0 = gp / (1.0f + tt), w1 = gp * tt / (1.0f + tt);
            const int e0 = gi * 8 + i1, e1 = gi * 8 + i2;
            const int li0 = __hip_atomic_fetch_add(LCNT + e0, 1, __ATOMIC_RELAXED, __HIP_MEMORY_SCOPE_WORKGROUP), li1 = __hip_atomic_fetch_add(LCNT + e1, 1, __ATOMIC_RELAXED, __HIP_MEMORY_SCOPE_WORKGROUP);
            F.toke[row] = (unsigned)e0 | ((unsigned)e1 << 8); F.tokl[row] = (unsigned)li0 | ((unsigned)li1 << 16); F.tokw[row] = (f32x2){w0, w1}; }
    }
    __syncthreads();
    if (F.tid < 32) F.cnt[c * 32 + F.tid] = LCNT[F.tid];
}
DI void moe_layout(Frame& F) {
    LAS int* red = (LAS int*)(F.lds);
    LAS int* PP = (LAS int*)(F.lds + PP_OFF); LAS int* TOT = (LAS int*)(F.lds + TOT_OFF); LAS int* BEF = (LAS int*)(F.lds + BEF_OFF); LAS int* BASE = (LAS int*)(F.lds + BASE_OFF);
    __syncthreads();
    { const int e = F.tid & 31, part = F.tid >> 5; int tot = 0, bef = 0;
      for (int k = 0; k < 16; ++k) { const int c2 = part * 16 + k; const int v = F.cnt[c2 * 32 + e]; tot += v; bef += (c2 < (int)blockIdx.x) ? v : 0; }
      red[(part * 32 + e) * 2] = tot; red[(part * 32 + e) * 2 + 1] = bef; }
    __syncthreads();
    if (F.tid < 32) { int t = 0, bf = 0;
        for (int p = 0; p < 16; ++p) { t += red[(p * 32 + F.tid) * 2]; bf += red[(p * 32 + F.tid) * 2 + 1]; }
        TOT[F.tid] = t; BEF[F.tid] = bf; }
    __syncthreads();
    if (F.tid == 0) { int acc = 0; for (int e = 0; e < 32; ++e) { PP[e] = acc; acc += (TOT[e] + 255) >> 8; } PP[32] = acc; }
    __syncthreads();
    if (F.tid < 32) BASE[F.tid] = PP[F.tid] * 256 + BEF[F.tid];
    __syncthreads();
}
DI void p6_assign(Frame& F) {
    moe_layout(F);
    const LAS int* BASE = (const LAS int*)(F.lds + BASE_OFF); const LAS int* PP = (const LAS int*)(F.lds + PP_OFF); const LAS int* TOT = (const LAS int*)(F.lds + TOT_OFF);
    const int c = blockIdx.x;
    if (F.tid < 256) { const int row = c * 256 + F.tid; const unsigned te = F.toke[row], tl = F.tokl[row];
        const int s0 = BASE[te & 255u] + (int)(tl & 0xffffu), s1 = BASE[(te >> 8) & 255u] + (int)(tl >> 16);
        F.stok[s0] = row; F.stok[s1] = row; F.toks[row * 2] = s0; F.toks[row * 2 + 1] = s1; const f32x2 wv = F.tokw[row]; F.PW[s0] = wv.x; F.PW[s1] = wv.y; }
    if (c < 32) { const int lo = PP[c] * 256 + TOT[c], hi = PP[c + 1] * 256; for (int sl = lo + F.tid; sl < hi; sl += 512) { F.stok[sl] = 0; F.PW[sl] = 0.f; } }
}
DI void p9_final(Frame& F) {
    const int gw = F.vcu * NWAVES + F.wave, NGW = F.G * NWAVES;
    f32x4 gv[4], bv[4];
#pragma unroll
    for (int j = 0; j < 4; ++j) { gv[j] = *(const f32x4*)(F.ln2_g + 4 * F.lane + 256 * j); bv[j] = *(const f32x4*)(F.ln2_b + 4 * F.lane + 256 * j); }
    u32x2 nh[4], mh[4]; unsigned na[4], nb[4], ma[4], mb[4]; int s0n, s1n;
    { const int r0 = gw, r1 = gw + NGW, r2 = gw + 2 * NGW;
      const int a0 = F.toks[r0 * 2], a1 = F.toks[r0 * 2 + 1], b0 = F.toks[r1 * 2], b1 = F.toks[r1 * 2 + 1];
      const GAS u32x2* hp = (const GAS u32x2*)(F.H1B + (size_t)r0 * D) + F.lane; const GAS unsigned* y0 = (const GAS unsigned*)(F.YP + (size_t)a0 * D) + F.lane; const GAS unsigned* y1 = (const GAS unsigned*)(F.YP + (size_t)a1 * D) + F.lane;
      const GAS u32x2* hq = (const GAS u32x2*)(F.H1B + (size_t)r1 * D) + F.lane; const GAS unsigned* z0 = (const GAS unsigned*)(F.YP + (size_t)b0 * D) + F.lane; const GAS unsigned* z1 = (const GAS unsigned*)(F.YP + (size_t)b1 * D) + F.lane;
#pragma unroll
      for (int j = 0; j < 4; ++j) { nh[j] = hp[64 * j]; na[j] = y0[64 * j]; nb[j] = y1[64 * j]; mh[j] = hq[64 * j]; ma[j] = z0[64 * j]; mb[j] = z1[64 * j]; }
      s0n = F.toks[r2 * 2]; s1n = F.toks[r2 * 2 + 1]; }
    for (int row = gw; row < M; row += NGW) {
        u32x2 ch[4]; unsigned ca[4], cb[4];
#pragma unroll
        for (int j = 0; j < 4; ++j) { ch[j] = nh[j]; ca[j] = na[j]; cb[j] = nb[j]; nh[j] = mh[j]; na[j] = ma[j]; nb[j] = mb[j]; }
        if (row + 2 * NGW < M) { const int rn = row + 2 * NGW;
            const GAS u32x2* hp = (const GAS u32x2*)(F.H1B + (size_t)rn * D) + F.lane; const GAS unsigned* y0 = (const GAS unsigned*)(F.YP + (size_t)s0n * D) + F.lane; const GAS unsigned* y1 = (const GAS unsigned*)(F.YP + (size_t)s1n * D) + F.lane;
#pragma unroll
            for (int j = 0; j < 4; ++j) { mh[j] = hp[64 * j]; ma[j] = y0[64 * j]; mb[j] = y1[64 * j]; }
            const int r3 = rn + NGW < M ? rn + NGW : rn; s0n = F.toks[r3 * 2]; s1n = F.toks[r3 * 2 + 1]; }
        f32x4 v[4]; float s = 0.f;
#pragma unroll
        for (int j = 0; j < 4; ++j) { const u32x2 hb = ch[j];
            const f32x2 a0 = __builtin_amdgcn_cvt_pk_f32_fp8((int)ca[j], false), a1 = __builtin_amdgcn_cvt_pk_f32_fp8((int)ca[j], true);
            const f32x2 b0 = __builtin_amdgcn_cvt_pk_f32_fp8((int)cb[j], false), b1 = __builtin_amdgcn_cvt_pk_f32_fp8((int)cb[j], true);
            v[j].x = ALPHA * bflo(hb.x) + (a0.x + b0.x) * 0.015625f; v[j].y = ALPHA * bfhi(hb.x) + (a0.y + b0.y) * 0.015625f;
            v[j].z = ALPHA * bflo(hb.y) + (a1.x + b1.x) * 0.015625f; v[j].w = ALPHA * bfhi(hb.y) + (a1.y + b1.y) * 0.015625f;
            s += (v[j].x + v[j].y) + (v[j].z + v[j].w); }
        const float mean = wave_sum(s) * (1.f / D); float s2 = 0.f;
#pragma unroll
        for (int j = 0; j < 4; ++j) { v[j] = v[j] - mean; s2 += (v[j].x * v[j].x + v[j].y * v[j].y) + (v[j].z * v[j].z + v[j].w * v[j].w); }
        const float rstd = 1.f / sqrtf(wave_sum(s2) * (1.f / D) + LN_EPS);
        GAS f32x4* op = (GAS f32x4*)(F.out + (size_t)row * D) + F.lane;
#pragma unroll
        for (int j = 0; j < 4; ++j) op[64 * j] = v[j] * rstd * gv[j] + bv[j];
    }
}

struct Args { const float* in[20]; float* out; unsigned char* ws; int ph_lo, ph_hi; };
__global__ void __launch_bounds__(NWAVES * 64, 2) hrp_fwd(Args args) {
    extern __shared__ __attribute__((aligned(16))) unsigned char lds[];
    Frame F;
    F.lds = (LAS unsigned char*)lds;
    F.MISC = (volatile LAS unsigned*)(F.lds + MISC_OFF);
    F.tid = threadIdx.x; F.lane = F.tid & 63; F.wave = __builtin_amdgcn_readfirstlane(F.tid >> 6);
    F.G = gridDim.x; { const int bx = blockIdx.x; F.vcu = (F.G % 8 == 0) ? (bx % 8) * (F.G / 8) + bx / 8 : bx; }
    unsigned char* ws = args.ws;
    F.ctl = (gu32*)(ws + WS_CTL);
    F.x = args.in[0]; F.meta = args.in[1]; F.lne_g = args.in[2]; F.lne_b = args.in[3]; F.w_in = args.in[4]; F.pool_w = args.in[5]; F.pool_b = args.in[6]; F.pool_scale = args.in[7];
    F.w_out = args.in[8]; F.ln1_g = args.in[9]; F.ln1_b = args.in[10]; F.rg_w = args.in[11]; F.rg_b = args.in[12]; F.re_w = args.in[13]; F.re_b = args.in[14];
    F.w_gate = args.in[15]; F.w_up = args.in[16]; F.w_down = args.in[17]; F.ln2_g = args.in[18]; F.ln2_b = args.in[19]; F.out = args.out;
    F.Win_t = (bf16*)(ws + WS_WIN); F.Wout_t = (bf16*)(ws + WS_WOUT); F.Wpool_t = (bf16*)(ws + WS_WPOOL); F.Wgu8 = ws + WS_WGU; F.Wd8 = ws + WS_WD; F.H1F8 = ws + WS_H1F8;
    F.RW = (float*)(ws + WS_RW); F.metak = (float*)(ws + WS_METAK); F.metav = (float*)(ws + WS_METAV); F.metau = (float*)(ws + WS_METAU); F.rope = (float*)(ws + WS_ROPE);
    F.T1 = (bf16*)(ws + WS_T1); F.PW = (float*)(ws + WS_PW);
    F.toke = (unsigned*)(ws + WS_TOKE); F.tokl = (unsigned*)(ws + WS_TOKL); F.tokw = (f32x2*)(ws + WS_TOKW); F.toks = (int*)(ws + WS_TOKS); F.cnt = (int*)(ws + WS_CNT); F.stok = (int*)(ws + WS_STOK);
    F.ST = (bf16*)(ws + WS_ST); F.H0 = (bf16*)(ws + WS_H0); F.Qb = (bf16*)(ws + WS_Q); F.Kb = (bf16*)(ws + WS_K); F.Vb = (bf16*)(ws + WS_V); F.Gb = (bf16*)(ws + WS_GATE); F.Ub = (bf16*)(ws + WS_U);
    F.MIXIN = (bf16*)(ws + WS_MIXIN); F.H1B = (bf16*)(ws + WS_H1B); F.HID = ws + WS_HID; F.YP = (unsigned char*)(ws + WS_YP);
    for (int u = F.tid; u < (LDS_BYTES - LDSCTL_OFF) / 4; u += NWAVES * 64) ((LAS unsigned*)(F.lds + LDSCTL_OFF))[u] = 0u;
    __syncthreads();
    if (F.G != 256) return;
    XcdBarrier bar; bar.bar = (unsigned*)(F.ctl + CW_BAR); bar.x = 0; bar.st = nullptr;
    if (N_LAUNCHES != PER_PHASE) bar = xcd_barrier_post((unsigned*)(F.ctl + CW_BAR), F.MISC + 8);
#define GRID_BAR() do { if (N_LAUNCHES != PER_PHASE) xcd_barrier(bar); } while (0)
    const int lo = args.ph_lo, hi = args.ph_hi;
#define RELANE() do { int l_; asm volatile("v_mbcnt_lo_u32_b32 %0, -1, 0\n\tv_mbcnt_hi_u32_b32 %0, -1, %0" : "=v"(l_)); F.lane = l_; F.tid = F.wave * 64 + l_; } while (0)
#define IN(k) (lo <= (k) && (k) < hi)
#define BOTH(k) (IN(k) && IN((k) + 1))

    if (IN(0)) { RELANE(); p0_prologue(F); if (BOTH(0)) GRID_BAR(); }
    if (IN(1)) {
        pg8::Gemm g{F.H0, F.Win_t, M, NPROJ, D}; pg8::StaticOrder S; S.init(M, NPROJ, F.G, (int)blockIdx.x);
        pg8::EpiProj E{F.Qb, F.Vb, F.rope};
        pg8::gemm_phase<pg8::EpiProj, pg8::StaticOrder, true, true>(F.lds + RING_OFF, g, S, E, F.wave);
        if (BOTH(1)) GRID_BAR();
    }
    if (IN(2)) { RELANE(); p2_scan(F); if (BOTH(2)) GRID_BAR(); }
    if (IN(3)) { RELANE(); p3_mixer(F); VM_WAIT(); __syncthreads(); }
    if (IN(4)) {
        pg8::Gemm g{F.MIXIN, F.Wout_t, M, D, D}; pg8::OwnPanelOrder S{(int)blockIdx.x, 4};
        pg8::EpiRes E{F.H0, F.T1, ALPHA};
        pg8::gemm_phase<pg8::EpiRes, pg8::OwnPanelOrder, true, true>(F.lds + RING_OFF, g, S, E, F.wave);
        VM_WAIT(); __syncthreads();
    }
    if (IN(5)) { RELANE(); p5_ln_router(F); if (BOTH(5)) GRID_BAR(); }
    if (IN(6)) { RELANE(); p6_assign(F); if (BOTH(6)) GRID_BAR(); }
    if (IN(7)) {
        if (!IN(6)) { RELANE(); moe_layout(F); }
        pg8::Gemm g{(const bf16*)F.H1F8, (const bf16*)F.Wgu8, SLOTS, 1024, D / 2, F.stok}; pg8::GroupedOrder S;     S.init((const LAS int*)(F.lds + PP_OFF), F.G, (int)blockIdx.x);
        pg8::EpiGateUp E{F.HID};
        pg8::gemm_phase<pg8::EpiGateUp, pg8::GroupedOrder, true, true, true, true>(F.lds + RING_OFF, g, S, E, F.wave);
        if (BOTH(7)) GRID_BAR();
    }
    if (IN(8)) {
        if (!IN(6)) { RELANE(); moe_layout(F); }
        pg8::Gemm g{(const bf16*)F.HID, (const bf16*)F.Wd8, SLOTS, 1024, DEXP / 2}; pg8::GroupedOrder S;     S.init((const LAS int*)(F.lds + PP_OFF), F.G, (int)blockIdx.x);
        pg8::EpiDown E{F.YP, F.PW};
        pg8::gemm_phase<pg8::EpiDown, pg8::GroupedOrder, true, true, false, true>(F.lds + RING_OFF, g, S, E, F.wave);
        if (BOTH(8)) GRID_BAR();
    }
    if (IN(9)) { RELANE(); p9_final(F); }
#undef IN
#undef BOTH
#undef GRID_BAR
#undef RELANE
}

extern "C" void kernel_launch(void* const* d_in, const int* in_sizes, int n_in, void* d_out, int out_size, void* d_ws, size_t ws_size, hipStream_t stream) {
    static int grid = 0;
    if (grid == 0) {
        if (n_in != 20 || in_sizes[0] != M * D || out_size != M * D || ws_size < WS_END) { fprintf(stderr, "kernel_launch: built for 20 inputs, x and out of %d floats, >= %zu bytes of workspace; got n_in %d, in0 %d, out %d, ws %zu; nothing launched\n", M * D, (size_t)WS_END, n_in, n_in > 0 ? in_sizes[0] : -1, out_size, ws_size); grid = -1; return; }
        int dev = 0, cus = 0, per_cu = 0;
        if (hipGetDevice(&dev) != hipSuccess || hipDeviceGetAttribute(&cus, hipDeviceAttributeMultiprocessorCount, dev) != hipSuccess) { fprintf(stderr, "kernel_launch: hipGetDevice / hipDeviceGetAttribute failed; nothing launched\n"); grid = -1; return; }
        if (hipFuncSetAttribute((const void*)hrp_fwd, hipFuncAttributeMaxDynamicSharedMemorySize, LDS_BYTES) != hipSuccess) { fprintf(stderr, "kernel_launch: hipFuncSetAttribute failed (%d bytes of dynamic LDS); nothing launched\n", LDS_BYTES); grid = -1; return; }
        if (hipOccupancyMaxActiveBlocksPerMultiprocessor(&per_cu, (const void*)hrp_fwd, NWAVES * 64, LDS_BYTES) != hipSuccess || per_cu < 1)
            fprintf(stderr, "kernel_launch: note: the occupancy query reports %d workgroups per CU; the launch goes ahead with one per CU\n", per_cu);
        (void)hipGetLastError();
        grid = cus;
        if (grid != 256) fprintf(stderr, "kernel_launch: %d CUs; this kernel is built for 256 and will leave the output unwritten\n", grid);
    }
    if (grid < 0) return;
    if (hipMemsetAsync((char*)d_ws + WS_CTL, 0, CTL_ZERO_BYTES, stream) != hipSuccess) { fprintf(stderr, "kernel_launch: hipMemsetAsync of the control words failed; nothing launched\n"); return; }
    Args a{};
    for (int i = 0; i < 20; ++i) a.in[i] = (const float*)d_in[i];
    a.out = (float*)d_out; a.ws = (unsigned char*)d_ws;
    for (int li = 0; li < N_LAUNCHES; ++li) {
        a.ph_lo = (N_LAUNCHES == PER_PHASE) ? li : 0; a.ph_hi = (N_LAUNCHES == PER_PHASE) ? li + 1 : PER_PHASE;
        hipLaunchKernelGGL(hrp_fwd, dim3(grid), dim3(NWAVES * 64), LDS_BYTES, stream, a);
        const hipError_t le = hipPeekAtLastError();
        if (le != hipSuccess) { fprintf(stderr, "kernel_launch: launch %d failed: %s\n", li, hipGetErrorName(le)); break; }
    }
}
```

```cpp
#include <hip/hip_runtime.h>
#include <cstdio>
#include <cstdint>
#ifndef MK_N_LAUNCHES
#define MK_N_LAUNCHES 1
#endif
namespace pg8 {
#define PG8_LAS __attribute__((address_space(3)))
typedef unsigned short bf16_t;
typedef short bf16x8 __attribute__((ext_vector_type(8)));
typedef float f32x4 __attribute__((ext_vector_type(4)));
typedef unsigned u32x4 __attribute__((ext_vector_type(4)));
constexpr int BM = 256, BK = 64, HALF = 128, HTB = HALF * BK * 2  , STAGE_BYTES = 8 * HTB, NXCD = 8, WGM = 8;

__host__ __device__ __forceinline__ int lds_byte(int r, int c) { const int st = (r >> 4) * 2 + (c >> 5), rr = r & 15, cc = c & 31, ob = rr * 64 + cc * 2; return st * 1024 + (ob ^ (((ob >> 9) & 1) << 5)); }
__host__ __device__ __forceinline__ void stage_rc(int b, int& R, int& C) { const int st = b / 1024, sb = b % 1024, swz = sb ^ (((sb >> 9) & 1) << 5); R = (st >> 1) * 16 + swz / 64; C = (st & 1) * 32 + (swz % 64) / 2; }
__host__ __device__ __forceinline__ int perm32(int rho) { const int n = rho >> 4, i = rho & 15; return 8 * (i >> 2) + 4 * n + (i & 3); }

struct Unit { int pm, pn; };
struct Gemm { const bf16_t* A; const bf16_t* Bt; int M, N, K; const int* gidx; };

struct StaticOrder {
    int nM, nN, nwg, G, c;
    __host__ __device__ void init(int M, int N, int G_, int c_) { nM = M / BM; nN = N / BM; nwg = nM * nN; G = G_; c = c_; }
    __host__ __device__ bool next(int i, Unit& u) const {
        const long L = (long)i * G + c; if (L >= nwg) return false;
        int wgid = (int)L; { const int q = nwg / NXCD, r = nwg % NXCD, xcd = wgid % NXCD, off = wgid / NXCD; wgid = (xcd < r ? xcd * (q + 1) : r * (q + 1) + (xcd - r) * q) + off; }
        const int nig = WGM * nN, gid = wgid / nig, fm = gid * WGM, gsz = (nM - fm) < WGM ? (nM - fm) : WGM;
        u.pm = fm + ((wgid % nig) % gsz); u.pn = (wgid % nig) / gsz; return true;
    }
    __device__ __forceinline__ void a_ready(const Unit&) const {}
    __device__ __forceinline__ void done(const Unit&) const {}
};

__device__ __forceinline__ unsigned cvt_pk_bf16(float lo, float hi) { unsigned r; asm volatile("v_cvt_pk_bf16_f32 %0, %1, %2" : "=v"(r) : "v"(lo), "v"(hi)); return r; }
__device__ __forceinline__ float bf_lo(unsigned w) { return __uint_as_float(w << 16); }
__device__ __forceinline__ float bf_hi(unsigned w) { return __uint_as_float(w & 0xffff0000u); }
__device__ __forceinline__ unsigned pk4_fp8(const f32x4 v) { int w = __builtin_amdgcn_cvt_pk_fp8_f32(v[0], v[1], 0, false); w = __builtin_amdgcn_cvt_pk_fp8_f32(v[2], v[3], w, true); return (unsigned)w; }

struct EpiProj {
    static constexpr bool PERM = true, AFTER_DRAIN = false;
    bf16_t *Q, *V; const float* rope;
    __device__ __forceinline__ void operator()(const f32x4 (&acc)[2][2][4][2], const Unit& u, int wr, int wc, int fr, int fq) const {
        const int row0 = u.pm * BM + wr * 64 + fr, lc0 = wc * 32 + 8 * fq;
        if (u.pn < 2) {
            bf16_t* base = Q + (size_t)u.pn * ((size_t)65536 * 256); const float sc = u.pn == 0 ? 1.0f : 0.125f;
#pragma unroll
            for (int ai = 0; ai < 2; ++ai)
#pragma unroll
                for (int m = 0; m < 4; ++m) { const int row = row0 + ai * HALF + m * 16; const int pos = 16 + (row & 4095);
#pragma unroll
                    for (int bj = 0; bj < 2; ++bj) { const int lc = lc0 + bj * HALF; const int i0 = (lc & 63) >> 1;
                        const f32x4* tp = (const f32x4*)(rope + ((size_t)pos * 32 + i0) * 2); const f32x4 t0 = tp[0], t1 = tp[1];
                        const f32x4 v0 = acc[ai][bj][m][0], v1 = acc[ai][bj][m][1];
                        const float o0 = (v0[0] * t0[0] - v0[1] * t0[1]) * sc, o1 = (v0[0] * t0[1] + v0[1] * t0[0]) * sc;
                        const float o2 = (v0[2] * t0[2] - v0[3] * t0[3]) * sc, o3 = (v0[2] * t0[3] + v0[3] * t0[2]) * sc;
                        const float o4 = (v1[0] * t1[0] - v1[1] * t1[1]) * sc, o5 = (v1[0] * t1[1] + v1[1] * t1[0]) * sc;
                        const float o6 = (v1[2] * t1[2] - v1[3] * t1[3]) * sc, o7 = (v1[2] * t1[3] + v1[3] * t1[2]) * sc;
                        u32x4 w; w.x = cvt_pk_bf16(o0, o1); w.y = cvt_pk_bf16(o2, o3); w.z = cvt_pk_bf16(o4, o5); w.w = cvt_pk_bf16(o6, o7);
                        *(u32x4*)(base + (size_t)row * 256 + lc) = w; } }
        } else {
            bf16_t* base = V + (size_t)((u.pn - 2) >> 1) * ((size_t)65536 * 512); const int colt = (u.pn & 1) * 256;
#pragma unroll
            for (int ai = 0; ai < 2; ++ai)
#pragma unroll
                for (int m = 0; m < 4; ++m) { bf16_t* rowp = base + (size_t)(row0 + ai * HALF + m * 16) * 512 + colt + lc0;
#pragma unroll
                    for (int bj = 0; bj < 2; ++bj) { const f32x4 v0 = acc[ai][bj][m][0], v1 = acc[ai][bj][m][1];
                        u32x4 w; w.x = cvt_pk_bf16(v0[0], v0[1]); w.y = cvt_pk_bf16(v0[2], v0[3]); w.z = cvt_pk_bf16(v1[0], v1[1]); w.w = cvt_pk_bf16(v1[2], v1[3]);
                        *(u32x4*)(rowp + bj * HALF) = w; } }
        }
    }
};
struct EpiMix {
    static constexpr bool PERM = true, AFTER_DRAIN = false;
    bf16_t* T;
    __device__ __forceinline__ void operator()(const f32x4 (&acc)[2][2][4][2], const Unit& u, int wr, int wc, int fr, int fq) const {
        const int row0 = u.pm * BM + wr * 64 + fr, col0 = u.pn * BM + wc * 32 + 8 * fq;
#pragma unroll
        for (int ai = 0; ai < 2; ++ai)
#pragma unroll
            for (int m = 0; m < 4; ++m) { bf16_t* rowp = T + (size_t)(row0 + ai * HALF + m * 16) * 1024 + col0;
#pragma unroll
                for (int bj = 0; bj < 2; ++bj) { const f32x4 v0 = acc[ai][bj][m][0], v1 = acc[ai][bj][m][1];
                    u32x4 w; w.x = cvt_pk_bf16(v0[0], v0[1]); w.y = cvt_pk_bf16(v0[2], v0[3]); w.z = cvt_pk_bf16(v1[0], v1[1]); w.w = cvt_pk_bf16(v1[2], v1[3]);
                    *(u32x4*)(rowp + bj * HALF) = w; } }
    }
};
struct EpiGateUp {
    static constexpr bool PERM = true, AFTER_DRAIN = false;
    unsigned char* HID;
    __device__ __forceinline__ void operator()(const f32x4 (&acc)[2][2][4][2], const Unit& u, int wr, int wc, int fr, int fq) const {
        const int row0 = u.pm * BM + wr * 64 + fr, hc = (u.pn & 3) * 128 + wc * 32 + 8 * fq;
#pragma unroll
        for (int ai = 0; ai < 2; ++ai)
#pragma unroll
            for (int m = 0; m < 4; ++m) { float h[8];
#pragma unroll
                for (int n = 0; n < 2; ++n)
#pragma unroll
                    for (int j = 0; j < 4; ++j) { const float g = acc[ai][0][m][n][j] * 0.03125f, up = acc[ai][1][m][n][j] * 0.03125f; h[4 * n + j] = g * up * __builtin_amdgcn_rcpf(1.0f + __expf(-g)); }
                typedef unsigned u32x2e __attribute__((ext_vector_type(2))); u32x2e w; w.x = pk4_fp8((f32x4){h[0], h[1], h[2], h[3]}); w.y = pk4_fp8((f32x4){h[4], h[5], h[6], h[7]});
                *(u32x2e*)(HID + (size_t)(row0 + ai * HALF + m * 16) * 512 + hc) = w; }
    }
};
struct EpiDown {
    static constexpr bool PERM = true, AFTER_DRAIN = false;
    unsigned char* YP; const float* PW;
    __device__ __forceinline__ void operator()(const f32x4 (&acc)[2][2][4][2], const Unit& u, int wr, int wc, int fr, int fq) const {
        const int row0 = u.pm * BM + wr * 64 + fr, col0 = (u.pn & 3) * BM + wc * 64 + 16 * fq;
        float pwv[8];
#pragma unroll
        for (int i = 0; i < 8; ++i) pwv[i] = PW[row0 + (i >> 2) * HALF + (i & 3) * 16];
        asm volatile("" ::: "memory");
#pragma unroll
        for (int ai = 0; ai < 2; ++ai)
#pragma unroll
            for (int m = 0; m < 4; ++m) { const int row = row0 + ai * HALF + m * 16; const float sc = pwv[ai * 4 + m] * 2.0f;
                u32x4 w; w.x = pk4_fp8(acc[ai][0][m][0] * sc); w.y = pk4_fp8(acc[ai][0][m][1] * sc); w.z = pk4_fp8(acc[ai][1][m][0] * sc); w.w = pk4_fp8(acc[ai][1][m][1] * sc);
                *(u32x4*)(YP + (size_t)row * 1024 + col0) = w; }
    }
};
struct OwnPanelOrder {
    int c, ntn;
    __device__ __forceinline__ bool next(int i, Unit& u) const { if (i >= ntn) return false; u.pm = c; u.pn = i; return true; }
    __device__ __forceinline__ void a_ready(const Unit&) const {}
    __device__ __forceinline__ void done(const Unit&) const {}
};
struct GroupedOrder {
    const PG8_LAS int* pp; int nwg, G, c;
    __device__ __forceinline__ void init(const PG8_LAS int* pp_, int G_, int c_) { pp = pp_; nwg = pp_[32] * 4; G = G_; c = c_; }
    __device__ __forceinline__ bool next(int i, Unit& u) const {
        const long L = (long)i * G + c; if (L >= nwg) return false;
        int wgid = (int)L; { const int q = nwg / NXCD, r = nwg % NXCD, xcd = wgid % NXCD, off = wgid / NXCD; wgid = (xcd < r ? xcd * (q + 1) : r * (q + 1) + (xcd - r) * q) + off; }
        const int panel = wgid >> 2; int e = 0;
#pragma unroll
        for (int k = 1; k < 32; ++k) e += (pp[k] <= panel) ? 1 : 0;
        u.pm = panel; u.pn = e * 4 + (wgid & 3); return true;
    }
    __device__ __forceinline__ void a_ready(const Unit&) const {}
    __device__ __forceinline__ void done(const Unit&) const {}
};
__device__ __forceinline__ void gather_off(const int* gidx, int pm, int K, int tid, unsigned (&v0)[2], unsigned (&v1)[2]) {
#pragma unroll
    for (int i = 0; i < 2; ++i) { int R, C; stage_rc(tid * 16 + i * 8192, R, C); v0[i] = (unsigned)(gidx[pm * 256 + R] * K + C) * 2u; v1[i] = (unsigned)(gidx[pm * 256 + 128 + R] * K + C) * 2u; }
}
typedef int v8i32 __attribute__((ext_vector_type(8))); typedef int v4i32 __attribute__((ext_vector_type(4)));
__device__ __forceinline__ v8i32 cat16(const bf16x8 lo, const bf16x8 hi) { return __builtin_shufflevector(__builtin_bit_cast(v4i32, lo), __builtin_bit_cast(v4i32, hi), 0, 1, 2, 3, 4, 5, 6, 7); }
template <class Epi, class Sched, bool ALIGN_EPI = false, bool SP2 = false, bool GATHER = false, bool FP8 = false>
__device__ __forceinline__ void gemm_phase(PG8_LAS unsigned char* lds, const Gemm g, const Sched& S, const Epi& E, const int wid) {
    int lane; asm volatile("v_mbcnt_lo_u32_b32 %0, -1, 0\n\tv_mbcnt_hi_u32_b32 %0, -1, %0" : "=v"(lane));
    const int tid = wid * 64 + lane, wr = wid >> 2, wc = wid & 3, fr = lane & 15, fq = lane >> 4;
    const int K = g.K, nt = K / BK;
    unsigned voffA[2], voffB[2];
#pragma unroll
    for (int i = 0; i < 2; ++i) { int R, C; stage_rc(tid * 16 + i * 8192, R, C); const int Rb = Epi::PERM ? ((R & ~31) + perm32(R & 31)) : R;
        voffA[i] = (unsigned)(R * K + C) * 2u; voffB[i] = (unsigned)(Rb * K + C) * 2u; }
    static_assert(SP2 || !GATHER, "GATHER is written for the SP2 loop");
    unsigned cv0[2] = {0u, 0u}, cv1[2] = {0u, 0u}, nv0[2] = {0u, 0u}, nv1[2] = {0u, 0u};
    const size_t kstep = (size_t)(BK * 2);
    const size_t hstep = (size_t)HALF * K * 2;
    const size_t tstep = 2 * hstep;
    const unsigned ldsw = (unsigned)wid * 1024u;
    const int aoff = lds_byte(wr * 64 + fr, fq * 8), boff = lds_byte(wc * 32 + fr, fq * 8);
#define PG8_SA(b, h) (((b) * 2 + (h)) * HTB)
#define PG8_SB(b, h) ((4 + (b) * 2 + (h)) * HTB)
#define PG8_STAGE(bufoff, gbase, voff) do { _Pragma("unroll") for (int _i = 0; _i < 2; ++_i) \
        __builtin_amdgcn_global_load_lds((const unsigned*)((const char*)(gbase) + (voff)[_i]), (PG8_LAS unsigned*)(lds + (bufoff) + ldsw + _i * 8192), 16, 0, 0); } while (0)
#define PG8_STAGE_A0C(bufoff, gb) do { if constexpr (GATHER) PG8_STAGE(bufoff, gb, cv0); else PG8_STAGE(bufoff, gb, voffA); } while (0)
#define PG8_STAGE_A1C(bufoff, gb) do { if constexpr (GATHER) PG8_STAGE(bufoff, gb, cv1); else PG8_STAGE(bufoff, (gb) + hstep, voffA); } while (0)
#define PG8_STAGE_A0X(bufoff, gb) do { if constexpr (GATHER) PG8_STAGE(bufoff, gb, sv0); else PG8_STAGE(bufoff, gb, voffA); } while (0)
#define PG8_STAGE_A1X(bufoff, gb) do { if constexpr (GATHER) PG8_STAGE(bufoff, gb, sv1); else PG8_STAGE(bufoff, (gb) + hstep, voffA); } while (0)
#define PG8_LDA(dst, b, h) do { _Pragma("unroll") for (int m = 0; m < 4; ++m) _Pragma("unroll") for (int k = 0; k < 2; ++k) dst[m][k] = *(const PG8_LAS bf16x8*)(lds + PG8_SA(b, h) + aoff + m * 2048 + k * 1024); } while (0)
#define PG8_LDB(dst, b, h) do { _Pragma("unroll") for (int n = 0; n < 2; ++n) _Pragma("unroll") for (int k = 0; k < 2; ++k) dst[n][k] = *(const PG8_LAS bf16x8*)(lds + PG8_SB(b, h) + boff + n * 2048 + k * 1024); } while (0)
#define PG8_MMA(ai, bj, At, Bt) do { __builtin_amdgcn_s_setprio(1); if constexpr (FP8) { _Pragma("unroll") for (int m = 0; m < 4; ++m) _Pragma("unroll") for (int n = 0; n < 2; ++n) \
        { const v8i32 a8_ = cat16(Bt[n][0], Bt[n][1]), b8_ = cat16(At[m][0], At[m][1]); asm volatile("v_mfma_scale_f32_16x16x128_f8f6f4 %0, %1, %2, %0, %3, %3 op_sel_hi:[0,0,0]" : "+v"(acc[ai][bj][m][n]) : "v"(a8_), "v"(b8_), "v"(mx_unit)); } } else { \
        _Pragma("unroll") for (int m = 0; m < 4; ++m) _Pragma("unroll") for (int n = 0; n < 2; ++n) _Pragma("unroll") for (int k = 0; k < 2; ++k) \
        acc[ai][bj][m][n] = __builtin_amdgcn_mfma_f32_16x16x32_bf16(Bt[n][k], At[m][k], acc[ai][bj][m][n], 0, 0, 0); } __builtin_amdgcn_s_setprio(0); } while (0)
#define PG8_WAIT_V(n) asm volatile("s_waitcnt vmcnt(" #n ")" ::: "memory")
#define PG8_WAIT_L(n) asm volatile("s_waitcnt lgkmcnt(" #n ")" ::: "memory")
#define PG8_BAR __builtin_amdgcn_s_barrier()
#define PG8_SCHED __builtin_amdgcn_sched_barrier(0)
    const int mx_unit = 0x7f7f7f7f;
    Unit cur, nxt; int ui = 0;
    if (!S.next(0, cur)) return;
    f32x4 acc[2][2][4][2];
#pragma unroll
    for (int a = 0; a < 2; ++a)
#pragma unroll
        for (int b = 0; b < 2; ++b)
#pragma unroll
            for (int m = 0; m < 4; ++m)
#pragma unroll
                for (int n = 0; n < 2; ++n) acc[a][b][m][n] = (f32x4){0.f, 0.f, 0.f, 0.f};
    bf16x8 At[4][2], B0[2][2], B1[2][2];
    const char* cA = (const char*)g.A + (GATHER ? (size_t)0 : (size_t)cur.pm * tstep); const char* cB = (const char*)g.Bt + (size_t)cur.pn * tstep;
    if constexpr (GATHER) gather_off(g.gidx, cur.pm, K, tid, cv0, cv1);
    S.a_ready(cur);
    if constexpr (SP2) {
        PG8_STAGE(PG8_SB(0, 0), cB, voffB); PG8_STAGE(PG8_SB(0, 1), cB + hstep, voffB); PG8_STAGE_A0C(PG8_SA(0, 0), cA); PG8_STAGE_A1C(PG8_SA(0, 1), cA);
        if (wr == 1) PG8_BAR;
        PG8_WAIT_V(2); PG8_BAR;
        PG8_STAGE(PG8_SB(1, 0), cB + kstep, voffB); PG8_STAGE_A0C(PG8_SA(1, 0), cA + kstep); PG8_STAGE(PG8_SB(1, 1), cB + hstep + kstep, voffB);
        PG8_WAIT_V(6); PG8_BAR;
    } else {
        PG8_STAGE(PG8_SB(0, 0), cB, voffB); PG8_STAGE(PG8_SA(0, 0), cA, voffA); PG8_STAGE(PG8_SB(0, 1), cB + hstep, voffB); PG8_STAGE(PG8_SA(0, 1), cA + hstep, voffA);
        if (wr == 1) PG8_BAR;
        PG8_WAIT_V(4); PG8_BAR;
        PG8_STAGE(PG8_SB(1, 0), cB + kstep, voffB); PG8_STAGE(PG8_SA(1, 0), cA + kstep, voffA); PG8_STAGE(PG8_SB(1, 1), cB + hstep + kstep, voffB);
        PG8_WAIT_V(6); PG8_BAR;
    }
    for (;;) {
        const bool has_next = S.next(ui + 1, nxt);
        if constexpr (GATHER) { if (has_next) gather_off(g.gidx, nxt.pm, K, tid, nv0, nv1); else { nv0[0] = cv0[0]; nv0[1] = cv0[1]; nv1[0] = cv1[0]; nv1[1] = cv1[1]; } }
        const char* nA = GATHER ? cA : (has_next ? (const char*)g.A + (size_t)nxt.pm * tstep : cA); const char* nB = has_next ? (const char*)g.Bt + (size_t)nxt.pn * tstep : cB;
#pragma unroll 1
        for (int t = 0; t < nt; t += 2) {
            const bool last = (t == nt - 2);
            const char* a1 = cA + (size_t)(t + 1) * kstep;
            const char* a2 = last ? nA : cA + (size_t)(t + 2) * kstep; const char* b2 = last ? nB : cB + (size_t)(t + 2) * kstep;
            const char* a3 = a2 + kstep; const char* b3 = b2 + kstep;
            if (last && has_next) S.a_ready(nxt);
            unsigned sv0[2], sv1[2]; sv0[0] = last ? nv0[0] : cv0[0]; sv0[1] = last ? nv0[1] : cv0[1]; sv1[0] = last ? nv1[0] : cv1[0]; sv1[1] = last ? nv1[1] : cv1[1];
            if constexpr (SP2) {
            PG8_LDB(B0, 0, 0); PG8_LDB(B1, 0, 1); PG8_SCHED; PG8_LDA(At, 0, 0); PG8_STAGE_A1C(PG8_SA(1, 1), a1);
            PG8_WAIT_V(8); PG8_WAIT_L(0); PG8_BAR; PG8_MMA(0, 0, At, B0); PG8_MMA(0, 1, At, B1); PG8_BAR; PG8_SCHED;
            PG8_LDA(At, 0, 1); PG8_STAGE(PG8_SB(0, 0), b2, voffB); PG8_STAGE(PG8_SB(0, 1), b2 + hstep, voffB); PG8_STAGE_A0X(PG8_SA(0, 0), a2);
            PG8_WAIT_V(8); PG8_WAIT_L(0); PG8_BAR; PG8_MMA(1, 0, At, B0); PG8_MMA(1, 1, At, B1); PG8_BAR; PG8_SCHED;
            PG8_LDB(B0, 1, 0); PG8_LDB(B1, 1, 1); PG8_SCHED; PG8_LDA(At, 1, 0); PG8_STAGE_A1X(PG8_SA(0, 1), a2);
            PG8_WAIT_V(8); PG8_WAIT_L(0); PG8_BAR; PG8_MMA(0, 0, At, B0); PG8_MMA(0, 1, At, B1); PG8_BAR; PG8_SCHED;
            PG8_LDA(At, 1, 1); PG8_STAGE(PG8_SB(1, 0), b3, voffB); PG8_STAGE(PG8_SB(1, 1), b3 + hstep, voffB); PG8_STAGE_A0X(PG8_SA(1, 0), a3);
            PG8_WAIT_V(8); PG8_WAIT_L(0); PG8_BAR; PG8_MMA(1, 0, At, B0); PG8_MMA(1, 1, At, B1); PG8_BAR; PG8_SCHED;
            } else {
            PG8_LDB(B0, 0, 0); PG8_SCHED; PG8_LDA(At, 0, 0); PG8_STAGE(PG8_SA(1, 1), a1 + hstep, voffA);
            PG8_WAIT_L(8); PG8_BAR; PG8_WAIT_L(0); PG8_MMA(0, 0, At, B0); PG8_BAR; PG8_SCHED;
            PG8_LDB(B1, 0, 1); PG8_STAGE(PG8_SB(0, 0), b2, voffB);
            PG8_BAR; PG8_WAIT_L(0); PG8_MMA(0, 1, At, B1); PG8_BAR;
            PG8_LDA(At, 0, 1); PG8_STAGE(PG8_SA(0, 0), a2, voffA);
            PG8_BAR; PG8_WAIT_L(0); PG8_MMA(1, 0, At, B0); PG8_BAR; PG8_SCHED;
            PG8_STAGE(PG8_SB(0, 1), b2 + hstep, voffB);
            PG8_WAIT_V(6); PG8_BAR; PG8_MMA(1, 1, At, B1); PG8_BAR;
            PG8_LDB(B0, 1, 0); PG8_SCHED; PG8_LDA(At, 1, 0); PG8_STAGE(PG8_SA(0, 1), a2 + hstep, voffA);
            PG8_WAIT_L(8); PG8_BAR; PG8_WAIT_L(0); PG8_MMA(0, 0, At, B0); PG8_BAR; PG8_SCHED;
            PG8_LDB(B1, 1, 1); PG8_STAGE(PG8_SB(1, 0), b3, voffB);
            PG8_BAR; PG8_WAIT_L(0); PG8_MMA(0, 1, At, B1); PG8_BAR;
            PG8_LDA(At, 1, 1); PG8_STAGE(PG8_SA(1, 0), a3, voffA);
            PG8_BAR; PG8_WAIT_L(0); PG8_MMA(1, 0, At, B0); PG8_BAR; PG8_SCHED;
            PG8_STAGE(PG8_SB(1, 1), b3 + hstep, voffB);
            PG8_WAIT_V(6); PG8_BAR; PG8_MMA(1, 1, At, B1); PG8_BAR;
            }
        }
        if constexpr (ALIGN_EPI) { if (wr == 0) PG8_BAR; }
        if constexpr (FP8) asm volatile("s_nop 15\n\ts_nop 15" ::: "memory");
        if constexpr (!Epi::AFTER_DRAIN) { E(acc, cur, wr, wc, fr, fq); S.done(cur); }
        if (!has_next) break;
#pragma unroll
        for (int a = 0; a < 2; ++a)
#pragma unroll
            for (int b = 0; b < 2; ++b)
#pragma unroll
                for (int m = 0; m < 4; ++m)
#pragma unroll
                    for (int n = 0; n < 2; ++n) acc[a][b][m][n] = (f32x4){0.f, 0.f, 0.f, 0.f};
        cur = nxt; cA = nA; cB = nB; ++ui;
        if constexpr (GATHER) { cv0[0] = nv0[0]; cv0[1] = nv0[1]; cv1[0] = nv1[0]; cv1[1] = nv1[1]; }
        if constexpr (ALIGN_EPI) { if (wr == 1) PG8_BAR; }
    }
    PG8_WAIT_V(0);
    if constexpr (!ALIGN_EPI) { if (wr == 0) PG8_BAR; }
    PG8_BAR;
    if constexpr (Epi::AFTER_DRAIN) { E.fused(acc, cur, wr, wc, fr, fq, lds, wid, lane); S.done(cur); }
#undef PG8_SA
#undef PG8_SB
#undef PG8_STAGE
#undef PG8_LDA
#undef PG8_STAGE_A0C
#undef PG8_STAGE_A1C
#undef PG8_STAGE_A0X
#undef PG8_STAGE_A1X
#undef PG8_LDB
#undef PG8_MMA
#undef PG8_WAIT_V
#undef PG8_WAIT_L
#undef PG8_BAR
#undef PG8_SCHED
}
}

constexpr int NWAVES = 8;
constexpr int N_LAUNCHES = MK_N_LAUNCHES;
constexpr int PER_PHASE = 10;

constexpr int BATCH = 16, SEQ = 4096, D = 1024, NMETA = 16;
constexpr int M = BATCH * SEQ;
constexpr int NPROJ = 2048, NEXP = 32, DEXP = 512;
constexpr int NPANEL_MAX = 544, SLOTS = NPANEL_MAX * 256;
constexpr float LN_EPS = 1e-5f, GN_EPS = 1e-6f;
constexpr float ALPHA = 1.189207115002721f;

constexpr size_t MiB = 1u << 20;
constexpr size_t WS_CTL = 0, CTL_ZERO_BYTES = 1 * MiB;
constexpr size_t WS_WIN = 2 * MiB;
constexpr size_t WS_WOUT = 6 * MiB;
constexpr size_t WS_WPOOL = 8 * MiB;
constexpr size_t WS_RW = 8 * MiB + 256 * 1024;
constexpr size_t WS_METAK = 8 * MiB + 512 * 1024;
constexpr size_t WS_METAV = WS_METAK + 16 * 256 * 4;
constexpr size_t WS_METAU = WS_METAV + 16 * 512 * 4;
constexpr size_t WS_ROPE = 9 * MiB;
constexpr size_t WS_TOKE = 12 * MiB;
constexpr size_t WS_TOKL = WS_TOKE + (size_t)M * 4;
constexpr size_t WS_TOKW = WS_TOKL + (size_t)M * 4;
constexpr size_t WS_TOKS = WS_TOKW + (size_t)M * 8;
constexpr size_t WS_CNT = 14 * MiB;
constexpr size_t WS_PW = 15 * MiB;
constexpr size_t WS_STOK = 16 * MiB;
constexpr size_t WS_WGU = 32 * MiB;
constexpr size_t WS_WD = 96 * MiB;
constexpr size_t WS_ST = 128 * MiB;
constexpr size_t WS_H0 = 160 * MiB;
constexpr size_t WS_Q = 288 * MiB, WS_K = 320 * MiB;
constexpr size_t WS_V = 352 * MiB, WS_GATE = 416 * MiB, WS_U = 480 * MiB;
constexpr size_t WS_MIXIN = 544 * MiB;
constexpr size_t WS_T1 = 672 * MiB;
constexpr size_t WS_H1B = 288 * MiB;
constexpr size_t WS_HID = 688 * MiB;
constexpr size_t WS_H1F8 = 928 * MiB;
constexpr size_t WS_YP = 416 * MiB;
constexpr size_t WS_END = 992 * MiB;
static_assert(WS_ROPE + (size_t)4112 * 32 * 8 <= WS_TOKE && WS_TOKS + (size_t)M * 8 <= WS_CNT && WS_PW + (size_t)SLOTS * 4 <= WS_WGU, "small tables");
static_assert(WS_K == WS_Q + (size_t)M * 256 * 2 && WS_GATE == WS_V + (size_t)M * 512 * 2 && WS_U == WS_GATE + (size_t)M * 512 * 2, "EpiProj addresses K, gate, u relative to Q, V");
static_assert(WS_STOK + (size_t)SLOTS * 4 <= WS_WGU && WS_YP + (size_t)SLOTS * 1024 <= WS_HID && WS_HID + (size_t)SLOTS * 512 <= WS_H1F8 && WS_H1F8 + (size_t)M * 1024 <= WS_END && WS_WGU + (size_t)32 * 1024 * 1024 <= WS_WD && WS_WD + (size_t)32 * 1024 * 512 <= WS_ST && WS_T1 + (size_t)M * 1024 * 2 <= WS_END, "d_ws map");
constexpr int CW_BAR = 4096;

constexpr int RING_OFF = 0, RING_BYTES = 131072;
constexpr int LDSCTL_OFF = RING_BYTES;
constexpr int PP_OFF = LDSCTL_OFF, TOT_OFF = LDSCTL_OFF + 192, BEF_OFF = LDSCTL_OFF + 320, BASE_OFF = LDSCTL_OFF + 448, LCNT_OFF = LDSCTL_OFF + 576, MISC_OFF = LDSCTL_OFF + 768;
constexpr int LDS_BYTES = 147456;
static_assert(MISC_OFF + 128 <= LDS_BYTES, "LDS map");
#define GAS __attribute__((address_space(1)))
#define LAS __attribute__((address_space(3)))
typedef unsigned short bf16;
typedef unsigned v4u __attribute__((ext_vector_type(4)));
typedef float f32x4 __attribute__((ext_vector_type(4)));
typedef short bf16x8 __attribute__((ext_vector_type(8)));
typedef GAS unsigned gu32;
typedef GAS unsigned long long gu64;
#define RLX_AGENT __ATOMIC_RELAXED, __HIP_MEMORY_SCOPE_AGENT
#define LDS_WAIT() asm volatile("s_waitcnt lgkmcnt(0)" ::: "memory")
#define VM_WAIT() asm volatile("s_waitcnt vmcnt(0)" ::: "memory")
__device__ __forceinline__ unsigned long long rt() { return __builtin_amdgcn_s_memrealtime(); }
__device__ __forceinline__ unsigned f2bf(float f) { unsigned u = __builtin_bit_cast(unsigned, f); return (u + 0x7fffu + ((u >> 16) & 1u)) >> 16; }
__device__ __forceinline__ unsigned pk2(float lo, float hi) { return f2bf(lo) | (f2bf(hi) << 16); }

#define XB_TMO      128
#define XB_XCNT(j)  (256  + 64 * (j))
#define XB_XSUB(j)  (1280 + 64 * (j))
#define XB_XGEN(j)  (2304 + 64 * (j))
#define XB_TOP      3328
#define XB_TOPGEN   3392
#define XCD_BAR_WORDS 3456
#define XB_SPIN_CAP (1u << 18)

__device__ __forceinline__ unsigned xb_ld(unsigned* p)              { return __hip_atomic_load(p, __ATOMIC_RELAXED, __HIP_MEMORY_SCOPE_AGENT); }
__device__ __forceinline__ unsigned xb_add(unsigned* p, unsigned v) { return __hip_atomic_fetch_add(p, v, __ATOMIC_RELAXED, __HIP_MEMORY_SCOPE_AGENT); }
__device__ __forceinline__ unsigned xb_xcc_id() { return (unsigned)__builtin_amdgcn_s_getreg((3 << 11) | 20) & 0xFu; }
#define XB_SPIN(cond, bar) do { unsigned _sp = 0; while (cond) { __builtin_amdgcn_s_sleep(1); \
    if ((++_sp & 255u) == 0u) { if (xb_ld(&(bar)[XB_TMO])) break; if (_sp > XB_SPIN_CAP) { atomicAdd(&(bar)[XB_TMO], 1u); break; } } } } while (0)

struct XcdBarrier {
    unsigned* bar; unsigned x;
    volatile LAS unsigned* st;
};

__device__ __forceinline__ XcdBarrier xcd_barrier_post(unsigned* bar, volatile LAS unsigned* st) {
    XcdBarrier b; b.bar = bar; b.x = xb_xcc_id(); b.st = st;
    if (threadIdx.x == 0) (void)xb_add(&bar[XB_XCNT(b.x)], 1u);
    return b;
}
__device__ __forceinline__ void xcd_barrier_complete(unsigned* bar, unsigned x, unsigned& nloc, unsigned& nx) {
    const unsigned G = gridDim.x * gridDim.y * gridDim.z;
    unsigned sum, cnt, mine, sp = 0u;
    for (;;) {
        sum = 0u; cnt = 0u; mine = 0u;
#pragma unroll
        for (unsigned j = 0; j < 16; ++j) { const unsigned c = xb_ld(&bar[XB_XCNT(j)]); sum += c; cnt += (c > 0u) ? 1u : 0u; mine = (j == x) ? c : mine; }
        if (sum == G) break;
        __builtin_amdgcn_s_sleep(1);
        if ((++sp & 255u) == 0u) { if (xb_ld(&bar[XB_TMO])) break; if (sp > XB_SPIN_CAP) { atomicAdd(&bar[XB_TMO], 1u); break; } }
    }
    nloc = mine > 0u ? mine : 1u; nx = cnt > 0u ? cnt : 1u;
}

__device__ __forceinline__ void xcd_barrier(const XcdBarrier& b) {
    asm volatile("s_waitcnt vmcnt(0)" ::: "memory");
    __syncthreads();
    if (threadIdx.x == 0) {
        unsigned* bar = b.bar;
        __builtin_amdgcn_s_waitcnt(0);
        unsigned nloc = b.st[0], nx = b.st[1];
        if (nloc == 0u) { xcd_barrier_complete(bar, b.x, nloc, nx); b.st[0] = nloc; b.st[1] = nx; }
        const unsigned old = xb_add(&bar[XB_XSUB(b.x)], 1u);
        const unsigned gen = old / nloc;
        if (old + 1u == (gen + 1u) * nloc) {
            __builtin_amdgcn_fence(__ATOMIC_RELEASE, "agent");
            asm volatile("s_waitcnt vmcnt(0)" ::: "memory");
            const unsigned og = xb_add(&bar[XB_TOP], 1u);
            const unsigned tg = og / nx;
            if (og + 1u == (tg + 1u) * nx) xb_add(&bar[XB_TOPGEN], 1u);
            else XB_SPIN(xb_ld(&bar[XB_TOPGEN]) == tg, bar);
            __builtin_amdgcn_fence(__ATOMIC_ACQUIRE, "agent");
            xb_add(&bar[XB_XGEN(b.x)], 1u);
            asm volatile("s_waitcnt vmcnt(0)" ::: "memory");
        } else {
            XB_SPIN(xb_ld(&bar[XB_XGEN(b.x)]) == gen, bar);
            __builtin_amdgcn_fence(__ATOMIC_ACQUIRE, "agent");
            asm volatile("s_waitcnt vmcnt(0)" ::: "memory");
        }
    }
    __syncthreads();
}

#define DI __device__ __forceinline__
typedef short v4i16_t __attribute__((ext_vector_type(4)));
typedef unsigned u32x2 __attribute__((ext_vector_type(2)));
typedef float f32x2 __attribute__((ext_vector_type(2)));
struct Frame {
    LAS unsigned char* lds;
    volatile LAS unsigned* MISC;
    gu32* ctl;
    int tid, lane, wave;
    int vcu, G;
    const float *x, *meta, *lne_g, *lne_b, *w_in, *pool_w, *pool_b, *pool_scale, *w_out, *ln1_g, *ln1_b, *rg_w, *rg_b, *re_w, *re_b, *w_gate, *w_up, *w_down, *ln2_g, *ln2_b;
    float* out;
    bf16 *Win_t, *Wout_t, *Wpool_t;
    unsigned char *Wgu8, *Wd8, *H1F8, *HID;
    float *RW, *metak, *metav, *metau, *rope, *PW; bf16* T1;
    unsigned *toke, *tokl; f32x2* tokw; int* toks; int* cnt; int* stok;
    bf16 *ST, *H0, *Qb, *Kb, *Vb, *Gb, *Ub, *MIXIN, *H1B; unsigned char* YP;
};
DI float wave_sum(float v) {
#pragma unroll
    for (int o = 1; o < 64; o <<= 1) v += __shfl_xor(v, o);
    return v;
}
DI float bf2f(bf16 v) { return __uint_as_float(((unsigned)v) << 16); }
DI float bflo(unsigned w) { return __uint_as_float(w << 16); }
DI float bfhi(unsigned w) { return __uint_as_float(w & 0xffff0000u); }
DI unsigned cvtpk(float lo, float hi) { return pg8::cvt_pk_bf16(lo, hi); }
DI unsigned pk4f8(float a, float b, float c, float d) { int w = __builtin_amdgcn_cvt_pk_fp8_f32(a, b, 0, false); w = __builtin_amdgcn_cvt_pk_fp8_f32(c, d, w, true); return (unsigned)w; }

template <int MODE> DI int rowmap(int n) {
    if (MODE == 1) { if (n < 512) { const int i = n & 63; return (n & ~63) + (i < 32 ? 2 * i : 2 * (i - 32) + 1); } return n; }
    if (MODE == 2) return 256 * (n >> 7) + (n & 127);
    if (MODE == 3) return 256 * (n >> 7) + 128 + (n & 127);
    if (MODE == 4) { const int o = n & 255; return (n & ~255) + 128 * ((o >> 3) & 1) + 32 * (o >> 6) + 8 * ((o >> 4) & 3) + (o & 7); }
    return n;
}
template <int MODE, bool F8 = false> DI void p0_transpose_item(const float* W, int K, int N, void* WTv, LAS float* scr, int item, int lane) {
    const int nblk = N / 32, kb = item / nblk, nb = item % nblk, k0 = 64 * kb, n0 = 32 * nb;
    f32x4 tv[8];
#pragma unroll
    for (int i = 0; i < 8; ++i) tv[i] = *(const GAS f32x4*)(W + (size_t)(k0 + i * 8 + (lane >> 3)) * N + n0 + 4 * (lane & 7));
#pragma unroll
    for (int i = 0; i < 8; ++i) { LAS float* d = scr + (i * 8 + (lane >> 3)) * 33 + 4 * (lane & 7); d[0] = tv[i].x; d[1] = tv[i].y; d[2] = tv[i].z; d[3] = tv[i].w; }
    LDS_WAIT(); asm volatile("" ::: "memory");
    const int c = lane & 7;
#pragma unroll
    for (int j = 0; j < 4; ++j) { const int n = (lane >> 3) + 8 * j; const LAS float* s = scr + (8 * c) * 33 + n;
        if constexpr (F8) { u32x2 o; o.x = pk4f8(32.f * s[0 * 33], 32.f * s[1 * 33], 32.f * s[2 * 33], 32.f * s[3 * 33]); o.y = pk4f8(32.f * s[4 * 33], 32.f * s[5 * 33], 32.f * s[6 * 33], 32.f * s[7 * 33]);
            *(GAS u32x2*)((unsigned char*)WTv + (size_t)rowmap<MODE>(n0 + n) * K + k0 + 8 * c) = o; }
        else { bf16* WT = (bf16*)WTv; v4u o; o.x = pk2(s[0 * 33], s[1 * 33]); o.y = pk2(s[2 * 33], s[3 * 33]); o.z = pk2(s[4 * 33], s[5 * 33]); o.w = pk2(s[6 * 33], s[7 * 33]);
            *(GAS v4u*)(WT + (size_t)rowmap<MODE>(n0 + n) * K + k0 + 8 * c) = o; } }
    LDS_WAIT(); asm volatile("" ::: "memory");
}
DI void ld_row(const float* xrow, f32x4 (&v)[4], int lane) {
    const GAS f32x4* xr = (const GAS f32x4*)xrow + lane;
#pragma unroll
    for (int j = 0; j < 4; ++j) v[j] = xr[64 * j];
}
DI void ln_regs(const f32x4 (&gv)[4], const f32x4 (&bv)[4], f32x4 (&v)[4], float eps) {
    float s = 0.f;
#pragma unroll
    for (int j = 0; j < 4; ++j) s += (v[j].x + v[j].y) + (v[j].z + v[j].w);
    const float mean = wave_sum(s) * (1.f / D); float s2 = 0.f;
#pragma unroll
    for (int j = 0; j < 4; ++j) { v[j] = v[j] - mean; s2 += (v[j].x * v[j].x + v[j].y * v[j].y) + (v[j].z * v[j].z + v[j].w * v[j].w); }
    const float rstd = 1.f / sqrtf(wave_sum(s2) * (1.f / D) + eps);
#pragma unroll
    for (int j = 0; j < 4; ++j) v[j] = v[j] * rstd * gv[j] + bv[j];
}
DI void ln_row(const float* xrow, const f32x4 (&gv)[4], const f32x4 (&bv)[4], f32x4 (&v)[4], int lane, float eps) { ld_row(xrow, v, lane); ln_regs(gv, bv, v, eps); }
DI void store_row_bf16(bf16* orow, const f32x4 (&v)[4], int lane) {
    GAS unsigned long long* o8 = (GAS unsigned long long*)orow + lane;
#pragma unroll
    for (int j = 0; j < 4; ++j) o8[64 * j] = (unsigned long long)pk2(v[j].x, v[j].y) | ((unsigned long long)pk2(v[j].z, v[j].w) << 32);
}
DI void p0_prologue(Frame& F) {
    LAS float* scr = (LAS float*)(F.lds + RING_OFF + F.wave * 16384);
    const int gw = F.vcu * NWAVES + F.wave, NGW = F.G * NWAVES;
    constexpr int I_IN = 16 * 64, I_OUT = 16 * 32, I_POOL = 4 * 8, I_G = 32 * 256, I_U = 32 * 256, I_D = 32 * 256;
    constexpr int NITEMS = I_IN + I_OUT + I_POOL + I_G + I_U + I_D;
    for (int it = gw; it < NITEMS; it += NGW) {
        int r = it;
        if (r < I_IN) { p0_transpose_item<1>(F.w_in, 1024, 2048, F.Win_t, scr, r, F.lane); continue; } r -= I_IN;
        if (r < I_OUT) { p0_transpose_item<0>(F.w_out, 1024, 1024, F.Wout_t, scr, r, F.lane); continue; } r -= I_OUT;
        if (r < I_POOL) { const int g = r >> 3; p0_transpose_item<0>(F.pool_w + g * 16384, 128, 128, F.Wpool_t + g * 16384, scr, r & 7, F.lane); continue; } r -= I_POOL;
        if (r < I_G) { const int e = r >> 8; p0_transpose_item<2, true>(F.w_gate + (size_t)e * 524288, 1024, 512, F.Wgu8 + (size_t)e * 1048576, scr, r & 255, F.lane); continue; } r -= I_G;
        if (r < I_U) { const int e = r >> 8; p0_transpose_item<3, true>(F.w_up + (size_t)e * 524288, 1024, 512, F.Wgu8 + (size_t)e * 1048576, scr, r & 255, F.lane); continue; } r -= I_U;
        { const int e = r >> 8; p0_transpose_item<4, true>(F.w_down + (size_t)e * 524288, 512, 1024, F.Wd8 + (size_t)e * 524288, scr, r & 255, F.lane); }
    }
    { f32x4 gv[4], bv[4];
#pragma unroll
      for (int j = 0; j < 4; ++j) { gv[j] = *(const f32x4*)(F.lne_g + 4 * F.lane + 256 * j); bv[j] = *(const f32x4*)(F.lne_b + 4 * F.lane + 256 * j); }
      f32x4 nx[4], ny[4]; ld_row(F.x + (size_t)gw * D, nx, F.lane); ld_row(F.x + (size_t)(gw + NGW) * D, ny, F.lane);
      for (int m = gw; m < M; m += NGW) { f32x4 v[4];
#pragma unroll
          for (int j = 0; j < 4; ++j) { v[j] = nx[j]; nx[j] = ny[j]; }
          if (m + 2 * NGW < M) ld_row(F.x + (size_t)(m + 2 * NGW) * D, ny, F.lane);
          ln_regs(gv, bv, v, LN_EPS); store_row_bf16(F.H0 + (size_t)m * D, v, F.lane); }
    }
    { const int gt = gw * 64 + F.lane, NT = NGW * 64;
      for (int idx = gt; idx < 4112 * 32; idx += NT) { const int pos = idx >> 5, i = idx & 31;
          const float inv = exp2f(-(float)i * 0.415241011860920f);
          const float ang = (float)pos * inv;
          const double a = (double)ang; const double k = __builtin_rint(a * 0.15915494309189535); const float rr = (float)__builtin_fma(-k, 6.283185307179586, a);
          F.rope[(size_t)idx * 2] = cosf(rr); F.rope[(size_t)idx * 2 + 1] = sinf(rr); }
      for (int idx = gt; idx < 36 * 1024; idx += NT) { const int c = idx >> 10, k = idx & 1023; F.RW[idx] = c < 4 ? F.rg_w[k * 4 + c] : F.re_w[k * 32 + (c - 4)]; }
    }
    if (blockIdx.x < 20) {
        __syncthreads();
        LAS float* ML = (LAS float*)(F.lds);
        LAS float* RED = (LAS float*)(F.lds + 65536);
        LAS float* OUTM = (LAS float*)(F.lds + 98304);
        { f32x4 gv[4], bv[4];
#pragma unroll
          for (int j = 0; j < 4; ++j) { gv[j] = *(const f32x4*)(F.lne_g + 4 * F.lane + 256 * j); bv[j] = *(const f32x4*)(F.lne_b + 4 * F.lane + 256 * j); }
          for (int rr = 0; rr < 2; ++rr) { const int m = F.wave * 2 + rr; f32x4 v[4]; ln_row(F.meta + (size_t)m * D, gv, bv, v, F.lane, LN_EPS);
#pragma unroll
              for (int j = 0; j < 4; ++j) *(LAS f32x4*)(ML + m * 1024 + 4 * F.lane + 256 * j) = v[j]; } }
        __syncthreads();
        const int item = blockIdx.x;
        const int col0 = item < 4 ? 256 + 64 * item : (item < 12 ? 512 + 64 * (item - 4) : 1536 + 64 * (item - 12));
        float acc[16];
#pragma unroll
        for (int m = 0; m < 16; ++m) acc[m] = 0.f;
        for (int kk = 0; kk < 128; ++kk) { const int k = F.wave * 128 + kk; const float wv = F.w_in[(size_t)k * 2048 + col0 + F.lane];
#pragma unroll
            for (int m = 0; m < 16; ++m) acc[m] += ML[m * 1024 + k] * wv; }
#pragma unroll
        for (int m = 0; m < 16; ++m) RED[(F.wave * 16 + m) * 64 + F.lane] = acc[m];
        __syncthreads();
        for (int o = F.tid; o < 1024; o += 512) { float s = 0.f;
#pragma unroll
            for (int w = 0; w < 8; ++w) s += RED[w * 1024 + o];
            OUTM[o] = s; }
        __syncthreads();
        for (int o = F.tid; o < 1024; o += 512) { const int m = o >> 6, ii = o & 63;
            if (item < 4) {
                const int i = ii >> 1; const float x1 = OUTM[m * 64 + i], x2 = OUTM[m * 64 + 32 + i];
                const float inv = exp2f(-(float)i * 0.415241011860920f); const float ang = (float)m * inv;
                const double a = (double)ang; const double kq = __builtin_rint(a * 0.15915494309189535); const float rr = (float)__builtin_fma(-kq, 6.283185307179586, a);
                const float cs = cosf(rr), sn = sinf(rr);
                F.metak[m * 256 + item * 64 + ii] = ((ii & 1) ? (x1 * sn + x2 * cs) : (x1 * cs - x2 * sn)) * 0.125f;
            } else if (item < 12) F.metav[m * 512 + (item - 4) * 64 + ii] = OUTM[o];
            else F.metau[m * 512 + (item - 12) * 64 + ii] = OUTM[o];
        }
        __syncthreads();
    }
}

DI f32x4 mma(bf16x8 xf, bf16x8 yf, f32x4 acc) { return __builtin_amdgcn_mfma_f32_16x16x32_bf16(xf, yf, acc, 0, 0, 0); }
DI bf16x8 frag_row(const LAS unsigned char* base, int stride, int row0, int k0, int lane) {
    return *(const LAS bf16x8*)(base + (row0 + (lane & 15)) * stride + (k0 + 8 * (lane >> 4)) * 2);
}
DI bf16x8 frag_tr(const LAS unsigned char* base, int stride, int k0, int x0, int lane) {
    const int g = lane >> 4, q = (lane & 15) >> 2, p = lane & 3;
    const LAS unsigned char* a = base + (k0 + 8 * g + q) * stride + (x0 + 4 * p) * 2;
    const v4i16_t lo = __builtin_amdgcn_ds_read_tr16_b64_v4i16((LAS v4i16_t*)a);
    const v4i16_t hi = __builtin_amdgcn_ds_read_tr16_b64_v4i16((LAS v4i16_t*)(a + 4 * stride));
    return __builtin_shufflevector(lo, hi, 0, 1, 2, 3, 4, 5, 6, 7);
}
constexpr int SQ = 144, SV = 272;
DI v4u scale8(v4u x, float z) { v4u o;
#pragma unroll
    for (int p = 0; p < 4; ++p) o[p] = cvtpk(bflo(x[p]) * z, bfhi(x[p]) * z);
    return o; }
DI void p2_scan(Frame& F) {
    constexpr int SVS = 80;
    LAS unsigned char* KS = F.lds; LAS unsigned char* VSL = F.lds + 18432;
    const int w = F.wave, lane = F.lane, fr = lane & 15, fq = lane >> 4, dt = w >> 1, vt = w & 1;
    for (int unit = blockIdx.x; unit < 256; unit += F.G) {
        const int b = unit >> 4, h = (unit >> 2) & 3, vs = unit & 3;
        const float lg = log2f(1.0f - exp2f(-5.0f - (float)h));
        const float cd = exp2f(128.0f * lg);
        const int kr0 = F.tid >> 3, kc8 = F.tid & 7, vr = F.tid >> 2, vc4 = F.tid & 3;
        const float z0 = exp2f((float)(127 - kr0) * lg), z1 = exp2f((float)(63 - kr0) * lg);
        const int d0 = 16 * dt + 4 * fq, vcol = vs * 32 + 16 * vt + fr;
        f32x4 st = {0.f, 0.f, 0.f, 0.f};
        for (int m = 0; m < 16; ++m) { const float zm = exp2f((float)(15 - m) * lg) * F.metav[m * 512 + h * 128 + vcol]; const f32x4 kk = *(const f32x4*)(F.metak + m * 256 + h * 64 + d0); st = st + kk * zm; }
        bf16* STb = F.ST + (size_t)((b * 4 + h) * 32) * 8192 + vcol * 64 + d0;
        const bf16* kp = F.Kb + ((size_t)b * 4096 + kr0) * 256 + h * 64 + kc8 * 8; const bf16* vp = F.Vb + ((size_t)b * 4096 + vr) * 512 + h * 128 + vs * 32 + vc4 * 8;
        v4u rk0[4], rk1[4], rvv[4];
#pragma unroll
        for (int u = 0; u < 4; ++u) { const size_t o = (size_t)u * 128; rk0[u] = *(const GAS v4u*)(kp + o * 256); rk1[u] = *(const GAS v4u*)(kp + (o + 64) * 256); rvv[u] = *(const GAS v4u*)(vp + o * 512); }
        for (int n0 = 0; n0 < 32; n0 += 4) {
#pragma unroll
            for (int u = 0; u < 4; ++u) { const int n = n0 + u;
                { u32x2 pk; pk.x = cvtpk(st[0], st[1]); pk.y = cvtpk(st[2], st[3]); *(GAS u32x2*)(STb + (size_t)n * 8192) = pk; }
                if (n < 31) {
                    __syncthreads();
                    *(LAS v4u*)(KS + kr0 * SQ + kc8 * 16) = scale8(rk0[u], z0); *(LAS v4u*)(KS + (kr0 + 64) * SQ + kc8 * 16) = scale8(rk1[u], z1);
                    *(LAS v4u*)(VSL + vr * SVS + vc4 * 16) = rvv[u];
                    __syncthreads();
                    if (n + 4 < 31) { const size_t o = (size_t)(n + 4) * 128; rk0[u] = *(const GAS v4u*)(kp + o * 256); rk1[u] = *(const GAS v4u*)(kp + (o + 64) * 256); rvv[u] = *(const GAS v4u*)(vp + o * 512); }
                    f32x4 a = {0.f, 0.f, 0.f, 0.f};
#pragma unroll
                    for (int kk = 0; kk < 4; ++kk) a = mma(frag_tr(KS, SQ, 32 * kk, 16 * dt, lane), frag_tr(VSL, SVS, 32 * kk, 16 * vt, lane), a);
                    st = st * cd + a;
                }
            }
        }
    }
    __syncthreads();
}

struct RetRegs { v4u q[2], k[2], s[2], v[4]; u32x2 g[8]; };
DI void ret_fetch(const Frame& F, RetRegs& r, int b, int h, int nn) {
    const size_t R0 = (size_t)b * 4096 + (size_t)nn * 128;
#pragma unroll
    for (int i = 0; i < 2; ++i) { const int ch = F.tid + 512 * i, rw = ch >> 3, c8 = ch & 7;
        r.q[i] = *(const GAS v4u*)(F.Qb + (R0 + rw) * 256 + h * 64 + c8 * 8); r.k[i] = *(const GAS v4u*)(F.Kb + (R0 + rw) * 256 + h * 64 + c8 * 8);
        r.s[i] = *(const GAS v4u*)(F.ST + (size_t)((b * 4 + h) * 32 + nn) * 8192 + rw * 64 + c8 * 8); }
#pragma unroll
    for (int i = 0; i < 4; ++i) { const int ch = F.tid + 512 * i, rw = ch >> 4, c16 = ch & 15; r.v[i] = *(const GAS v4u*)(F.Vb + (R0 + rw) * 512 + h * 128 + c16 * 8); }
    { const bf16* grow = F.Gb + (R0 + 16 * F.wave + (F.lane & 15)) * 512 + h * 128 + 4 * (F.lane >> 4);
#pragma unroll
      for (int vt = 0; vt < 8; ++vt) r.g[vt] = *(const GAS u32x2*)(grow + 16 * vt); }
}
DI void ret_compute(Frame& F, int b, int h, int nn, float lg, const u32x2 (&gb)[8]) {
    LAS unsigned char* QS = F.lds; LAS unsigned char* KS = F.lds + 18432; LAS unsigned char* VS = F.lds + 36864; LAS unsigned char* SS = F.lds + 71680; LAS unsigned char* CS = F.lds + 90112;
    const size_t R0 = (size_t)b * 4096 + (size_t)nn * 128;
    const int w = F.wave, lane = F.lane, fr = lane & 15, fq = lane >> 4;
    const int il = 16 * w + fr;
    const bf16x8 qf0 = frag_row(QS, SQ, 16 * w, 0, lane), qf1 = frag_row(QS, SQ, 16 * w, 32, lane);
    const int jtmax = w | 1;
    for (int jt = 0; jt <= jtmax; ++jt) {
        f32x4 a = {0.f, 0.f, 0.f, 0.f};
        a = mma(frag_row(KS, SQ, 16 * jt, 0, lane), qf0, a); a = mma(frag_row(KS, SQ, 16 * jt, 32, lane), qf1, a);
        float o[4];
#pragma unroll
        for (int r = 0; r < 4; ++r) { const int dl = il - (16 * jt + 4 * fq + r); o[r] = dl >= 0 ? a[r] * exp2f((float)dl * lg) : 0.f; }
        u32x2 pk; pk.x = cvtpk(o[0], o[1]); pk.y = cvtpk(o[2], o[3]);
        *(LAS u32x2*)(CS + il * SV + (16 * jt + 4 * fq) * 2) = pk;
    }
    asm volatile("s_waitcnt lgkmcnt(0)" ::: "memory");
    f32x4 accI[8], accC[8];
#pragma unroll
    for (int vt = 0; vt < 8; ++vt) { accI[vt] = (f32x4){0.f, 0.f, 0.f, 0.f}; accC[vt] = (f32x4){0.f, 0.f, 0.f, 0.f}; }
    const int kkmax = w >> 1;
    for (int kk = 0; kk <= kkmax; ++kk) { const bf16x8 cf = frag_row(CS, SV, 16 * w, 32 * kk, lane);
#pragma unroll
        for (int vt = 0; vt < 8; ++vt) accI[vt] = mma(frag_tr(VS, SV, 32 * kk, 16 * vt, lane), cf, accI[vt]); }
#pragma unroll
    for (int vt = 0; vt < 8; ++vt) { accC[vt] = mma(frag_row(SS, SQ, 16 * vt, 0, lane), qf0, accC[vt]); accC[vt] = mma(frag_row(SS, SQ, 16 * vt, 32, lane), qf1, accC[vt]); }
    const float xi = exp2f((float)(il + 1) * lg);
    float s = 0.f;
#pragma unroll
    for (int vt = 0; vt < 8; ++vt) { accI[vt] = accI[vt] + accC[vt] * xi; s += (accI[vt][0] + accI[vt][1]) + (accI[vt][2] + accI[vt][3]); }
    s += __shfl_xor(s, 16); s += __shfl_xor(s, 32);
    const float mean = s * (1.0f / 128.0f); float q = 0.f;
#pragma unroll
    for (int vt = 0; vt < 8; ++vt) { accI[vt] = accI[vt] - mean; q += (accI[vt][0] * accI[vt][0] + accI[vt][1] * accI[vt][1]) + (accI[vt][2] * accI[vt][2] + accI[vt][3] * accI[vt][3]); }
    q += __shfl_xor(q, 16); q += __shfl_xor(q, 32);
    const float rstd = 1.0f / sqrtf(q * (1.0f / 128.0f) + GN_EPS);
    bf16* orow = F.MIXIN + (R0 + il) * 1024 + h * 128 + 4 * fq;
#pragma unroll
    for (int vt = 0; vt < 8; ++vt) {
        const float g0 = bflo(gb[vt].x), g1 = bfhi(gb[vt].x), g2 = bflo(gb[vt].y), g3 = bfhi(gb[vt].y);
        const float y0 = accI[vt][0] * rstd * g0 / (1.0f + __expf(-g0)), y1 = accI[vt][1] * rstd * g1 / (1.0f + __expf(-g1));
        const float y2 = accI[vt][2] * rstd * g2 / (1.0f + __expf(-g2)), y3 = accI[vt][3] * rstd * g3 / (1.0f + __expf(-g3));
        u32x2 pk; pk.x = cvtpk(y0, y1); pk.y = cvtpk(y2, y3); *(GAS u32x2*)(orow + 16 * vt) = pk; }
}
DI void pool_fetch(const Frame& F, v4u (&ru)[5], int b, int g, int nn) {
#pragma unroll
    for (int i = 0; i < 5; ++i) { const int ch = F.tid + 512 * i; ru[i] = (v4u){0u, 0u, 0u, 0u};
        if (ch < 144 * 16) { const int rr = ch >> 4, c16 = ch & 15, t = nn * 128 - 16 + rr;
            if (t >= 0) ru[i] = *(const GAS v4u*)(F.Ub + ((size_t)b * 4096 + t) * 512 + g * 128 + c16 * 8);
            else { const float* mu = F.metau + (16 + t) * 512 + g * 128 + c16 * 8; ru[i].x = pk2(mu[0], mu[1]); ru[i].y = pk2(mu[2], mu[3]); ru[i].z = pk2(mu[4], mu[5]); ru[i].w = pk2(mu[6], mu[7]); } } }
}
DI void p3_mixer(Frame& F) {
    const int c = blockIdx.x;
    {
        LAS unsigned char* QS = F.lds; LAS unsigned char* KS = F.lds + 18432; LAS unsigned char* VS = F.lds + 36864; LAS unsigned char* SS = F.lds + 71680;
        RetRegs rg; { const int tile = 2 * c; ret_fetch(F, rg, tile >> 5, 0, tile & 31); }
        for (int i = 0; i < 8; ++i) {
            const int tile = 2 * c + (i >> 2), hg = i & 3, b = tile >> 5, nn = tile & 31;
            const float lg = log2f(1.0f - exp2f(-5.0f - (float)hg));
            __syncthreads();
#pragma unroll
            for (int k = 0; k < 2; ++k) { const int ch = F.tid + 512 * k, rw = ch >> 3, c8 = ch & 7;
                *(LAS v4u*)(QS + rw * SQ + c8 * 16) = rg.q[k]; *(LAS v4u*)(KS + rw * SQ + c8 * 16) = rg.k[k]; *(LAS v4u*)(SS + rw * SQ + c8 * 16) = rg.s[k]; }
#pragma unroll
            for (int k = 0; k < 4; ++k) { const int ch = F.tid + 512 * k, rw = ch >> 4, c16 = ch & 15; *(LAS v4u*)(VS + rw * SV + c16 * 16) = rg.v[k]; }
            __syncthreads();
            u32x2 gcur[8];
#pragma unroll
            for (int vt = 0; vt < 8; ++vt) gcur[vt] = rg.g[vt];
            if (i < 7) { const int t2 = 2 * c + ((i + 1) >> 2); ret_fetch(F, rg, t2 >> 5, (i + 1) & 3, t2 & 31); }
            ret_compute(F, b, hg, nn, lg, gcur);
        }
    }
    {
        LAS unsigned char* US = F.lds; LAS unsigned char* PS = F.lds + 40960; LAS unsigned char* WSM = F.lds + 77824;
        const int w = F.wave, lane = F.lane, fr = lane & 15, fq = lane >> 4;
        f32x4 pb[8], psc[8]; v4u wreg[4];
        v4u ru[5]; { const int tile = 2 * c; pool_fetch(F, ru, tile >> 5, 0, tile & 31); }
#pragma unroll
        for (int k = 0; k < 4; ++k) { const int ch = F.tid + 512 * k; wreg[k] = *(const GAS v4u*)(F.Wpool_t + (ch >> 4) * 128 + (ch & 15) * 8); }
        for (int i = 0; i < 8; ++i) {
            const int g = i >> 1, tile = 2 * c + (i & 1), b = tile >> 5, nn = tile & 31, win = 2 << g; const float invw = 1.0f / (float)win;
            const size_t R0 = (size_t)b * 4096 + (size_t)nn * 128;
            __syncthreads();
            if ((i & 1) == 0) {
#pragma unroll
                for (int k = 0; k < 4; ++k) { const int ch = F.tid + 512 * k; *(LAS v4u*)(WSM + (ch >> 4) * SV + (ch & 15) * 16) = wreg[k]; }
#pragma unroll
                for (int dt = 0; dt < 8; ++dt) { pb[dt] = *(const f32x4*)(F.pool_b + g * 128 + 16 * dt + 4 * fq); psc[dt] = *(const f32x4*)(F.pool_scale + g * 128 + 16 * dt + 4 * fq); } }
#pragma unroll
            for (int k = 0; k < 5; ++k) { const int ch = F.tid + 512 * k; if (ch < 144 * 16) *(LAS v4u*)(US + (ch >> 4) * SV + (ch & 15) * 16) = ru[k]; }
            __syncthreads();
            if (i < 7) { const int t2 = 2 * c + ((i + 1) & 1), g2 = (i + 1) >> 1; pool_fetch(F, ru, t2 >> 5, g2, t2 & 31);
                if ((i & 1) == 1) {
#pragma unroll
                    for (int k = 0; k < 4; ++k) { const int ch = F.tid + 512 * k; wreg[k] = *(const GAS v4u*)(F.Wpool_t + g2 * 16384 + (ch >> 4) * 128 + (ch & 15) * 8); } } }
            { const int c2 = F.tid & 63, ib = F.tid >> 6; float run0 = 0.f, run1 = 0.f;
              for (int sI = 0; sI < win; ++sI) { const unsigned xw = *(const LAS unsigned*)(US + (16 + 16 * ib - sI) * SV + c2 * 4); run0 += bflo(xw); run1 += bfhi(xw); }
              for (int ii = 0; ii < 16; ++ii) { const int ir = 16 * ib + ii; const unsigned cur = *(const LAS unsigned*)(US + (16 + ir) * SV + c2 * 4);
                  if (ii > 0) { const unsigned old = *(const LAS unsigned*)(US + (16 + ir - win) * SV + c2 * 4); run0 += bflo(cur) - bflo(old); run1 += bfhi(cur) - bfhi(old); }
                  *(LAS unsigned*)(PS + ir * SV + c2 * 4) = cvtpk(run0 * invw - bflo(cur), run1 * invw - bfhi(cur)); } }
            __syncthreads();
            bf16x8 pf[4];
#pragma unroll
            for (int kk = 0; kk < 4; ++kk) pf[kk] = frag_row(PS, SV, 16 * w, 32 * kk, lane);
            bf16* orow = F.MIXIN + (R0 + 16 * w + fr) * 1024 + 512 + g * 128 + 4 * fq;
#pragma unroll
            for (int dt = 0; dt < 8; ++dt) { f32x4 a = {0.f, 0.f, 0.f, 0.f};
#pragma unroll
                for (int kk = 0; kk < 4; ++kk) a = mma(frag_row(WSM, SV, 16 * dt, 32 * kk, lane), pf[kk], a);
                a = (a + pb[dt]) * psc[dt];
                u32x2 pk; pk.x = cvtpk(a[0], a[1]); pk.y = cvtpk(a[2], a[3]); *(GAS u32x2*)(orow + 16 * dt) = pk; }
        }
    }
    __syncthreads();
}

DI void split8(const float (&h)[8], bf16x8& hi, bf16x8& lo) {
    v4u a, b;
#pragma unroll
    for (int p = 0; p < 4; ++p) { const unsigned wd = cvtpk(h[2 * p], h[2 * p + 1]); a[p] = wd; b[p] = cvtpk(h[2 * p] - bflo(wd), h[2 * p + 1] - bfhi(wd)); }
    hi = __builtin_bit_cast(bf16x8, a); lo = __builtin_bit_cast(bf16x8, b);
}
DI void p5_ln_router(Frame& F) {
    LAS int* LCNT = (LAS int*)(F.lds + LCNT_OFF);
    LAS f32x2* SP = (LAS f32x2*)(F.lds);
    LAS float* LP = (LAS float*)(F.lds + 1024);
    LAS float* LG = (LAS float*)(F.lds + 1024 + 24576);
    LAS float* GB = (LAS float*)(F.lds + 32768);
    for (int i = F.tid; i < 256; i += 512) { *(LAS f32x4*)(GB + 4 * i) = *(const f32x4*)(F.ln1_g + 4 * i); *(LAS f32x4*)(GB + 1024 + 4 * i) = *(const f32x4*)(F.ln1_b + 4 * i); }
    if (F.tid < 32) LCNT[F.tid] = 0;
    const int w = F.wave, lane = F.lane, fr = lane & 15, fq = lane >> 4;
    const int kb = 128 * w + 8 * fq;
    bf16x8 wh[3][4], wl[3][4];
#pragma unroll
    for (int ct = 0; ct < 3; ++ct)
#pragma unroll
        for (int ks = 0; ks < 4; ++ks) { const int cc = 16 * ct + fr; float f[8];
            if (cc < 36) { const f32x4 a = *(const f32x4*)(F.RW + cc * 1024 + kb + 32 * ks), b = *(const f32x4*)(F.RW + cc * 1024 + kb + 32 * ks + 4);
                f[0] = a[0]; f[1] = a[1]; f[2] = a[2]; f[3] = a[3]; f[4] = b[0]; f[5] = b[1]; f[6] = b[2]; f[7] = b[3]; }
            else {
#pragma unroll
                for (int j = 0; j < 8; ++j) f[j] = 0.f; }
            split8(f, wh[ct][ks], wl[ct][ks]); }
    const int c = blockIdx.x;
    const float rbias = lane < 4 ? F.rg_b[lane] : (lane < 36 ? F.re_b[lane - 4] : 0.f);
    const bf16* tbase = F.T1 + (size_t)(c * 256 + fr) * D + kb;
    const bf16* hbase = F.H0 + (size_t)(c * 256 + fr) * D + kb;
    v4u tn[4], hn[4];
#pragma unroll
    for (int ks = 0; ks < 4; ++ks) { tn[ks] = *(const GAS v4u*)(tbase + 32 * ks); hn[ks] = *(const GAS v4u*)(hbase + 32 * ks); }
    __syncthreads();
    for (int grp = 0; grp < 16; ++grp) {
        f32x4 t[8];
#pragma unroll
        for (int i = 0; i < 4; ++i) {
            t[2 * i] = (f32x4){ALPHA * bflo(hn[i].x) + bflo(tn[i].x), ALPHA * bfhi(hn[i].x) + bfhi(tn[i].x), ALPHA * bflo(hn[i].y) + bflo(tn[i].y), ALPHA * bfhi(hn[i].y) + bfhi(tn[i].y)};
            t[2 * i + 1] = (f32x4){ALPHA * bflo(hn[i].z) + bflo(tn[i].z), ALPHA * bfhi(hn[i].z) + bfhi(tn[i].z), ALPHA * bflo(hn[i].w) + bflo(tn[i].w), ALPHA * bfhi(hn[i].w) + bfhi(tn[i].w)}; }
        if (grp < 15) { const bf16* nb = tbase + (size_t)(grp + 1) * 16 * D; const bf16* nh = hbase + (size_t)(grp + 1) * 16 * D;
#pragma unroll
            for (int ks = 0; ks < 4; ++ks) { tn[ks] = *(const GAS v4u*)(nb + 32 * ks); hn[ks] = *(const GAS v4u*)(nh + 32 * ks); } }
        float s = 0.f, s2 = 0.f;
#pragma unroll
        for (int i = 0; i < 8; ++i) { s += (t[i][0] + t[i][1]) + (t[i][2] + t[i][3]); s2 += (t[i][0] * t[i][0] + t[i][1] * t[i][1]) + (t[i][2] * t[i][2] + t[i][3] * t[i][3]); }
        s += __shfl_xor(s, 16); s += __shfl_xor(s, 32); s2 += __shfl_xor(s2, 16); s2 += __shfl_xor(s2, 32);
        if (fq == 0) SP[fr * 8 + w] = (f32x2){s, s2};
        __syncthreads();
        float ts = 0.f, ts2 = 0.f;
#pragma unroll
        for (int k = 0; k < 8; ++k) { const f32x2 p = SP[fr * 8 + k]; ts += p.x; ts2 += p.y; }
        const float mean = ts * (1.f / D); const float rstd = 1.f / sqrtf(ts2 * (1.f / D) - mean * mean + LN_EPS);
        f32x4 acc[3];
#pragma unroll
        for (int ct = 0; ct < 3; ++ct) acc[ct] = (f32x4){0.f, 0.f, 0.f, 0.f};
        bf16* hrow = F.H1B + (size_t)(c * 256 + grp * 16 + fr) * D + kb; unsigned char* frow = F.H1F8 + (size_t)(c * 256 + grp * 16 + fr) * D + kb;
#pragma unroll
        for (int ks = 0; ks < 4; ++ks) { const int col = kb + 32 * ks;
            const f32x4 g0 = *(const LAS f32x4*)(GB + col), g1 = *(const LAS f32x4*)(GB + col + 4), b0 = *(const LAS f32x4*)(GB + 1024 + col), b1 = *(const LAS f32x4*)(GB + 1024 + col + 4);
            const f32x4 h0 = (t[2 * ks] - mean) * rstd * g0 + b0, h1 = (t[2 * ks + 1] - mean) * rstd * g1 + b1;
            const float h[8] = {h0[0], h0[1], h0[2], h0[3], h1[0], h1[1], h1[2], h1[3]};
            bf16x8 hh, hl; split8(h, hh, hl);
            *(GAS bf16x8*)(hrow + 32 * ks) = hh;
            { u32x2 f8; f8.x = pk4f8(h[0], h[1], h[2], h[3]); f8.y = pk4f8(h[4], h[5], h[6], h[7]); *(GAS u32x2*)(frow + 32 * ks) = f8; }
#pragma unroll
            for (int ct = 0; ct < 3; ++ct) { acc[ct] = mma(wh[ct][ks], hh, acc[ct]); acc[ct] = mma(wh[ct][ks], hl, acc[ct]); acc[ct] = mma(wl[ct][ks], hh, acc[ct]); } }
#pragma unroll
        for (int ct = 0; ct < 3; ++ct) *(LAS f32x4*)(LP + ((w * 16 + fr) * 48 + 16 * ct + 4 * fq)) = acc[ct];
        __syncthreads();
#pragma unroll
        for (int rr = 0; rr < 2; ++rr) { const int rl = 2 * w + rr;
            if (lane < 36) { float sg = 0.f;
#pragma unroll
                for (int k = 0; k < 8; ++k) sg += LP[(k * 16 + rl) * 48 + lane];
                LG[rl * 40 + lane] = sg + rbias; } }
        asm volatile("s_waitcnt lgkmcnt(0)" ::: "memory");
        if (lane < 2) { const int rl = 2 * w + lane, row = c * 256 + grp * 16 + rl; const LAS float* lg = LG + rl * 40;
            const float l0 = lg[0], l1 = lg[1], l2 = lg[2], l3 = lg[3];
            const float gmax = fmaxf(fmaxf(l0, l1), fmaxf(l2, l3));
            const int gi = l0 == gmax ? 0 : (l1 == gmax ? 1 : (l2 == gmax ? 2 : 3));
            const float gp = 1.0f / ((expf(l0 - gmax) + expf(l1 - gmax)) + (expf(l2 - gmax) + expf(l3 - gmax)));
            float sel[8];
#pragma unroll
            for (int k = 0; k < 8; ++k) sel[k] = lg[4 + gi * 8 + k];
            float m1 = sel[0];
#pragma unroll
            for (int k = 1; k < 8; ++k) m1 = fmaxf(m1, sel[k]);
            int i1 = 7;
#pragma unroll
            for (int k = 6; k >= 0; --k) i1 = sel[k] == m1 ? k : i1;
            float m2 = -3.0e38f;
#pragma unroll
            for (int k = 0; k < 8; ++k) m2 = (k != i1) ? fmaxf(m2, sel[k]) : m2;
            int i2 = -1;
#pragma unroll
            for (int k = 7; k >= 0; --k) i2 = (k != i1 && sel[k] == m2) ? k : i2;
            const float tt = expf(m2 - m1); const float w0 = gp / (1.0f + tt), w1 = gp * tt / (1.0f + tt);
            const int e0 = gi * 8 + i1, e1 = gi * 8 + i2;
            const int li0 = __hip_atomic_fetch_add(LCNT + e0, 1, __ATOMIC_RELAXED, __HIP_MEMORY_SCOPE_WORKGROUP), li1 = __hip_atomic_fetch_add(LCNT + e1, 1, __ATOMIC_RELAXED, __HIP_MEMORY_SCOPE_WORKGROUP);
            F.toke[row] = (unsigned)e0 | ((unsigned)e1 << 8); F.tokl[row] = (unsigned)li0 | ((unsigned)li1 << 16); F.tokw[row] = (f32x2){w0, w1}; }
    }
    __syncthreads();
    if (F.tid < 32) F.cnt[c * 32 + F.tid] = LCNT[F.tid];
}
DI void moe_layout(Frame& F) {
    LAS int* red = (LAS int*)(F.lds);
    LAS int* PP = (LAS int*)(F.lds + PP_OFF); LAS int* TOT = (LAS int*)(F.lds + TOT_OFF); LAS int* BEF = (LAS int*)(F.lds + BEF_OFF); LAS int* BASE = (LAS int*)(F.lds + BASE_OFF);
    __syncthreads();
    { const int e = F.tid & 31, part = F.tid >> 5; int tot = 0, bef = 0;
      for (int k = 0; k < 16; ++k) { const int c2 = part * 16 + k; const int v = F.cnt[c2 * 32 + e]; tot += v; bef += (c2 < (int)blockIdx.x) ? v : 0; }
      red[(part * 32 + e) * 2] = tot; red[(part * 32 + e) * 2 + 1] = bef; }
    __syncthreads();
    if (F.tid < 32) { int t = 0, bf = 0;
        for (int p = 0; p < 16; ++p) { t += red[(p * 32 + F.tid) * 2]; bf += red[(p * 32 + F.tid) * 2 + 1]; }
        TOT[F.tid] = t; BEF[F.tid] = bf; }
    __syncthreads();
    if (F.tid == 0) { int acc = 0; for (int e = 0; e < 32; ++e) { PP[e] = acc; acc += (TOT[e] + 255) >> 8; } PP[32] = acc; }
    __syncthreads();
    if (F.tid < 32) BASE[F.tid] = PP[F.tid] * 256 + BEF[F.tid];
    __syncthreads();
}
DI void p6_assign(Frame& F) {
    moe_layout(F);
    const LAS int* BASE = (const LAS int*)(F.lds + BASE_OFF); const LAS int* PP = (const LAS int*)(F.lds + PP_OFF); const LAS int* TOT = (const LAS int*)(F.lds + TOT_OFF);
    const int c = blockIdx.x;
    if (F.tid < 256) { const int row = c * 256 + F.tid; const unsigned te = F.toke[row], tl = F.tokl[row];
        const int s0 = BASE[te & 255u] + (int)(tl & 0xffffu), s1 = BASE[(te >> 8) & 255u] + (int)(tl >> 16);
        F.stok[s0] = row; F.stok[s1] = row; F.toks[row * 2] = s0; F.toks[row * 2 + 1] = s1; const f32x2 wv = F.tokw[row]; F.PW[s0] = wv.x; F.PW[s1] = wv.y; }
    if (c < 32) { const int lo = PP[c] * 256 + TOT[c], hi = PP[c + 1] * 256; for (int sl = lo + F.tid; sl < hi; sl += 512) { F.stok[sl] = 0; F.PW[sl] = 0.f; } }
}
DI void p9_final(Frame& F) {
    const int gw = F.vcu * NWAVES + F.wave, NGW = F.G * NWAVES;
    f32x4 gv[4], bv[4];
#pragma unroll
    for (int j = 0; j < 4; ++j) { gv[j] = *(const f32x4*)(F.ln2_g + 4 * F.lane + 256 * j); bv[j] = *(const f32x4*)(F.ln2_b + 4 * F.lane + 256 * j); }
    u32x2 nh[4], mh[4]; unsigned na[4], nb[4], ma[4], mb[4]; int s0n, s1n;
    { const int r0 = gw, r1 = gw + NGW, r2 = gw + 2 * NGW;
      const int a0 = F.toks[r0 * 2], a1 = F.toks[r0 * 2 + 1], b0 = F.toks[r1 * 2], b1 = F.toks[r1 * 2 + 1];
      const GAS u32x2* hp = (const GAS u32x2*)(F.H1B + (size_t)r0 * D) + F.lane; const GAS unsigned* y0 = (const GAS unsigned*)(F.YP + (size_t)a0 * D) + F.lane; const GAS unsigned* y1 = (const GAS unsigned*)(F.YP + (size_t)a1 * D) + F.lane;
      const GAS u32x2* hq = (const GAS u32x2*)(F.H1B + (size_t)r1 * D) + F.lane; const GAS unsigned* z0 = (const GAS unsigned*)(F.YP + (size_t)b0 * D) + F.lane; const GAS unsigned* z1 = (const GAS unsigned*)(F.YP + (size_t)b1 * D) + F.lane;
#pragma unroll
      for (int j = 0; j < 4; ++j) { nh[j] = hp[64 * j]; na[j] = y0[64 * j]; nb[j] = y1[64 * j]; mh[j] = hq[64 * j]; ma[j] = z0[64 * j]; mb[j] = z1[64 * j]; }
      s0n = F.toks[r2 * 2]; s1n = F.toks[r2 * 2 + 1]; }
    for (int row = gw; row < M; row += NGW) {
        u32x2 ch[4]; unsigned ca[4], cb[4];
#pragma unroll
        for (int j = 0; j < 4; ++j) { ch[j] = nh[j]; ca[j] = na[j]; cb[j] = nb[j]; nh[j] = mh[j]; na[j] = ma[j]; nb[j] = mb[j]; }
        if (row + 2 * NGW < M) { const int rn = row + 2 * NGW;
            const GAS u32x2* hp = (const GAS u32x2*)(F.H1B + (size_t)rn * D) + F.lane; const GAS unsigned* y0 = (const GAS unsigned*)(F.YP + (size_t)s0n * D) + F.lane; const GAS unsigned* y1 = (const GAS unsigned*)(F.YP + (size_t)s1n * D) + F.lane;
#pragma unroll
            for (int j = 0; j < 4; ++j) { mh[j] = hp[64 * j]; ma[j] = y0[64 * j]; mb[j] = y1[64 * j]; }
            const int r3 = rn + NGW < M ? rn + NGW : rn; s0n = F.toks[r3 * 2]; s1n = F.toks[r3 * 2 + 1]; }
        f32x4 v[4]; float s = 0.f;
#pragma unroll
        for (int j = 0; j < 4; ++j) { const u32x2 hb = ch[j];
            const f32x2 a0 = __builtin_amdgcn_cvt_pk_f32_fp8((int)ca[j], false), a1 = __builtin_amdgcn_cvt_pk_f32_fp8((int)ca[j], true);
            const f32x2 b0 = __builtin_amdgcn_cvt_pk_f32_fp8((int)cb[j], false), b1 = __builtin_amdgcn_cvt_pk_f32_fp8((int)cb[j], true);
            v[j].x = ALPHA * bflo(hb.x) + (a0.x + b0.x) * 0.015625f; v[j].y = ALPHA * bfhi(hb.x) + (a0.y + b0.y) * 0.015625f;
            v[j].z = ALPHA * bflo(hb.y) + (a1.x + b1.x) * 0.015625f; v[j].w = ALPHA * bfhi(hb.y) + (a1.y + b1.y) * 0.015625f;
            s += (v[j].x + v[j].y) + (v[j].z + v[j].w); }
        const float mean = wave_sum(s) * (1.f / D); float s2 = 0.f;
#pragma unroll
        for (int j = 0; j < 4; ++j) { v[j] = v[j] - mean; s2 += (v[j].x * v[j].x + v[j].y * v[j].y) + (v[j].z * v[j].z + v[j].w * v[j].w); }
        const float rstd = 1.f / sqrtf(wave_sum(s2) * (1.f / D) + LN_EPS);
        GAS f32x4* op = (GAS f32x4*)(F.out + (size_t)row * D) + F.lane;
#pragma unroll
        for (int j = 0; j < 4; ++j) op[64 * j] = v[j] * rstd * gv[j] + bv[j];
    }
}

struct Args { const float* in[20]; float* out; unsigned char* ws; int ph_lo, ph_hi; };
__global__ void __launch_bounds__(NWAVES * 64, 2) hrp_fwd(Args args) {
    extern __shared__ __attribute__((aligned(16))) unsigned char lds[];
    Frame F;
    F.lds = (LAS unsigned char*)lds;
    F.MISC = (volatile LAS unsigned*)(F.lds + MISC_OFF);
    F.tid = threadIdx.x; F.lane = F.tid & 63; F.wave = __builtin_amdgcn_readfirstlane(F.tid >> 6);
    F.G = gridDim.x; { const int bx = blockIdx.x; F.vcu = (F.G % 8 == 0) ? (bx % 8) * (F.G / 8) + bx / 8 : bx; }
    unsigned char* ws = args.ws;
    F.ctl = (gu32*)(ws + WS_CTL);
    F.x = args.in[0]; F.meta = args.in[1]; F.lne_g = args.in[2]; F.lne_b = args.in[3]; F.w_in = args.in[4]; F.pool_w = args.in[5]; F.pool_b = args.in[6]; F.pool_scale = args.in[7];
    F.w_out = args.in[8]; F.ln1_g = args.in[9]; F.ln1_b = args.in[10]; F.rg_w = args.in[11]; F.rg_b = args.in[12]; F.re_w = args.in[13]; F.re_b = args.in[14];
    F.w_gate = args.in[15]; F.w_up = args.in[16]; F.w_down = args.in[17]; F.ln2_g = args.in[18]; F.ln2_b = args.in[19]; F.out = args.out;
    F.Win_t = (bf16*)(ws + WS_WIN); F.Wout_t = (bf16*)(ws + WS_WOUT); F.Wpool_t = (bf16*)(ws + WS_WPOOL); F.Wgu8 = ws + WS_WGU; F.Wd8 = ws + WS_WD; F.H1F8 = ws + WS_H1F8;
    F.RW = (float*)(ws + WS_RW); F.metak = (float*)(ws + WS_METAK); F.metav = (float*)(ws + WS_METAV); F.metau = (float*)(ws + WS_METAU); F.rope = (float*)(ws + WS_ROPE);
    F.T1 = (bf16*)(ws + WS_T1); F.PW = (float*)(ws + WS_PW);
    F.toke = (unsigned*)(ws + WS_TOKE); F.tokl = (unsigned*)(ws + WS_TOKL); F.tokw = (f32x2*)(ws + WS_TOKW); F.toks = (int*)(ws + WS_TOKS); F.cnt = (int*)(ws + WS_CNT); F.stok = (int*)(ws + WS_STOK);
    F.ST = (bf16*)(ws + WS_ST); F.H0 = (bf16*)(ws + WS_H0); F.Qb = (bf16*)(ws + WS_Q); F.Kb = (bf16*)(ws + WS_K); F.Vb = (bf16*)(ws + WS_V); F.Gb = (bf16*)(ws + WS_GATE); F.Ub = (bf16*)(ws + WS_U);
    F.MIXIN = (bf16*)(ws + WS_MIXIN); F.H1B = (bf16*)(ws + WS_H1B); F.HID = ws + WS_HID; F.YP = (unsigned char*)(ws + WS_YP);
    for (int u = F.tid; u < (LDS_BYTES - LDSCTL_OFF) / 4; u += NWAVES * 64) ((LAS unsigned*)(F.lds + LDSCTL_OFF))[u] = 0u;
    __syncthreads();
    if (F.G != 256) return;
    XcdBarrier bar; bar.bar = (unsigned*)(F.ctl + CW_BAR); bar.x = 0; bar.st = nullptr;
    if (N_LAUNCHES != PER_PHASE) bar = xcd_barrier_post((unsigned*)(F.ctl + CW_BAR), F.MISC + 8);
#define GRID_BAR() do { if (N_LAUNCHES != PER_PHASE) xcd_barrier(bar); } while (0)
    const int lo = args.ph_lo, hi = args.ph_hi;
#define RELANE() do { int l_; asm volatile("v_mbcnt_lo_u32_b32 %0, -1, 0\n\tv_mbcnt_hi_u32_b32 %0, -1, %0" : "=v"(l_)); F.lane = l_; F.tid = F.wave * 64 + l_; } while (0)
#define IN(k) (lo <= (k) && (k) < hi)
#define BOTH(k) (IN(k) && IN((k) + 1))

    if (IN(0)) { RELANE(); p0_prologue(F); if (BOTH(0)) GRID_BAR(); }
    if (IN(1)) {
        pg8::Gemm g{F.H0, F.Win_t, M, NPROJ, D}; pg8::StaticOrder S; S.init(M, NPROJ, F.G, (int)blockIdx.x);
        pg8::EpiProj E{F.Qb, F.Vb, F.rope};
        pg8::gemm_phase<pg8::EpiProj, pg8::StaticOrder, true, true>(F.lds + RING_OFF, g, S, E, F.wave);
        if (BOTH(1)) GRID_BAR();
    }
    if (IN(2)) { RELANE(); p2_scan(F); if (BOTH(2)) GRID_BAR(); }
    if (IN(3)) { RELANE(); p3_mixer(F); VM_WAIT(); __syncthreads(); }
    if (IN(4)) {
        pg8::Gemm g{F.MIXIN, F.Wout_t, M, D, D}; pg8::OwnPanelOrder S{(int)blockIdx.x, 4};
        pg8::EpiMix E{F.T1};
        pg8::gemm_phase<pg8::EpiMix, pg8::OwnPanelOrder, true, true>(F.lds + RING_OFF, g, S, E, F.wave);
        VM_WAIT(); __syncthreads();
    }
    if (IN(5)) { RELANE(); p5_ln_router(F); if (BOTH(5)) GRID_BAR(); }
    if (IN(6)) { RELANE(); p6_assign(F); if (BOTH(6)) GRID_BAR(); }
    if (IN(7)) {
        if (!IN(6)) { RELANE(); moe_layout(F); }
        pg8::Gemm g{(const bf16*)F.H1F8, (const bf16*)F.Wgu8, SLOTS, 1024, D / 2, F.stok}; pg8::GroupedOrder S;     S.init((const LAS int*)(F.lds + PP_OFF), F.G, (int)blockIdx.x);
        pg8::EpiGateUp E{F.HID};
        pg8::gemm_phase<pg8::EpiGateUp, pg8::GroupedOrder, true, true, true, true>(F.lds + RING_OFF, g, S, E, F.wave);
        if (BOTH(7)) GRID_BAR();
    }
    if (IN(8)) {
        if (!IN(6)) { RELANE(); moe_layout(F); }
        pg8::Gemm g{(const bf16*)F.HID, (const bf16*)F.Wd8, SLOTS, 1024, DEXP / 2}; pg8::GroupedOrder S;     S.init((const LAS int*)(F.lds + PP_OFF), F.G, (int)blockIdx.x);
        pg8::EpiDown E{F.YP, F.PW};
        pg8::gemm_phase<pg8::EpiDown, pg8::GroupedOrder, true, true, false, true>(F.lds + RING_OFF, g, S, E, F.wave);
        if (BOTH(8)) GRID_BAR();
    }
    if (IN(9)) { RELANE(); p9_final(F); }
#undef IN
#undef BOTH
#undef GRID_BAR
#undef RELANE
}

extern "C" void kernel_launch(void* const* d_in, const int* in_sizes, int n_in, void* d_out, int out_size, void* d_ws, size_t ws_size, hipStream_t stream) {
    static int grid = 0;
    if (grid == 0) {
        if (n_in != 20 || in_sizes[0] != M * D || out_size != M * D || ws_size < WS_END) { fprintf(stderr, "kernel_launch: built for 20 inputs, x and out of %d floats, >= %zu bytes of workspace; got n_in %d, in0 %d, out %d, ws %zu; nothing launched\n", M * D, (size_t)WS_END, n_in, n_in > 0 ? in_sizes[0] : -1, out_size, ws_size); grid = -1; return; }
        int dev = 0, cus = 0, per_cu = 0;
        if (hipGetDevice(&dev) != hipSuccess || hipDeviceGetAttribute(&cus, hipDeviceAttributeMultiprocessorCount, dev) != hipSuccess) { fprintf(stderr, "kernel_launch: hipGetDevice / hipDeviceGetAttribute failed; nothing launched\n"); grid = -1; return; }
        if (hipFuncSetAttribute((const void*)hrp_fwd, hipFuncAttributeMaxDynamicSharedMemorySize, LDS_BYTES) != hipSuccess) { fprintf(stderr, "kernel_launch: hipFuncSetAttribute failed (%d bytes of dynamic LDS); nothing launched\n", LDS_BYTES); grid = -1; return; }
        if (hipOccupancyMaxActiveBlocksPerMultiprocessor(&per_cu, (const void*)hrp_fwd, NWAVES * 64, LDS_BYTES) != hipSuccess || per_cu < 1)
            fprintf(stderr, "kernel_launch: note: the occupancy query reports %d workgroups per CU; the launch goes ahead with one per CU\n", per_cu);
        (void)hipGetLastError();
        grid = cus;
        if (grid != 256) fprintf(stderr, "kernel_launch: %d CUs; this kernel is built for 256 and will leave the output unwritten\n", grid);
    }
    if (grid < 0) return;
    if (hipMemsetAsync((char*)d_ws + WS_CTL, 0, CTL_ZERO_BYTES, stream) != hipSuccess) { fprintf(stderr, "kernel_launch: hipMemsetAsync of the control words failed; nothing launched\n"); return; }
    Args a{};
    for (int i = 0; i < 20; ++i) a.in[i] = (const float*)d_in[i];
    a.out = (float*)d_out; a.ws = (unsigned char*)d_ws;
    for (int li = 0; li < N_LAUNCHES; ++li) {
        a.ph_lo = (N_LAUNCHES == PER_PHASE) ? li : 0; a.ph_hi = (N_LAUNCHES == PER_PHASE) ? li + 1 : PER_PHASE;
        hipLaunchKernelGGL(hrp_fwd, dim3(grid), dim3(NWAVES * 64), LDS_BYTES, stream, a);
        const hipError_t le = hipPeekAtLastError();
        if (le != hipSuccess) { fprintf(stderr, "kernel_launch: launch %d failed: %s\n", li, hipGetErrorName(le)); break; }
    }
}
```

```cpp
#include <hip/hip_runtime.h>
#include <cstdio>
#include <cstdint>
#ifndef MK_N_LAUNCHES
#define MK_N_LAUNCHES 1
#endif
namespace pg8 {
#define PG8_LAS __attribute__((address_space(3)))
typedef unsigned short bf16_t;
typedef short bf16x8 __attribute__((ext_vector_type(8)));
typedef float f32x4 __attribute__((ext_vector_type(4)));
typedef unsigned u32x4 __attribute__((ext_vector_type(4)));
constexpr int BM = 256, BK = 64, HALF = 128, HTB = HALF * BK * 2  , STAGE_BYTES = 8 * HTB, NXCD = 8, WGM = 8;

__host__ __device__ __forceinline__ int lds_byte(int r, int c) { const int st = (r >> 4) * 2 + (c >> 5), rr = r & 15, cc = c & 31, ob = rr * 64 + cc * 2; return st * 1024 + (ob ^ (((ob >> 9) & 1) << 5)); }
__host__ __device__ __forceinline__ void stage_rc(int b, int& R, int& C) { const int st = b / 1024, sb = b % 1024, swz = sb ^ (((sb >> 9) & 1) << 5); R = (st >> 1) * 16 + swz / 64; C = (st & 1) * 32 + (swz % 64) / 2; }
__host__ __device__ __forceinline__ int perm32(int rho) { const int n = rho >> 4, i = rho & 15; return 8 * (i >> 2) + 4 * n + (i & 3); }

struct Unit { int pm, pn; };
struct Gemm { const bf16_t* A; const bf16_t* Bt; int M, N, K; const int* gidx; };

struct StaticOrder {
    int nM, nN, nwg, G, c;
    __host__ __device__ void init(int M, int N, int G_, int c_) { nM = M / BM; nN = N / BM; nwg = nM * nN; G = G_; c = c_; }
    __host__ __device__ bool next(int i, Unit& u) const {
        const long L = (long)i * G + c; if (L >= nwg) return false;
        int wgid = (int)L; { const int q = nwg / NXCD, r = nwg % NXCD, xcd = wgid % NXCD, off = wgid / NXCD; wgid = (xcd < r ? xcd * (q + 1) : r * (q + 1) + (xcd - r) * q) + off; }
        const int nig = WGM * nN, gid = wgid / nig, fm = gid * WGM, gsz = (nM - fm) < WGM ? (nM - fm) : WGM;
        u.pm = fm + ((wgid % nig) % gsz); u.pn = (wgid % nig) / gsz; return true;
    }
    __device__ __forceinline__ void a_ready(const Unit&) const {}
    __device__ __forceinline__ void done(const Unit&) const {}
};

__device__ __forceinline__ unsigned cvt_pk_bf16(float lo, float hi) { unsigned r; asm volatile("v_cvt_pk_bf16_f32 %0, %1, %2" : "=v"(r) : "v"(lo), "v"(hi)); return r; }
__device__ __forceinline__ float bf_lo(unsigned w) { return __uint_as_float(w << 16); }
__device__ __forceinline__ float bf_hi(unsigned w) { return __uint_as_float(w & 0xffff0000u); }
__device__ __forceinline__ unsigned pk4_fp8(const f32x4 v) { int w = __builtin_amdgcn_cvt_pk_fp8_f32(v[0], v[1], 0, false); w = __builtin_amdgcn_cvt_pk_fp8_f32(v[2], v[3], w, true); return (unsigned)w; }

struct EpiProj {
    static constexpr bool PERM = true, AFTER_DRAIN = false;
    bf16_t *Q, *V; const float* rope;
    __device__ __forceinline__ void operator()(const f32x4 (&acc)[2][2][4][2], const Unit& u, int wr, int wc, int fr, int fq) const {
        const int row0 = u.pm * BM + wr * 64 + fr, lc0 = wc * 32 + 8 * fq;
        if (u.pn < 2) {
            bf16_t* base = Q + (size_t)u.pn * ((size_t)65536 * 256); const float sc = u.pn == 0 ? 1.0f : 0.125f;
            f32x4 tb[4][2][2]; u32x4 wv[4][2];
#pragma unroll
            for (int ai = 0; ai < 2; ++ai) {
#pragma unroll
                for (int m = 0; m < 4; ++m) { const int pos = 16 + ((row0 + ai * HALF + m * 16) & 4095);
#pragma unroll
                    for (int bj = 0; bj < 2; ++bj) { const f32x4* tp = (const f32x4*)(rope + ((size_t)pos * 32 + (((lc0 + bj * HALF) & 63) >> 1)) * 2); tb[m][bj][0] = tp[0]; tb[m][bj][1] = tp[1]; } }
                asm volatile("" ::: "memory");
                if (ai == 1) {
#pragma unroll
                    for (int m = 0; m < 4; ++m)
#pragma unroll
                        for (int bj = 0; bj < 2; ++bj) *(u32x4*)(base + (size_t)(row0 + m * 16) * 256 + lc0 + bj * HALF) = wv[m][bj];
                    asm volatile("" ::: "memory"); }
#pragma unroll
                for (int m = 0; m < 4; ++m)
#pragma unroll
                    for (int bj = 0; bj < 2; ++bj) { const f32x4 t0 = tb[m][bj][0], t1 = tb[m][bj][1]; const f32x4 v0 = acc[ai][bj][m][0], v1 = acc[ai][bj][m][1];
                        const float o0 = (v0[0] * t0[0] - v0[1] * t0[1]) * sc, o1 = (v0[0] * t0[1] + v0[1] * t0[0]) * sc;
                        const float o2 = (v0[2] * t0[2] - v0[3] * t0[3]) * sc, o3 = (v0[2] * t0[3] + v0[3] * t0[2]) * sc;
                        const float o4 = (v1[0] * t1[0] - v1[1] * t1[1]) * sc, o5 = (v1[0] * t1[1] + v1[1] * t1[0]) * sc;
                        const float o6 = (v1[2] * t1[2] - v1[3] * t1[3]) * sc, o7 = (v1[2] * t1[3] + v1[3] * t1[2]) * sc;
                        wv[m][bj].x = cvt_pk_bf16(o0, o1); wv[m][bj].y = cvt_pk_bf16(o2, o3); wv[m][bj].z = cvt_pk_bf16(o4, o5); wv[m][bj].w = cvt_pk_bf16(o6, o7); }
            }
#pragma unroll
            for (int m = 0; m < 4; ++m)
#pragma unroll
                for (int bj = 0; bj < 2; ++bj) *(u32x4*)(base + (size_t)(row0 + HALF + m * 16) * 256 + lc0 + bj * HALF) = wv[m][bj];
        } else {
            bf16_t* base = V + (size_t)((u.pn - 2) >> 1) * ((size_t)65536 * 512); const int colt = (u.pn & 1) * 256;
#pragma unroll
            for (int ai = 0; ai < 2; ++ai)
#pragma unroll
                for (int m = 0; m < 4; ++m) { bf16_t* rowp = base + (size_t)(row0 + ai * HALF + m * 16) * 512 + colt + lc0;
#pragma unroll
                    for (int bj = 0; bj < 2; ++bj) { const f32x4 v0 = acc[ai][bj][m][0], v1 = acc[ai][bj][m][1];
                        u32x4 w; w.x = cvt_pk_bf16(v0[0], v0[1]); w.y = cvt_pk_bf16(v0[2], v0[3]); w.z = cvt_pk_bf16(v1[0], v1[1]); w.w = cvt_pk_bf16(v1[2], v1[3]);
                        *(u32x4*)(rowp + bj * HALF) = w; } }
        }
    }
};
struct EpiMix {
    static constexpr bool PERM = true, AFTER_DRAIN = false;
    bf16_t* T;
    __device__ __forceinline__ void operator()(const f32x4 (&acc)[2][2][4][2], const Unit& u, int wr, int wc, int fr, int fq) const {
        const int row0 = u.pm * BM + wr * 64 + fr, col0 = u.pn * BM + wc * 32 + 8 * fq;
#pragma unroll
        for (int ai = 0; ai < 2; ++ai)
#pragma unroll
            for (int m = 0; m < 4; ++m) { bf16_t* rowp = T + (size_t)(row0 + ai * HALF + m * 16) * 1024 + col0;
#pragma unroll
                for (int bj = 0; bj < 2; ++bj) { const f32x4 v0 = acc[ai][bj][m][0], v1 = acc[ai][bj][m][1];
                    u32x4 w; w.x = cvt_pk_bf16(v0[0], v0[1]); w.y = cvt_pk_bf16(v0[2], v0[3]); w.z = cvt_pk_bf16(v1[0], v1[1]); w.w = cvt_pk_bf16(v1[2], v1[3]);
                    *(u32x4*)(rowp + bj * HALF) = w; } }
    }
};
struct EpiGateUp {
    static constexpr bool PERM = true, AFTER_DRAIN = false;
    unsigned char* HID;
    __device__ __forceinline__ void operator()(const f32x4 (&acc)[2][2][4][2], const Unit& u, int wr, int wc, int fr, int fq) const {
        const int row0 = u.pm * BM + wr * 64 + fr, hc = (u.pn & 3) * 128 + wc * 32 + 8 * fq;
#pragma unroll
        for (int ai = 0; ai < 2; ++ai)
#pragma unroll
            for (int m = 0; m < 4; ++m) { float h[8];
#pragma unroll
                for (int n = 0; n < 2; ++n)
#pragma unroll
                    for (int j = 0; j < 4; ++j) { const float g = acc[ai][0][m][n][j] * 0.03125f, up = acc[ai][1][m][n][j] * 0.03125f; h[4 * n + j] = g * up * __builtin_amdgcn_rcpf(1.0f + __expf(-g)); }
                typedef unsigned u32x2e __attribute__((ext_vector_type(2))); u32x2e w; w.x = pk4_fp8((f32x4){h[0], h[1], h[2], h[3]}); w.y = pk4_fp8((f32x4){h[4], h[5], h[6], h[7]});
                *(u32x2e*)(HID + (size_t)(row0 + ai * HALF + m * 16) * 512 + hc) = w; }
    }
};
struct EpiDown {
    static constexpr bool PERM = true, AFTER_DRAIN = false;
    unsigned char* YP; const float* PW;
    __device__ __forceinline__ void operator()(const f32x4 (&acc)[2][2][4][2], const Unit& u, int wr, int wc, int fr, int fq) const {
        const int row0 = u.pm * BM + wr * 64 + fr, col0 = (u.pn & 3) * BM + wc * 64 + 16 * fq;
        float pwv[8];
#pragma unroll
        for (int i = 0; i < 8; ++i) pwv[i] = PW[row0 + (i >> 2) * HALF + (i & 3) * 16];
        asm volatile("" ::: "memory");
#pragma unroll
        for (int ai = 0; ai < 2; ++ai)
#pragma unroll
            for (int m = 0; m < 4; ++m) { const int row = row0 + ai * HALF + m * 16; const float sc = pwv[ai * 4 + m] * 2.0f;
                u32x4 w; w.x = pk4_fp8(acc[ai][0][m][0] * sc); w.y = pk4_fp8(acc[ai][0][m][1] * sc); w.z = pk4_fp8(acc[ai][1][m][0] * sc); w.w = pk4_fp8(acc[ai][1][m][1] * sc);
                *(u32x4*)(YP + (size_t)row * 1024 + col0) = w; }
    }
};
struct RotOrder : StaticOrder {
    __device__ __forceinline__ bool next(int i, Unit& u) const { if (!StaticOrder::next(i, u)) return false; u.pn = (u.pn + (i >> 1)) % nN; return true; }
};
struct OwnPanelOrder {
    int c, ntn;
    __device__ __forceinline__ bool next(int i, Unit& u) const { if (i >= ntn) return false; u.pm = c; u.pn = i; return true; }
    __device__ __forceinline__ void a_ready(const Unit&) const {}
    __device__ __forceinline__ void done(const Unit&) const {}
};
struct GroupedOrder {
    const PG8_LAS int* pp; int nwg, G, c;
    __device__ __forceinline__ void init(const PG8_LAS int* pp_, int G_, int c_) { pp = pp_; nwg = pp_[32] * 4; G = G_; c = c_; }
    __device__ __forceinline__ bool next(int i, Unit& u) const {
        const long L = (long)i * G + c; if (L >= nwg) return false;
        int wgid = (int)L; { const int q = nwg / NXCD, r = nwg % NXCD, xcd = wgid % NXCD, off = wgid / NXCD; wgid = (xcd < r ? xcd * (q + 1) : r * (q + 1) + (xcd - r) * q) + off; }
        const int panel = wgid >> 2; int e = 0;
#pragma unroll
        for (int k = 1; k < 32; ++k) e += (pp[k] <= panel) ? 1 : 0;
        u.pm = panel; u.pn = e * 4 + (wgid & 3); return true;
    }
    __device__ __forceinline__ void a_ready(const Unit&) const {}
    __device__ __forceinline__ void done(const Unit&) const {}
};
__device__ __forceinline__ void gather_off(const int* gidx, int pm, int K, int tid, unsigned (&v0)[2], unsigned (&v1)[2]) {
#pragma unroll
    for (int i = 0; i < 2; ++i) { int R, C; stage_rc(tid * 16 + i * 8192, R, C); v0[i] = (unsigned)(gidx[pm * 256 + R] * K + C) * 2u; v1[i] = (unsigned)(gidx[pm * 256 + 128 + R] * K + C) * 2u; }
}
typedef int v8i32 __attribute__((ext_vector_type(8))); typedef int v4i32 __attribute__((ext_vector_type(4)));
__device__ __forceinline__ v8i32 cat16(const bf16x8 lo, const bf16x8 hi) { return __builtin_shufflevector(__builtin_bit_cast(v4i32, lo), __builtin_bit_cast(v4i32, hi), 0, 1, 2, 3, 4, 5, 6, 7); }
template <class Epi, class Sched, bool ALIGN_EPI = false, bool SP2 = false, bool GATHER = false, bool FP8 = false>
__device__ __forceinline__ void gemm_phase(PG8_LAS unsigned char* lds, const Gemm g, const Sched& S, const Epi& E, const int wid) {
    int lane; asm volatile("v_mbcnt_lo_u32_b32 %0, -1, 0\n\tv_mbcnt_hi_u32_b32 %0, -1, %0" : "=v"(lane));
    const int tid = wid * 64 + lane, wr = wid >> 2, wc = wid & 3, fr = lane & 15, fq = lane >> 4;
    const int K = g.K, nt = K / BK;
    unsigned voffA[2], voffB[2];
#pragma unroll
    for (int i = 0; i < 2; ++i) { int R, C; stage_rc(tid * 16 + i * 8192, R, C); const int Rb = Epi::PERM ? ((R & ~31) + perm32(R & 31)) : R;
        voffA[i] = (unsigned)(R * K + C) * 2u; voffB[i] = (unsigned)(Rb * K + C) * 2u; }
    static_assert(SP2 || !GATHER, "GATHER is written for the SP2 loop");
    unsigned cv0[2] = {0u, 0u}, cv1[2] = {0u, 0u}, nv0[2] = {0u, 0u}, nv1[2] = {0u, 0u};
    const size_t kstep = (size_t)(BK * 2);
    const size_t hstep = (size_t)HALF * K * 2;
    const size_t tstep = 2 * hstep;
    const unsigned ldsw = (unsigned)wid * 1024u;
    const int aoff = lds_byte(wr * 64 + fr, fq * 8), boff = lds_byte(wc * 32 + fr, fq * 8);
#define PG8_SA(b, h) (((b) * 2 + (h)) * HTB)
#define PG8_SB(b, h) ((4 + (b) * 2 + (h)) * HTB)
#define PG8_STAGE(bufoff, gbase, voff) do { _Pragma("unroll") for (int _i = 0; _i < 2; ++_i) \
        __builtin_amdgcn_global_load_lds((const unsigned*)((const char*)(gbase) + (voff)[_i]), (PG8_LAS unsigned*)(lds + (bufoff) + ldsw + _i * 8192), 16, 0, 0); } while (0)
#define PG8_STAGE_A0C(bufoff, gb) do { if constexpr (GATHER) PG8_STAGE(bufoff, gb, cv0); else PG8_STAGE(bufoff, gb, voffA); } while (0)
#define PG8_STAGE_A1C(bufoff, gb) do { if constexpr (GATHER) PG8_STAGE(bufoff, gb, cv1); else PG8_STAGE(bufoff, (gb) + hstep, voffA); } while (0)
#define PG8_STAGE_A0X(bufoff, gb) do { if constexpr (GATHER) PG8_STAGE(bufoff, gb, sv0); else PG8_STAGE(bufoff, gb, voffA); } while (0)
#define PG8_STAGE_A1X(bufoff, gb) do { if constexpr (GATHER) PG8_STAGE(bufoff, gb, sv1); else PG8_STAGE(bufoff, (gb) + hstep, voffA); } while (0)
#define PG8_LDA(dst, b, h) do { _Pragma("unroll") for (int m = 0; m < 4; ++m) _Pragma("unroll") for (int k = 0; k < 2; ++k) dst[m][k] = *(const PG8_LAS bf16x8*)(lds + PG8_SA(b, h) + aoff + m * 2048 + k * 1024); } while (0)
#define PG8_LDB(dst, b, h) do { _Pragma("unroll") for (int n = 0; n < 2; ++n) _Pragma("unroll") for (int k = 0; k < 2; ++k) dst[n][k] = *(const PG8_LAS bf16x8*)(lds + PG8_SB(b, h) + boff + n * 2048 + k * 1024); } while (0)
#define PG8_MMA(ai, bj, At, Bt) do { __builtin_amdgcn_s_setprio(1); if constexpr (FP8) { _Pragma("unroll") for (int m = 0; m < 4; ++m) _Pragma("unroll") for (int n = 0; n < 2; ++n) \
        { const v8i32 a8_ = cat16(Bt[n][0], Bt[n][1]), b8_ = cat16(At[m][0], At[m][1]); asm volatile("v_mfma_scale_f32_16x16x128_f8f6f4 %0, %1, %2, %0, %3, %3 op_sel_hi:[0,0,0]" : "+v"(acc[ai][bj][m][n]) : "v"(a8_), "v"(b8_), "v"(mx_unit)); } } else { \
        _Pragma("unroll") for (int m = 0; m < 4; ++m) _Pragma("unroll") for (int n = 0; n < 2; ++n) _Pragma("unroll") for (int k = 0; k < 2; ++k) \
        acc[ai][bj][m][n] = __builtin_amdgcn_mfma_f32_16x16x32_bf16(Bt[n][k], At[m][k], acc[ai][bj][m][n], 0, 0, 0); } __builtin_amdgcn_s_setprio(0); } while (0)
#define PG8_WAIT_V(n) asm volatile("s_waitcnt vmcnt(" #n ")" ::: "memory")
#define PG8_WAIT_L(n) asm volatile("s_waitcnt lgkmcnt(" #n ")" ::: "memory")
#define PG8_BAR __builtin_amdgcn_s_barrier()
#define PG8_SCHED __builtin_amdgcn_sched_barrier(0)
    const int mx_unit = 0x7f7f7f7f;
    Unit cur, nxt; int ui = 0;
    if (!S.next(0, cur)) return;
    f32x4 acc[2][2][4][2];
#pragma unroll
    for (int a = 0; a < 2; ++a)
#pragma unroll
        for (int b = 0; b < 2; ++b)
#pragma unroll
            for (int m = 0; m < 4; ++m)
#pragma unroll
                for (int n = 0; n < 2; ++n) acc[a][b][m][n] = (f32x4){0.f, 0.f, 0.f, 0.f};
    bf16x8 At[4][2], B0[2][2], B1[2][2];
    const char* cA = (const char*)g.A + (GATHER ? (size_t)0 : (size_t)cur.pm * tstep); const char* cB = (const char*)g.Bt + (size_t)cur.pn * tstep;
    if constexpr (GATHER) gather_off(g.gidx, cur.pm, K, tid, cv0, cv1);
    S.a_ready(cur);
    if constexpr (SP2) {
        PG8_STAGE(PG8_SB(0, 0), cB, voffB); PG8_STAGE(PG8_SB(0, 1), cB + hstep, voffB); PG8_STAGE_A0C(PG8_SA(0, 0), cA); PG8_STAGE_A1C(PG8_SA(0, 1), cA);
        if (wr == 1) PG8_BAR;
        PG8_WAIT_V(2); PG8_BAR;
        PG8_STAGE(PG8_SB(1, 0), cB + kstep, voffB); PG8_STAGE_A0C(PG8_SA(1, 0), cA + kstep); PG8_STAGE(PG8_SB(1, 1), cB + hstep + kstep, voffB);
        PG8_WAIT_V(6); PG8_BAR;
    } else {
        PG8_STAGE(PG8_SB(0, 0), cB, voffB); PG8_STAGE(PG8_SA(0, 0), cA, voffA); PG8_STAGE(PG8_SB(0, 1), cB + hstep, voffB); PG8_STAGE(PG8_SA(0, 1), cA + hstep, voffA);
        if (wr == 1) PG8_BAR;
        PG8_WAIT_V(4); PG8_BAR;
        PG8_STAGE(PG8_SB(1, 0), cB + kstep, voffB); PG8_STAGE(PG8_SA(1, 0), cA + kstep, voffA); PG8_STAGE(PG8_SB(1, 1), cB + hstep + kstep, voffB);
        PG8_WAIT_V(6); PG8_BAR;
    }
    for (;;) {
        const bool has_next = S.next(ui + 1, nxt);
        if constexpr (GATHER) { if (has_next) gather_off(g.gidx, nxt.pm, K, tid, nv0, nv1); else { nv0[0] = cv0[0]; nv0[1] = cv0[1]; nv1[0] = cv1[0]; nv1[1] = cv1[1]; } }
        const char* nA = GATHER ? cA : (has_next ? (const char*)g.A + (size_t)nxt.pm * tstep : cA); const char* nB = has_next ? (const char*)g.Bt + (size_t)nxt.pn * tstep : cB;
#pragma unroll 1
        for (int t = 0; t < nt; t += 2) {
            const bool last = (t == nt - 2);
            const char* a1 = cA + (size_t)(t + 1) * kstep;
            const char* a2 = last ? nA : cA + (size_t)(t + 2) * kstep; const char* b2 = last ? nB : cB + (size_t)(t + 2) * kstep;
            const char* a3 = a2 + kstep; const char* b3 = b2 + kstep;
            if (last && has_next) S.a_ready(nxt);
            unsigned sv0[2], sv1[2]; sv0[0] = last ? nv0[0] : cv0[0]; sv0[1] = last ? nv0[1] : cv0[1]; sv1[0] = last ? nv1[0] : cv1[0]; sv1[1] = last ? nv1[1] : cv1[1];
            if constexpr (SP2) {
            PG8_LDB(B0, 0, 0); PG8_LDB(B1, 0, 1); PG8_SCHED; PG8_LDA(At, 0, 0); PG8_STAGE_A1C(PG8_SA(1, 1), a1);
            PG8_WAIT_V(8); PG8_WAIT_L(0); PG8_BAR; PG8_MMA(0, 0, At, B0); PG8_MMA(0, 1, At, B1); PG8_BAR; PG8_SCHED;
            PG8_LDA(At, 0, 1); PG8_STAGE(PG8_SB(0, 0), b2, voffB); PG8_STAGE(PG8_SB(0, 1), b2 + hstep, voffB); PG8_STAGE_A0X(PG8_SA(0, 0), a2);
            PG8_WAIT_V(8); PG8_WAIT_L(0); PG8_BAR; PG8_MMA(1, 0, At, B0); PG8_MMA(1, 1, At, B1); PG8_BAR; PG8_SCHED;
            PG8_LDB(B0, 1, 0); PG8_LDB(B1, 1, 1); PG8_SCHED; PG8_LDA(At, 1, 0); PG8_STAGE_A1X(PG8_SA(0, 1), a2);
            PG8_WAIT_V(8); PG8_WAIT_L(0); PG8_BAR; PG8_MMA(0, 0, At, B0); PG8_MMA(0, 1, At, B1); PG8_BAR; PG8_SCHED;
            PG8_LDA(At, 1, 1); PG8_STAGE(PG8_SB(1, 0), b3, voffB); PG8_STAGE(PG8_SB(1, 1), b3 + hstep, voffB); PG8_STAGE_A0X(PG8_SA(1, 0), a3);
            PG8_WAIT_V(8); PG8_WAIT_L(0); PG8_BAR; PG8_MMA(1, 0, At, B0); PG8_MMA(1, 1, At, B1); PG8_BAR; PG8_SCHED;
            } else {
            PG8_LDB(B0, 0, 0); PG8_SCHED; PG8_LDA(At, 0, 0); PG8_STAGE(PG8_SA(1, 1), a1 + hstep, voffA);
            PG8_WAIT_L(8); PG8_BAR; PG8_WAIT_L(0); PG8_MMA(0, 0, At, B0); PG8_BAR; PG8_SCHED;
            PG8_LDB(B1, 0, 1); PG8_STAGE(PG8_SB(0, 0), b2, voffB);
            PG8_BAR; PG8_WAIT_L(0); PG8_MMA(0, 1, At, B1); PG8_BAR;
            PG8_LDA(At, 0, 1); PG8_STAGE(PG8_SA(0, 0), a2, voffA);
            PG8_BAR; PG8_WAIT_L(0); PG8_MMA(1, 0, At, B0); PG8_BAR; PG8_SCHED;
            PG8_STAGE(PG8_SB(0, 1), b2 + hstep, voffB);
            PG8_WAIT_V(6); PG8_BAR; PG8_MMA(1, 1, At, B1); PG8_BAR;
            PG8_LDB(B0, 1, 0); PG8_SCHED; PG8_LDA(At, 1, 0); PG8_STAGE(PG8_SA(0, 1), a2 + hstep, voffA);
            PG8_WAIT_L(8); PG8_BAR; PG8_WAIT_L(0); PG8_MMA(0, 0, At, B0); PG8_BAR; PG8_SCHED;
            PG8_LDB(B1, 1, 1); PG8_STAGE(PG8_SB(1, 0), b3, voffB);
            PG8_BAR; PG8_WAIT_L(0); PG8_MMA(0, 1, At, B1); PG8_BAR;
            PG8_LDA(At, 1, 1); PG8_STAGE(PG8_SA(1, 0), a3, voffA);
            PG8_BAR; PG8_WAIT_L(0); PG8_MMA(1, 0, At, B0); PG8_BAR; PG8_SCHED;
            PG8_STAGE(PG8_SB(1, 1), b3 + hstep, voffB);
            PG8_WAIT_V(6); PG8_BAR; PG8_MMA(1, 1, At, B1); PG8_BAR;
            }
        }
        if constexpr (ALIGN_EPI) { if (wr == 0) PG8_BAR; }
        if constexpr (FP8) asm volatile("s_nop 15\n\ts_nop 15" ::: "memory");
        if constexpr (!Epi::AFTER_DRAIN) { E(acc, cur, wr, wc, fr, fq); S.done(cur); }
        if (!has_next) break;
#pragma unroll
        for (int a = 0; a < 2; ++a)
#pragma unroll
            for (int b = 0; b < 2; ++b)
#pragma unroll
                for (int m = 0; m < 4; ++m)
#pragma unroll
                    for (int n = 0; n < 2; ++n) acc[a][b][m][n] = (f32x4){0.f, 0.f, 0.f, 0.f};
        cur = nxt; cA = nA; cB = nB; ++ui;
        if constexpr (GATHER) { cv0[0] = nv0[0]; cv0[1] = nv0[1]; cv1[0] = nv1[0]; cv1[1] = nv1[1]; }
        if constexpr (ALIGN_EPI) { if (wr == 1) PG8_BAR; }
    }
    PG8_WAIT_V(0);
    if constexpr (!ALIGN_EPI) { if (wr == 0) PG8_BAR; }
    PG8_BAR;
    if constexpr (Epi::AFTER_DRAIN) { E.fused(acc, cur, wr, wc, fr, fq, lds, wid, lane); S.done(cur); }
#undef PG8_SA
#undef PG8_SB
#undef PG8_STAGE
#undef PG8_LDA
#undef PG8_STAGE_A0C
#undef PG8_STAGE_A1C
#undef PG8_STAGE_A0X
#undef PG8_STAGE_A1X
#undef PG8_LDB
#undef PG8_MMA
#undef PG8_WAIT_V
#undef PG8_WAIT_L
#undef PG8_BAR
#undef PG8_SCHED
}
}

constexpr int NWAVES = 8;
constexpr int N_LAUNCHES = MK_N_LAUNCHES;
constexpr int PER_PHASE = 10;

constexpr int BATCH = 16, SEQ = 4096, D = 1024, NMETA = 16;
constexpr int M = BATCH * SEQ;
constexpr int NPROJ = 2048, NEXP = 32, DEXP = 512;
constexpr int NPANEL_MAX = 544, SLOTS = NPANEL_MAX * 256;
constexpr float LN_EPS = 1e-5f, GN_EPS = 1e-6f;
constexpr float ALPHA = 1.189207115002721f;

constexpr size_t MiB = 1u << 20;
constexpr size_t WS_CTL = 0, CTL_ZERO_BYTES = 1 * MiB;
constexpr size_t WS_WIN = 2 * MiB;
constexpr size_t WS_WOUT = 6 * MiB;
constexpr size_t WS_WPOOL = 8 * MiB;
constexpr size_t WS_RW = 8 * MiB + 256 * 1024;
constexpr size_t WS_METAK = 8 * MiB + 512 * 1024;
constexpr size_t WS_METAV = WS_METAK + 16 * 256 * 4;
constexpr size_t WS_METAU = WS_METAV + 16 * 512 * 4;
constexpr size_t WS_ROPE = 9 * MiB;
constexpr size_t WS_TOKE = 12 * MiB;
constexpr size_t WS_TOKL = WS_TOKE + (size_t)M * 4;
constexpr size_t WS_TOKW = WS_TOKL + (size_t)M * 4;
constexpr size_t WS_TOKS = WS_TOKW + (size_t)M * 8;
constexpr size_t WS_CNT = 14 * MiB;
constexpr size_t WS_PW = 15 * MiB;
constexpr size_t WS_STOK = 16 * MiB;
constexpr size_t WS_WGU = 32 * MiB;
constexpr size_t WS_WD = 96 * MiB;
constexpr size_t WS_ST = 128 * MiB;
constexpr size_t WS_H0 = 160 * MiB;
constexpr size_t WS_Q = 288 * MiB, WS_K = 320 * MiB;
constexpr size_t WS_V = 352 * MiB, WS_GATE = 416 * MiB, WS_U = 480 * MiB;
constexpr size_t WS_MIXIN = 544 * MiB;
constexpr size_t WS_T1 = 672 * MiB;
constexpr size_t WS_H1B = 288 * MiB;
constexpr size_t WS_HID = 688 * MiB;
constexpr size_t WS_H1F8 = 928 * MiB;
constexpr size_t WS_YP = 416 * MiB;
constexpr size_t WS_END = 992 * MiB;
static_assert(WS_ROPE + (size_t)4112 * 32 * 8 <= WS_TOKE && WS_TOKS + (size_t)M * 8 <= WS_CNT && WS_PW + (size_t)SLOTS * 4 <= WS_WGU, "small tables");
static_assert(WS_K == WS_Q + (size_t)M * 256 * 2 && WS_GATE == WS_V + (size_t)M * 512 * 2 && WS_U == WS_GATE + (size_t)M * 512 * 2, "EpiProj addresses K, gate, u relative to Q, V");
static_assert(WS_STOK + (size_t)SLOTS * 4 <= WS_WGU && WS_YP + (size_t)SLOTS * 1024 <= WS_HID && WS_HID + (size_t)SLOTS * 512 <= WS_H1F8 && WS_H1F8 + (size_t)M * 1024 <= WS_END && WS_WGU + (size_t)32 * 1024 * 1024 <= WS_WD && WS_WD + (size_t)32 * 1024 * 512 <= WS_ST && WS_T1 + (size_t)M * 1024 * 2 <= WS_END, "d_ws map");
constexpr int CW_BAR = 4096;

constexpr int RING_OFF = 0, RING_BYTES = 131072;
constexpr int LDSCTL_OFF = RING_BYTES;
constexpr int PP_OFF = LDSCTL_OFF, TOT_OFF = LDSCTL_OFF + 192, BEF_OFF = LDSCTL_OFF + 320, BASE_OFF = LDSCTL_OFF + 448, LCNT_OFF = LDSCTL_OFF + 576, MISC_OFF = LDSCTL_OFF + 768;
constexpr int LDS_BYTES = 147456;
static_assert(MISC_OFF + 128 <= LDS_BYTES, "LDS map");
#define GAS __attribute__((address_space(1)))
#define LAS __attribute__((address_space(3)))
typedef unsigned short bf16;
typedef unsigned v4u __attribute__((ext_vector_type(4)));
typedef float f32x4 __attribute__((ext_vector_type(4)));
typedef short bf16x8 __attribute__((ext_vector_type(8)));
typedef GAS unsigned gu32;
typedef GAS unsigned long long gu64;
#define RLX_AGENT __ATOMIC_RELAXED, __HIP_MEMORY_SCOPE_AGENT
#define LDS_WAIT() asm volatile("s_waitcnt lgkmcnt(0)" ::: "memory")
#define VM_WAIT() asm volatile("s_waitcnt vmcnt(0)" ::: "memory")
__device__ __forceinline__ unsigned long long rt() { return __builtin_amdgcn_s_memrealtime(); }
__device__ __forceinline__ unsigned f2bf(float f) { unsigned u = __builtin_bit_cast(unsigned, f); return (u + 0x7fffu + ((u >> 16) & 1u)) >> 16; }
__device__ __forceinline__ unsigned pk2(float lo, float hi) { return f2bf(lo) | (f2bf(hi) << 16); }

#define XB_TMO      128
#define XB_XCNT(j)  (256  + 64 * (j))
#define XB_XSUB(j)  (1280 + 64 * (j))
#define XB_XGEN(j)  (2304 + 64 * (j))
#define XB_TOP      3328
#define XB_TOPGEN   3392
#define XCD_BAR_WORDS 3456
#define XB_SPIN_CAP (1u << 18)

__device__ __forceinline__ unsigned xb_ld(unsigned* p)              { return __hip_atomic_load(p, __ATOMIC_RELAXED, __HIP_MEMORY_SCOPE_AGENT); }
__device__ __forceinline__ unsigned xb_add(unsigned* p, unsigned v) { return __hip_atomic_fetch_add(p, v, __ATOMIC_RELAXED, __HIP_MEMORY_SCOPE_AGENT); }
__device__ __forceinline__ unsigned xb_xcc_id() { return (unsigned)__builtin_amdgcn_s_getreg((3 << 11) | 20) & 0xFu; }
#define XB_SPIN(cond, bar) do { unsigned _sp = 0; while (cond) { __builtin_amdgcn_s_sleep(1); \
    if ((++_sp & 255u) == 0u) { if (xb_ld(&(bar)[XB_TMO])) break; if (_sp > XB_SPIN_CAP) { atomicAdd(&(bar)[XB_TMO], 1u); break; } } } } while (0)

struct XcdBarrier {
    unsigned* bar; unsigned x;
    volatile LAS unsigned* st;
};

__device__ __forceinline__ XcdBarrier xcd_barrier_post(unsigned* bar, volatile LAS unsigned* st) {
    XcdBarrier b; b.bar = bar; b.x = xb_xcc_id(); b.st = st;
    if (threadIdx.x == 0) (void)xb_add(&bar[XB_XCNT(b.x)], 1u);
    return b;
}
__device__ __forceinline__ void xcd_barrier_complete(unsigned* bar, unsigned x, unsigned& nloc, unsigned& nx) {
    const unsigned G = gridDim.x * gridDim.y * gridDim.z;
    unsigned sum, cnt, mine, sp = 0u;
    for (;;) {
        sum = 0u; cnt = 0u; mine = 0u;
#pragma unroll
        for (unsigned j = 0; j < 16; ++j) { const unsigned c = xb_ld(&bar[XB_XCNT(j)]); sum += c; cnt += (c > 0u) ? 1u : 0u; mine = (j == x) ? c : mine; }
        if (sum == G) break;
        __builtin_amdgcn_s_sleep(1);
        if ((++sp & 255u) == 0u) { if (xb_ld(&bar[XB_TMO])) break; if (sp > XB_SPIN_CAP) { atomicAdd(&bar[XB_TMO], 1u); break; } }
    }
    nloc = mine > 0u ? mine : 1u; nx = cnt > 0u ? cnt : 1u;
}

__device__ __forceinline__ void xcd_barrier(const XcdBarrier& b) {
    asm volatile("s_waitcnt vmcnt(0)" ::: "memory");
    __syncthreads();
    if (threadIdx.x == 0) {
        unsigned* bar = b.bar;
        __builtin_amdgcn_s_waitcnt(0);
        unsigned nloc = b.st[0], nx = b.st[1];
        if (nloc == 0u) { xcd_barrier_complete(bar, b.x, nloc, nx); b.st[0] = nloc; b.st[1] = nx; }
        const unsigned old = xb_add(&bar[XB_XSUB(b.x)], 1u);
        const unsigned gen = old / nloc;
        if (old + 1u == (gen + 1u) * nloc) {
            __builtin_amdgcn_fence(__ATOMIC_RELEASE, "agent");
            asm volatile("s_waitcnt vmcnt(0)" ::: "memory");
            const unsigned og = xb_add(&bar[XB_TOP], 1u);
            const unsigned tg = og / nx;
            if (og + 1u == (tg + 1u) * nx) xb_add(&bar[XB_TOPGEN], 1u);
            else XB_SPIN(xb_ld(&bar[XB_TOPGEN]) == tg, bar);
            __builtin_amdgcn_fence(__ATOMIC_ACQUIRE, "agent");
            xb_add(&bar[XB_XGEN(b.x)], 1u);
            asm volatile("s_waitcnt vmcnt(0)" ::: "memory");
        } else {
            XB_SPIN(xb_ld(&bar[XB_XGEN(b.x)]) == gen, bar);
            __builtin_amdgcn_fence(__ATOMIC_ACQUIRE, "agent");
            asm volatile("s_waitcnt vmcnt(0)" ::: "memory");
        }
    }
    __syncthreads();
}

#define DI __device__ __forceinline__
typedef short v4i16_t __attribute__((ext_vector_type(4)));
typedef unsigned u32x2 __attribute__((ext_vector_type(2)));
typedef float f32x2 __attribute__((ext_vector_type(2)));
struct Frame {
    LAS unsigned char* lds;
    volatile LAS unsigned* MISC;
    gu32* ctl;
    int tid, lane, wave;
    int vcu, G;
    const float *x, *meta, *lne_g, *lne_b, *w_in, *pool_w, *pool_b, *pool_scale, *w_out, *ln1_g, *ln1_b, *rg_w, *rg_b, *re_w, *re_b, *w_gate, *w_up, *w_down, *ln2_g, *ln2_b;
    float* out;
    bf16 *Win_t, *Wout_t, *Wpool_t;
    unsigned char *Wgu8, *Wd8, *H1F8, *HID;
    float *RW, *metak, *metav, *metau, *rope, *PW; bf16* T1;
    unsigned *toke, *tokl; f32x2* tokw; int* toks; int* cnt; int* stok;
    bf16 *ST, *H0, *Qb, *Kb, *Vb, *Gb, *Ub, *MIXIN, *H1B; unsigned char* YP;
};
DI float wave_sum(float v) {
#pragma unroll
    for (int o = 1; o < 64; o <<= 1) v += __shfl_xor(v, o);
    return v;
}
DI float bf2f(bf16 v) { return __uint_as_float(((unsigned)v) << 16); }
DI float bflo(unsigned w) { return __uint_as_float(w << 16); }
DI float bfhi(unsigned w) { return __uint_as_float(w & 0xffff0000u); }
DI unsigned cvtpk(float lo, float hi) { return pg8::cvt_pk_bf16(lo, hi); }
DI unsigned pk4f8(float a, float b, float c, float d) { int w = __builtin_amdgcn_cvt_pk_fp8_f32(a, b, 0, false); w = __builtin_amdgcn_cvt_pk_fp8_f32(c, d, w, true); return (unsigned)w; }

template <int MODE> DI int rowmap(int n) {
    if (MODE == 1) { if (n < 512) { const int i = n & 63; return (n & ~63) + (i < 32 ? 2 * i : 2 * (i - 32) + 1); } return n; }
    if (MODE == 2) return 256 * (n >> 7) + (n & 127);
    if (MODE == 3) return 256 * (n >> 7) + 128 + (n & 127);
    if (MODE == 4) { const int o = n & 255; return (n & ~255) + 128 * ((o >> 3) & 1) + 32 * (o >> 6) + 8 * ((o >> 4) & 3) + (o & 7); }
    return n;
}
template <int MODE, bool F8 = false> DI void p0_transpose_item(const float* W, int K, int N, void* WTv, LAS float* scr, int item, int lane) {
    const int nblk = N / 32, kb = item / nblk, nb = item % nblk, k0 = 64 * kb, n0 = 32 * nb;
    f32x4 tv[8];
#pragma unroll
    for (int i = 0; i < 8; ++i) tv[i] = *(const GAS f32x4*)(W + (size_t)(k0 + i * 8 + (lane >> 3)) * N + n0 + 4 * (lane & 7));
#pragma unroll
    for (int i = 0; i < 8; ++i) { LAS float* d = scr + (i * 8 + (lane >> 3)) * 33 + 4 * (lane & 7); d[0] = tv[i].x; d[1] = tv[i].y; d[2] = tv[i].z; d[3] = tv[i].w; }
    LDS_WAIT(); asm volatile("" ::: "memory");
    const int c = lane & 7;
#pragma unroll
    for (int j = 0; j < 4; ++j) { const int n = (lane >> 3) + 8 * j; const LAS float* s = scr + (8 * c) * 33 + n;
        if constexpr (F8) { u32x2 o; o.x = pk4f8(32.f * s[0 * 33], 32.f * s[1 * 33], 32.f * s[2 * 33], 32.f * s[3 * 33]); o.y = pk4f8(32.f * s[4 * 33], 32.f * s[5 * 33], 32.f * s[6 * 33], 32.f * s[7 * 33]);
            *(GAS u32x2*)((unsigned char*)WTv + (size_t)rowmap<MODE>(n0 + n) * K + k0 + 8 * c) = o; }
        else { bf16* WT = (bf16*)WTv; v4u o; o.x = pk2(s[0 * 33], s[1 * 33]); o.y = pk2(s[2 * 33], s[3 * 33]); o.z = pk2(s[4 * 33], s[5 * 33]); o.w = pk2(s[6 * 33], s[7 * 33]);
            *(GAS v4u*)(WT + (size_t)rowmap<MODE>(n0 + n) * K + k0 + 8 * c) = o; } }
    LDS_WAIT(); asm volatile("" ::: "memory");
}
DI void ld_row(const float* xrow, f32x4 (&v)[4], int lane) {
    const GAS f32x4* xr = (const GAS f32x4*)xrow + lane;
#pragma unroll
    for (int j = 0; j < 4; ++j) v[j] = xr[64 * j];
}
DI void ln_regs(const f32x4 (&gv)[4], const f32x4 (&bv)[4], f32x4 (&v)[4], float eps) {
    float s = 0.f;
#pragma unroll
    for (int j = 0; j < 4; ++j) s += (v[j].x + v[j].y) + (v[j].z + v[j].w);
    const float mean = wave_sum(s) * (1.f / D); float s2 = 0.f;
#pragma unroll
    for (int j = 0; j < 4; ++j) { v[j] = v[j] - mean; s2 += (v[j].x * v[j].x + v[j].y * v[j].y) + (v[j].z * v[j].z + v[j].w * v[j].w); }
    const float rstd = 1.f / sqrtf(wave_sum(s2) * (1.f / D) + eps);
#pragma unroll
    for (int j = 0; j < 4; ++j) v[j] = v[j] * rstd * gv[j] + bv[j];
}
DI void ln_row(const float* xrow, const f32x4 (&gv)[4], const f32x4 (&bv)[4], f32x4 (&v)[4], int lane, float eps) { ld_row(xrow, v, lane); ln_regs(gv, bv, v, eps); }
DI void store_row_bf16(bf16* orow, const f32x4 (&v)[4], int lane) {
    GAS unsigned long long* o8 = (GAS unsigned long long*)orow + lane;
#pragma unroll
    for (int j = 0; j < 4; ++j) o8[64 * j] = (unsigned long long)pk2(v[j].x, v[j].y) | ((unsigned long long)pk2(v[j].z, v[j].w) << 32);
}
DI void p0_prologue(Frame& F) {
    LAS float* scr = (LAS float*)(F.lds + RING_OFF + F.wave * 16384);
    const int gw = F.vcu * NWAVES + F.wave, NGW = F.G * NWAVES;
    constexpr int I_IN = 16 * 64, I_OUT = 16 * 32, I_POOL = 4 * 8, I_G = 32 * 256, I_U = 32 * 256, I_D = 32 * 256;
    constexpr int NITEMS = I_IN + I_OUT + I_POOL + I_G + I_U + I_D;
    for (int it = gw; it < NITEMS; it += NGW) {
        int r = it;
        if (r < I_IN) { p0_transpose_item<1>(F.w_in, 1024, 2048, F.Win_t, scr, r, F.lane); continue; } r -= I_IN;
        if (r < I_OUT) { p0_transpose_item<0>(F.w_out, 1024, 1024, F.Wout_t, scr, r, F.lane); continue; } r -= I_OUT;
        if (r < I_POOL) { const int g = r >> 3; p0_transpose_item<0>(F.pool_w + g * 16384, 128, 128, F.Wpool_t + g * 16384, scr, r & 7, F.lane); continue; } r -= I_POOL;
        if (r < I_G) { const int e = r >> 8; p0_transpose_item<2, true>(F.w_gate + (size_t)e * 524288, 1024, 512, F.Wgu8 + (size_t)e * 1048576, scr, r & 255, F.lane); continue; } r -= I_G;
        if (r < I_U) { const int e = r >> 8; p0_transpose_item<3, true>(F.w_up + (size_t)e * 524288, 1024, 512, F.Wgu8 + (size_t)e * 1048576, scr, r & 255, F.lane); continue; } r -= I_U;
        { const int e = r >> 8; p0_transpose_item<4, true>(F.w_down + (size_t)e * 524288, 512, 1024, F.Wd8 + (size_t)e * 524288, scr, r & 255, F.lane); }
    }
    { f32x4 gv[4], bv[4];
#pragma unroll
      for (int j = 0; j < 4; ++j) { gv[j] = *(const f32x4*)(F.lne_g + 4 * F.lane + 256 * j); bv[j] = *(const f32x4*)(F.lne_b + 4 * F.lane + 256 * j); }
      constexpr int META_SKIP = 8;
      const bool metawg = blockIdx.x < 20;
      const int nrows = metawg ? 32 - META_SKIP : 32;
      int extra = -1;
      if (!metawg) { const int nw = ((int)blockIdx.x - 20) * NWAVES + F.wave;
          if (nw < 20 * NWAVES * META_SKIP) { const int mw = nw / META_SKIP, bx = mw / NWAVES, wv = mw % NWAVES; const int vcu2 = (bx % 8) * (F.G / 8) + bx / 8;
              extra = vcu2 * NWAVES + wv + NGW * (32 - META_SKIP + nw % META_SKIP); } }
      f32x4 nx[4], ny[4]; ld_row(F.x + (size_t)gw * D, nx, F.lane); ld_row(F.x + (size_t)(gw + NGW) * D, ny, F.lane);
      for (int i = 0; i < nrows; ++i) { const int m = gw + NGW * i; f32x4 v[4];
#pragma unroll
          for (int j = 0; j < 4; ++j) { v[j] = nx[j]; nx[j] = ny[j]; }
          if (i + 2 < nrows) ld_row(F.x + (size_t)(m + 2 * NGW) * D, ny, F.lane);
          else if (i + 2 == nrows && extra >= 0) ld_row(F.x + (size_t)extra * D, ny, F.lane);
          ln_regs(gv, bv, v, LN_EPS); store_row_bf16(F.H0 + (size_t)m * D, v, F.lane); }
      if (extra >= 0) { f32x4 v[4];
#pragma unroll
          for (int j = 0; j < 4; ++j) v[j] = nx[j];
          ln_regs(gv, bv, v, LN_EPS); store_row_bf16(F.H0 + (size_t)extra * D, v, F.lane); }
    }
    { const int gt = gw * 64 + F.lane, NT = NGW * 64;
      for (int idx = gt; idx < 4112 * 32; idx += NT) { const int pos = idx >> 5, i = idx & 31;
          const float inv = exp2f(-(float)i * 0.415241011860920f);
          const float ang = (float)pos * inv;
          const double a = (double)ang; const double k = __builtin_rint(a * 0.15915494309189535); const float rr = (float)__builtin_fma(-k, 6.283185307179586, a);
          F.rope[(size_t)idx * 2] = cosf(rr); F.rope[(size_t)idx * 2 + 1] = sinf(rr); }
      for (int idx = gt; idx < 36 * 1024; idx += NT) { const int c = idx >> 10, k = idx & 1023; F.RW[idx] = c < 4 ? F.rg_w[k * 4 + c] : F.re_w[k * 32 + (c - 4)]; }
    }
    if (blockIdx.x < 20) {
        __syncthreads();
        LAS float* ML = (LAS float*)(F.lds);
        LAS float* RED = (LAS float*)(F.lds + 65536);
        LAS float* OUTM = (LAS float*)(F.lds + 98304);
        { f32x4 gv[4], bv[4];
#pragma unroll
          for (int j = 0; j < 4; ++j) { gv[j] = *(const f32x4*)(F.lne_g + 4 * F.lane + 256 * j); bv[j] = *(const f32x4*)(F.lne_b + 4 * F.lane + 256 * j); }
          for (int rr = 0; rr < 2; ++rr) { const int m = F.wave * 2 + rr; f32x4 v[4]; ln_row(F.meta + (size_t)m * D, gv, bv, v, F.lane, LN_EPS);
#pragma unroll
              for (int j = 0; j < 4; ++j) *(LAS f32x4*)(ML + m * 1024 + 4 * F.lane + 256 * j) = v[j]; } }
        __syncthreads();
        const int item = blockIdx.x;
        const int col0 = item < 4 ? 256 + 64 * item : (item < 12 ? 512 + 64 * (item - 4) : 1536 + 64 * (item - 12));
        float acc[16];
#pragma unroll
        for (int m = 0; m < 16; ++m) acc[m] = 0.f;
        for (int kb = 0; kb < 128; kb += 32) {
            float wv[32];
#pragma unroll
            for (int j = 0; j < 32; ++j) wv[j] = F.w_in[(size_t)(F.wave * 128 + kb + j) * 2048 + col0 + F.lane];
#pragma unroll
            for (int j = 0; j < 32; ++j) { const int k = F.wave * 128 + kb + j;
#pragma unroll
                for (int m = 0; m < 16; ++m) acc[m] += ML[m * 1024 + k] * wv[j]; } }
#pragma unroll
        for (int m = 0; m < 16; ++m) RED[(F.wave * 16 + m) * 64 + F.lane] = acc[m];
        __syncthreads();
        for (int o = F.tid; o < 1024; o += 512) { float s = 0.f;
#pragma unroll
            for (int w = 0; w < 8; ++w) s += RED[w * 1024 + o];
            OUTM[o] = s; }
        __syncthreads();
        for (int o = F.tid; o < 1024; o += 512) { const int m = o >> 6, ii = o & 63;
            if (item < 4) {
                const int i = ii >> 1; const float x1 = OUTM[m * 64 + i], x2 = OUTM[m * 64 + 32 + i];
                const float inv = exp2f(-(float)i * 0.415241011860920f); const float ang = (float)m * inv;
                const double a = (double)ang; const double kq = __builtin_rint(a * 0.15915494309189535); const float rr = (float)__builtin_fma(-kq, 6.283185307179586, a);
                const float cs = cosf(rr), sn = sinf(rr);
                F.metak[m * 256 + item * 64 + ii] = ((ii & 1) ? (x1 * sn + x2 * cs) : (x1 * cs - x2 * sn)) * 0.125f;
            } else if (item < 12) F.metav[m * 512 + (item - 4) * 64 + ii] = OUTM[o];
            else F.metau[m * 512 + (item - 12) * 64 + ii] = OUTM[o];
        }
        __syncthreads();
    }
}

DI f32x4 mma(bf16x8 xf, bf16x8 yf, f32x4 acc) { return __builtin_amdgcn_mfma_f32_16x16x32_bf16(xf, yf, acc, 0, 0, 0); }
DI bf16x8 frag_row(const LAS unsigned char* base, int stride, int row0, int k0, int lane) {
    return *(const LAS bf16x8*)(base + (row0 + (lane & 15)) * stride + (k0 + 8 * (lane >> 4)) * 2);
}
DI bf16x8 frag_tr(const LAS unsigned char* base, int stride, int k0, int x0, int lane) {
    const int g = lane >> 4, q = (lane & 15) >> 2, p = lane & 3;
    const LAS unsigned char* a = base + (k0 + 8 * g + q) * stride + (x0 + 4 * p) * 2;
    const v4i16_t lo = __builtin_amdgcn_ds_read_tr16_b64_v4i16((LAS v4i16_t*)a);
    const v4i16_t hi = __builtin_amdgcn_ds_read_tr16_b64_v4i16((LAS v4i16_t*)(a + 4 * stride));
    return __builtin_shufflevector(lo, hi, 0, 1, 2, 3, 4, 5, 6, 7);
}
constexpr int SQ = 144, SV = 272;
DI v4u scale8(v4u x, float z) { v4u o;
#pragma unroll
    for (int p = 0; p < 4; ++p) o[p] = cvtpk(bflo(x[p]) * z, bfhi(x[p]) * z);
    return o; }
DI void p2_scan(Frame& F) {
    constexpr int SVS = 80;
    LAS unsigned char* KS = F.lds; LAS unsigned char* VSL = F.lds + 18432;
    const int w = F.wave, lane = F.lane, fr = lane & 15, fq = lane >> 4, dt = w >> 1, vt = w & 1;
    for (int unit = blockIdx.x; unit < 256; unit += F.G) {
        const int b = unit >> 4, h = (unit >> 2) & 3, vs = unit & 3;
        const float lg = log2f(1.0f - exp2f(-5.0f - (float)h));
        const float cd = exp2f(128.0f * lg);
        const int kr0 = F.tid >> 3, kc8 = F.tid & 7, vr = F.tid >> 2, vc4 = F.tid & 3;
        const float z0 = exp2f((float)(127 - kr0) * lg), z1 = exp2f((float)(63 - kr0) * lg);
        const int d0 = 16 * dt + 4 * fq, vcol = vs * 32 + 16 * vt + fr;
        f32x4 st = {0.f, 0.f, 0.f, 0.f};
        for (int m = 0; m < 16; ++m) { const float zm = exp2f((float)(15 - m) * lg) * F.metav[m * 512 + h * 128 + vcol]; const f32x4 kk = *(const f32x4*)(F.metak + m * 256 + h * 64 + d0); st = st + kk * zm; }
        bf16* STb = F.ST + (size_t)((b * 4 + h) * 32) * 8192 + vcol * 64 + d0;
        const bf16* kp = F.Kb + ((size_t)b * 4096 + kr0) * 256 + h * 64 + kc8 * 8; const bf16* vp = F.Vb + ((size_t)b * 4096 + vr) * 512 + h * 128 + vs * 32 + vc4 * 8;
        v4u rk0[8], rk1[8], rvv[8];
#pragma unroll
        for (int u = 0; u < 8; ++u) { const size_t o = (size_t)u * 128; rk0[u] = *(const GAS v4u*)(kp + o * 256); rk1[u] = *(const GAS v4u*)(kp + (o + 64) * 256); rvv[u] = *(const GAS v4u*)(vp + o * 512); }
        for (int n0 = 0; n0 < 32; n0 += 8) {
#pragma unroll
            for (int u = 0; u < 8; ++u) { const int n = n0 + u;
                { u32x2 pk; pk.x = cvtpk(st[0], st[1]); pk.y = cvtpk(st[2], st[3]); *(GAS u32x2*)(STb + (size_t)n * 8192) = pk; }
                if (n < 31) {
                    __syncthreads();
                    *(LAS v4u*)(KS + kr0 * SQ + kc8 * 16) = scale8(rk0[u], z0); *(LAS v4u*)(KS + (kr0 + 64) * SQ + kc8 * 16) = scale8(rk1[u], z1);
                    *(LAS v4u*)(VSL + vr * SVS + vc4 * 16) = rvv[u];
                    __syncthreads();
                    if (n + 8 < 31) { const size_t o = (size_t)(n + 8) * 128; rk0[u] = *(const GAS v4u*)(kp + o * 256); rk1[u] = *(const GAS v4u*)(kp + (o + 64) * 256); rvv[u] = *(const GAS v4u*)(vp + o * 512); }
                    f32x4 a = {0.f, 0.f, 0.f, 0.f};
#pragma unroll
                    for (int kk = 0; kk < 4; ++kk) a = mma(frag_tr(KS, SQ, 32 * kk, 16 * dt, lane), frag_tr(VSL, SVS, 32 * kk, 16 * vt, lane), a);
                    st = st * cd + a;
                }
            }
        }
    }
    __syncthreads();
}

struct RetRegs { v4u q[2], k[2], s[2], v[4]; u32x2 g[8]; };
DI void ret_fetch(const Frame& F, RetRegs& r, int b, int h, int nn) {
    const size_t R0 = (size_t)b * 4096 + (size_t)nn * 128;
#pragma unroll
    for (int i = 0; i < 2; ++i) { const int ch = F.tid + 512 * i, rw = ch >> 3, c8 = ch & 7;
        r.q[i] = *(const GAS v4u*)(F.Qb + (R0 + rw) * 256 + h * 64 + c8 * 8); r.k[i] = *(const GAS v4u*)(F.Kb + (R0 + rw) * 256 + h * 64 + c8 * 8);
        r.s[i] = *(const GAS v4u*)(F.ST + (size_t)((b * 4 + h) * 32 + nn) * 8192 + rw * 64 + c8 * 8); }
#pragma unroll
    for (int i = 0; i < 4; ++i) { const int ch = F.tid + 512 * i, rw = ch >> 4, c16 = ch & 15; r.v[i] = *(const GAS v4u*)(F.Vb + (R0 + rw) * 512 + h * 128 + c16 * 8); }
    { const bf16* grow = F.Gb + (R0 + 16 * F.wave + (F.lane & 15)) * 512 + h * 128 + 4 * (F.lane >> 4);
#pragma unroll
      for (int vt = 0; vt < 8; ++vt) r.g[vt] = *(const GAS u32x2*)(grow + 16 * vt); }
}
DI void ret_compute(Frame& F, int b, int h, int nn, float lg, const u32x2 (&gb)[8]) {
    LAS unsigned char* QS = F.lds; LAS unsigned char* KS = F.lds + 18432; LAS unsigned char* VS = F.lds + 36864; LAS unsigned char* SS = F.lds + 71680; LAS unsigned char* CS = F.lds + 90112;
    const size_t R0 = (size_t)b * 4096 + (size_t)nn * 128;
    const int w = F.wave, lane = F.lane, fr = lane & 15, fq = lane >> 4;
    const int il = 16 * w + fr;
    const bf16x8 qf0 = frag_row(QS, SQ, 16 * w, 0, lane), qf1 = frag_row(QS, SQ, 16 * w, 32, lane);
    const int jtmax = w | 1;
    for (int jt = 0; jt <= jtmax; ++jt) {
        f32x4 a = {0.f, 0.f, 0.f, 0.f};
        a = mma(frag_row(KS, SQ, 16 * jt, 0, lane), qf0, a); a = mma(frag_row(KS, SQ, 16 * jt, 32, lane), qf1, a);
        float o[4];
#pragma unroll
        for (int r = 0; r < 4; ++r) { const int dl = il - (16 * jt + 4 * fq + r); o[r] = dl >= 0 ? a[r] * exp2f((float)dl * lg) : 0.f; }
        u32x2 pk; pk.x = cvtpk(o[0], o[1]); pk.y = cvtpk(o[2], o[3]);
        *(LAS u32x2*)(CS + il * SV + (16 * jt + 4 * fq) * 2) = pk;
    }
    asm volatile("s_waitcnt lgkmcnt(0)" ::: "memory");
    f32x4 accI[8], accC[8];
#pragma unroll
    for (int vt = 0; vt < 8; ++vt) { accI[vt] = (f32x4){0.f, 0.f, 0.f, 0.f}; accC[vt] = (f32x4){0.f, 0.f, 0.f, 0.f}; }
    const int kkmax = w >> 1;
    for (int kk = 0; kk <= kkmax; ++kk) { const bf16x8 cf = frag_row(CS, SV, 16 * w, 32 * kk, lane);
#pragma unroll
        for (int vt = 0; vt < 8; ++vt) accI[vt] = mma(frag_tr(VS, SV, 32 * kk, 16 * vt, lane), cf, accI[vt]); }
#pragma unroll
    for (int vt = 0; vt < 8; ++vt) { accC[vt] = mma(frag_row(SS, SQ, 16 * vt, 0, lane), qf0, accC[vt]); accC[vt] = mma(frag_row(SS, SQ, 16 * vt, 32, lane), qf1, accC[vt]); }
    const float xi = exp2f((float)(il + 1) * lg);
    float s = 0.f;
#pragma unroll
    for (int vt = 0; vt < 8; ++vt) { accI[vt] = accI[vt] + accC[vt] * xi; s += (accI[vt][0] + accI[vt][1]) + (accI[vt][2] + accI[vt][3]); }
    s += __shfl_xor(s, 16); s += __shfl_xor(s, 32);
    const float mean = s * (1.0f / 128.0f); float q = 0.f;
#pragma unroll
    for (int vt = 0; vt < 8; ++vt) { accI[vt] = accI[vt] - mean; q += (accI[vt][0] * accI[vt][0] + accI[vt][1] * accI[vt][1]) + (accI[vt][2] * accI[vt][2] + accI[vt][3] * accI[vt][3]); }
    q += __shfl_xor(q, 16); q += __shfl_xor(q, 32);
    const float rstd = 1.0f / sqrtf(q * (1.0f / 128.0f) + GN_EPS);
    bf16* orow = F.MIXIN + (R0 + il) * 1024 + h * 128 + 4 * fq;
#pragma unroll
    for (int vt = 0; vt < 8; ++vt) {
        const float g0 = bflo(gb[vt].x), g1 = bfhi(gb[vt].x), g2 = bflo(gb[vt].y), g3 = bfhi(gb[vt].y);
        const float y0 = accI[vt][0] * rstd * g0 / (1.0f + __expf(-g0)), y1 = accI[vt][1] * rstd * g1 / (1.0f + __expf(-g1));
        const float y2 = accI[vt][2] * rstd * g2 / (1.0f + __expf(-g2)), y3 = accI[vt][3] * rstd * g3 / (1.0f + __expf(-g3));
        u32x2 pk; pk.x = cvtpk(y0, y1); pk.y = cvtpk(y2, y3); *(GAS u32x2*)(orow + 16 * vt) = pk; }
}
DI void pool_fetch(const Frame& F, v4u (&ru)[5], int b, int g, int nn) {
#pragma unroll
    for (int i = 0; i < 5; ++i) { const int ch = F.tid + 512 * i; ru[i] = (v4u){0u, 0u, 0u, 0u};
        if (ch < 144 * 16) { const int rr = ch >> 4, c16 = ch & 15, t = nn * 128 - 16 + rr;
            if (t >= 0) ru[i] = *(const GAS v4u*)(F.Ub + ((size_t)b * 4096 + t) * 512 + g * 128 + c16 * 8);
            else { const float* mu = F.metau + (16 + t) * 512 + g * 128 + c16 * 8; ru[i].x = pk2(mu[0], mu[1]); ru[i].y = pk2(mu[2], mu[3]); ru[i].z = pk2(mu[4], mu[5]); ru[i].w = pk2(mu[6], mu[7]); } } }
}
DI void p3_mixer(Frame& F) {
    const int c = blockIdx.x;
    {
        LAS unsigned char* QS = F.lds; LAS unsigned char* KS = F.lds + 18432; LAS unsigned char* VS = F.lds + 36864; LAS unsigned char* SS = F.lds + 71680;
        RetRegs rg; { const int tile = 2 * c; ret_fetch(F, rg, tile >> 5, 0, tile & 31); }
        for (int i = 0; i < 8; ++i) {
            const int tile = 2 * c + (i >> 2), hg = i & 3, b = tile >> 5, nn = tile & 31;
            const float lg = log2f(1.0f - exp2f(-5.0f - (float)hg));
            __syncthreads();
#pragma unroll
            for (int k = 0; k < 2; ++k) { const int ch = F.tid + 512 * k, rw = ch >> 3, c8 = ch & 7;
                *(LAS v4u*)(QS + rw * SQ + c8 * 16) = rg.q[k]; *(LAS v4u*)(KS + rw * SQ + c8 * 16) = rg.k[k]; *(LAS v4u*)(SS + rw * SQ + c8 * 16) = rg.s[k]; }
#pragma unroll
            for (int k = 0; k < 4; ++k) { const int ch = F.tid + 512 * k, rw = ch >> 4, c16 = ch & 15; *(LAS v4u*)(VS + rw * SV + c16 * 16) = rg.v[k]; }
            __syncthreads();
            u32x2 gcur[8];
#pragma unroll
            for (int vt = 0; vt < 8; ++vt) gcur[vt] = rg.g[vt];
            if (i < 7) { const int t2 = 2 * c + ((i + 1) >> 2); ret_fetch(F, rg, t2 >> 5, (i + 1) & 3, t2 & 31); }
            ret_compute(F, b, hg, nn, lg, gcur);
        }
    }
    {
        LAS unsigned char* US = F.lds; LAS unsigned char* PS = F.lds + 40960; LAS unsigned char* WSM = F.lds + 77824;
        const int w = F.wave, lane = F.lane, fr = lane & 15, fq = lane >> 4;
        f32x4 pb[8], psc[8]; v4u wreg[4];
        v4u ru[5]; { const int tile = 2 * c; pool_fetch(F, ru, tile >> 5, 0, tile & 31); }
#pragma unroll
        for (int k = 0; k < 4; ++k) { const int ch = F.tid + 512 * k; wreg[k] = *(const GAS v4u*)(F.Wpool_t + (ch >> 4) * 128 + (ch & 15) * 8); }
        for (int i = 0; i < 8; ++i) {
            const int g = i >> 1, tile = 2 * c + (i & 1), b = tile >> 5, nn = tile & 31, win = 2 << g; const float invw = 1.0f / (float)win;
            const size_t R0 = (size_t)b * 4096 + (size_t)nn * 128;
            __syncthreads();
            if ((i & 1) == 0) {
#pragma unroll
                for (int k = 0; k < 4; ++k) { const int ch = F.tid + 512 * k; *(LAS v4u*)(WSM + (ch >> 4) * SV + (ch & 15) * 16) = wreg[k]; }
#pragma unroll
                for (int dt = 0; dt < 8; ++dt) { pb[dt] = *(const f32x4*)(F.pool_b + g * 128 + 16 * dt + 4 * fq); psc[dt] = *(const f32x4*)(F.pool_scale + g * 128 + 16 * dt + 4 * fq); } }
#pragma unroll
            for (int k = 0; k < 5; ++k) { const int ch = F.tid + 512 * k; if (ch < 144 * 16) *(LAS v4u*)(US + (ch >> 4) * SV + (ch & 15) * 16) = ru[k]; }
            __syncthreads();
            if (i < 7) { const int t2 = 2 * c + ((i + 1) & 1), g2 = (i + 1) >> 1; pool_fetch(F, ru, t2 >> 5, g2, t2 & 31);
                if ((i & 1) == 1) {
#pragma unroll
                    for (int k = 0; k < 4; ++k) { const int ch = F.tid + 512 * k; wreg[k] = *(const GAS v4u*)(F.Wpool_t + g2 * 16384 + (ch >> 4) * 128 + (ch & 15) * 8); } } }
            { const int c2 = F.tid & 63, ib = F.tid >> 6; float run0 = 0.f, run1 = 0.f;
              for (int sI = 0; sI < win; ++sI) { const unsigned xw = *(const LAS unsigned*)(US + (16 + 16 * ib - sI) * SV + c2 * 4); run0 += bflo(xw); run1 += bfhi(xw); }
              for (int ii = 0; ii < 16; ++ii) { const int ir = 16 * ib + ii; const unsigned cur = *(const LAS unsigned*)(US + (16 + ir) * SV + c2 * 4);
                  if (ii > 0) { const unsigned old = *(const LAS unsigned*)(US + (16 + ir - win) * SV + c2 * 4); run0 += bflo(cur) - bflo(old); run1 += bfhi(cur) - bfhi(old); }
                  *(LAS unsigned*)(PS + ir * SV + c2 * 4) = cvtpk(run0 * invw - bflo(cur), run1 * invw - bfhi(cur)); } }
            __syncthreads();
            bf16x8 pf[4];
#pragma unroll
            for (int kk = 0; kk < 4; ++kk) pf[kk] = frag_row(PS, SV, 16 * w, 32 * kk, lane);
            bf16* orow = F.MIXIN + (R0 + 16 * w + fr) * 1024 + 512 + g * 128 + 4 * fq;
#pragma unroll
            for (int dt = 0; dt < 8; ++dt) { f32x4 a = {0.f, 0.f, 0.f, 0.f};
#pragma unroll
                for (int kk = 0; kk < 4; ++kk) a = mma(frag_row(WSM, SV, 16 * dt, 32 * kk, lane), pf[kk], a);
                a = (a + pb[dt]) * psc[dt];
                u32x2 pk; pk.x = cvtpk(a[0], a[1]); pk.y = cvtpk(a[2], a[3]); *(GAS u32x2*)(orow + 16 * dt) = pk; }
        }
    }
    __syncthreads();
}

DI void split8(const float (&h)[8], bf16x8& hi, bf16x8& lo) {
    v4u a, b;
#pragma unroll
    for (int p = 0; p < 4; ++p) { const unsigned wd = cvtpk(h[2 * p], h[2 * p + 1]); a[p] = wd; b[p] = cvtpk(h[2 * p] - bflo(wd), h[2 * p + 1] - bfhi(wd)); }
    hi = __builtin_bit_cast(bf16x8, a); lo = __builtin_bit_cast(bf16x8, b);
}
DI void p5_ln_router(Frame& F) {
    LAS int* LCNT = (LAS int*)(F.lds + LCNT_OFF);
    LAS f32x2* SP = (LAS f32x2*)(F.lds);
    LAS float* LP = (LAS float*)(F.lds + 1024);
    LAS float* LG = (LAS float*)(F.lds + 1024 + 24576);
    LAS float* GB = (LAS float*)(F.lds + 32768);
    for (int i = F.tid; i < 256; i += 512) { *(LAS f32x4*)(GB + 4 * i) = *(const f32x4*)(F.ln1_g + 4 * i); *(LAS f32x4*)(GB + 1024 + 4 * i) = *(const f32x4*)(F.ln1_b + 4 * i); }
    if (F.tid < 32) LCNT[F.tid] = 0;
    const int w = F.wave, lane = F.lane, fr = lane & 15, fq = lane >> 4;
    const int kb = 128 * w + 8 * fq;
    bf16x8 wh[3][4], wl[3][4];
#pragma unroll
    for (int ct = 0; ct < 3; ++ct)
#pragma unroll
        for (int ks = 0; ks < 4; ++ks) { const int cc = 16 * ct + fr; float f[8];
            if (cc < 36) { const f32x4 a = *(const f32x4*)(F.RW + cc * 1024 + kb + 32 * ks), b = *(const f32x4*)(F.RW + cc * 1024 + kb + 32 * ks + 4);
                f[0] = a[0]; f[1] = a[1]; f[2] = a[2]; f[3] = a[3]; f[4] = b[0]; f[5] = b[1]; f[6] = b[2]; f[7] = b[3]; }
            else {
#pragma unroll
                for (int j = 0; j < 8; ++j) f[j] = 0.f; }
            split8(f, wh[ct][ks], wl[ct][ks]); }
    const int c = blockIdx.x;
    const float rbias = lane < 4 ? F.rg_b[lane] : (lane < 36 ? F.re_b[lane - 4] : 0.f);
    const bf16* tbase = F.T1 + (size_t)(c * 256 + fr) * D + kb;
    const bf16* hbase = F.H0 + (size_t)(c * 256 + fr) * D + kb;
    v4u tn[4], hn[4];
#pragma unroll
    for (int ks = 0; ks < 4; ++ks) { tn[ks] = *(const GAS v4u*)(tbase + 32 * ks); hn[ks] = *(const GAS v4u*)(hbase + 32 * ks); }
    __syncthreads();
    for (int grp = 0; grp < 16; ++grp) {
        f32x4 t[8];
#pragma unroll
        for (int i = 0; i < 4; ++i) {
            t[2 * i] = (f32x4){ALPHA * bflo(hn[i].x) + bflo(tn[i].x), ALPHA * bfhi(hn[i].x) + bfhi(tn[i].x), ALPHA * bflo(hn[i].y) + bflo(tn[i].y), ALPHA * bfhi(hn[i].y) + bfhi(tn[i].y)};
            t[2 * i + 1] = (f32x4){ALPHA * bflo(hn[i].z) + bflo(tn[i].z), ALPHA * bfhi(hn[i].z) + bfhi(tn[i].z), ALPHA * bflo(hn[i].w) + bflo(tn[i].w), ALPHA * bfhi(hn[i].w) + bfhi(tn[i].w)}; }
        if (grp < 15) { const bf16* nb = tbase + (size_t)(grp + 1) * 16 * D; const bf16* nh = hbase + (size_t)(grp + 1) * 16 * D;
#pragma unroll
            for (int ks = 0; ks < 4; ++ks) { tn[ks] = *(const GAS v4u*)(nb + 32 * ks); hn[ks] = *(const GAS v4u*)(nh + 32 * ks); } }
        float s = 0.f, s2 = 0.f;
#pragma unroll
        for (int i = 0; i < 8; ++i) { s += (t[i][0] + t[i][1]) + (t[i][2] + t[i][3]); s2 += (t[i][0] * t[i][0] + t[i][1] * t[i][1]) + (t[i][2] * t[i][2] + t[i][3] * t[i][3]); }
        s += __shfl_xor(s, 16); s += __shfl_xor(s, 32); s2 += __shfl_xor(s2, 16); s2 += __shfl_xor(s2, 32);
        if (fq == 0) SP[fr * 8 + w] = (f32x2){s, s2};
        __syncthreads();
        float ts = 0.f, ts2 = 0.f;
#pragma unroll
        for (int k = 0; k < 8; ++k) { const f32x2 p = SP[fr * 8 + k]; ts += p.x; ts2 += p.y; }
        const float mean = ts * (1.f / D); const float rstd = 1.f / sqrtf(ts2 * (1.f / D) - mean * mean + LN_EPS);
        f32x4 acc[3];
#pragma unroll
        for (int ct = 0; ct < 3; ++ct) acc[ct] = (f32x4){0.f, 0.f, 0.f, 0.f};
        bf16* hrow = F.H1B + (size_t)(c * 256 + grp * 16 + fr) * D + kb; unsigned char* frow = F.H1F8 + (size_t)(c * 256 + grp * 16 + fr) * D + kb;
#pragma unroll
        for (int ks = 0; ks < 4; ++ks) { const int col = kb + 32 * ks;
            const f32x4 g0 = *(const LAS f32x4*)(GB + col), g1 = *(const LAS f32x4*)(GB + col + 4), b0 = *(const LAS f32x4*)(GB + 1024 + col), b1 = *(const LAS f32x4*)(GB + 1024 + col + 4);
            const f32x4 h0 = (t[2 * ks] - mean) * rstd * g0 + b0, h1 = (t[2 * ks + 1] - mean) * rstd * g1 + b1;
            const float h[8] = {h0[0], h0[1], h0[2], h0[3], h1[0], h1[1], h1[2], h1[3]};
            bf16x8 hh, hl; split8(h, hh, hl);
            *(GAS bf16x8*)(hrow + 32 * ks) = hh;
            { u32x2 f8; f8.x = pk4f8(h[0], h[1], h[2], h[3]); f8.y = pk4f8(h[4], h[5], h[6], h[7]); *(GAS u32x2*)(frow + 32 * ks) = f8; }
#pragma unroll
            for (int ct = 0; ct < 3; ++ct) { acc[ct] = mma(wh[ct][ks], hh, acc[ct]); acc[ct] = mma(wh[ct][ks], hl, acc[ct]); acc[ct] = mma(wl[ct][ks], hh, acc[ct]); } }
#pragma unroll
        for (int ct = 0; ct < 3; ++ct) *(LAS f32x4*)(LP + ((w * 16 + fr) * 48 + 16 * ct + 4 * fq)) = acc[ct];
        __syncthreads();
#pragma unroll
        for (int rr = 0; rr < 2; ++rr) { const int rl = 2 * w + rr;
            if (lane < 36) { float sg = 0.f;
#pragma unroll
                for (int k = 0; k < 8; ++k) sg += LP[(k * 16 + rl) * 48 + lane];
                LG[rl * 40 + lane] = sg + rbias; } }
        asm volatile("s_waitcnt lgkmcnt(0)" ::: "memory");
        if (lane < 2) { const int rl = 2 * w + lane, row = c * 256 + grp * 16 + rl; const LAS float* lg = LG + rl * 40;
            const float l0 = lg[0], l1 = lg[1], l2 = lg[2], l3 = lg[3];
            const float gmax = fmaxf(fmaxf(l0, l1), fmaxf(l2, l3));
            const int gi = l0 == gmax ? 0 : (l1 == gmax ? 1 : (l2 == gmax ? 2 : 3));
            const float gp = 1.0f / ((expf(l0 - gmax) + expf(l1 - gmax)) + (expf(l2 - gmax) + expf(l3 - gmax)));
            float sel[8];
#pragma unroll
            for (int k = 0; k < 8; ++k) sel[k] = lg[4 + gi * 8 + k];
            float m1 = sel[0];
#pragma unroll
            for (int k = 1; k < 8; ++k) m1 = fmaxf(m1, sel[k]);
            int i1 = 7;
#pragma unroll
            for (int k = 6; k >= 0; --k) i1 = sel[k] == m1 ? k : i1;
            float m2 = -3.0e38f;
#pragma unroll
            for (int k = 0; k < 8; ++k) m2 = (k != i1) ? fmaxf(m2, sel[k]) : m2;
            int i2 = -1;
#pragma unroll
            for (int k = 7; k >= 0; --k) i2 = (k != i1 && sel[k] == m2) ? k : i2;
            const float tt = expf(m2 - m1); const float w0 = gp / (1.0f + tt), w1 = gp * tt / (1.0f + tt);
            const int e0 = gi * 8 + i1, e1 = gi * 8 + i2;
            const int li0 = __hip_atomic_fetch_add(LCNT + e0, 1, __ATOMIC_RELAXED, __HIP_MEMORY_SCOPE_WORKGROUP), li1 = __hip_atomic_fetch_add(LCNT + e1, 1, __ATOMIC_RELAXED, __HIP_MEMORY_SCOPE_WORKGROUP);
            F.toke[row] = (unsigned)e0 | ((unsigned)e1 << 8); F.tokl[row] = (unsigned)li0 | ((unsigned)li1 << 16); F.tokw[row] = (f32x2){w0, w1}; }
    }
    __syncthreads();
    if (F.tid < 32) F.cnt[c * 32 + F.tid] = LCNT[F.tid];
}
DI void moe_layout(Frame& F) {
    LAS int* red = (LAS int*)(F.lds);
    LAS int* PP = (LAS int*)(F.lds + PP_OFF); LAS int* TOT = (LAS int*)(F.lds + TOT_OFF); LAS int* BEF = (LAS int*)(F.lds + BEF_OFF); LAS int* BASE = (LAS int*)(F.lds + BASE_OFF);
    __syncthreads();
    { const int e = F.tid & 31, part = F.tid >> 5; int tot = 0, bef = 0;
      for (int k = 0; k < 16; ++k) { const int c2 = part * 16 + k; const int v = F.cnt[c2 * 32 + e]; tot += v; bef += (c2 < (int)blockIdx.x) ? v : 0; }
      red[(part * 32 + e) * 2] = tot; red[(part * 32 + e) * 2 + 1] = bef; }
    __syncthreads();
    if (F.tid < 32) { int t = 0, bf = 0;
        for (int p = 0; p < 16; ++p) { t += red[(p * 32 + F.tid) * 2]; bf += red[(p * 32 + F.tid) * 2 + 1]; }
        TOT[F.tid] = t; BEF[F.tid] = bf; }
    __syncthreads();
    if (F.tid == 0) { int acc = 0; for (int e = 0; e < 32; ++e) { PP[e] = acc; acc += (TOT[e] + 255) >> 8; } PP[32] = acc; }
    __syncthreads();
    if (F.tid < 32) BASE[F.tid] = PP[F.tid] * 256 + BEF[F.tid];
    __syncthreads();
}
DI void p6_assign(Frame& F) {
    moe_layout(F);
    const LAS int* BASE = (const LAS int*)(F.lds + BASE_OFF); const LAS int* PP = (const LAS int*)(F.lds + PP_OFF); const LAS int* TOT = (const LAS int*)(F.lds + TOT_OFF);
    const int c = blockIdx.x;
    if (F.tid < 256) { const int row = c * 256 + F.tid; const unsigned te = F.toke[row], tl = F.tokl[row];
        const int s0 = BASE[te & 255u] + (int)(tl & 0xffffu), s1 = BASE[(te >> 8) & 255u] + (int)(tl >> 16);
        F.stok[s0] = row; F.stok[s1] = row; F.toks[row * 2] = s0; F.toks[row * 2 + 1] = s1; const f32x2 wv = F.tokw[row]; F.PW[s0] = wv.x; F.PW[s1] = wv.y; }
    if (c < 32) { const int lo = PP[c] * 256 + TOT[c], hi = PP[c + 1] * 256; for (int sl = lo + F.tid; sl < hi; sl += 512) { F.stok[sl] = 0; F.PW[sl] = 0.f; } }
}
DI void p9_final(Frame& F) {
    const int gw = F.vcu * NWAVES + F.wave, NGW = F.G * NWAVES;
    f32x4 gv[4], bv[4];
#pragma unroll
    for (int j = 0; j < 4; ++j) { gv[j] = *(const f32x4*)(F.ln2_g + 4 * F.lane + 256 * j); bv[j] = *(const f32x4*)(F.ln2_b + 4 * F.lane + 256 * j); }
    u32x2 nh[4], mh[4]; unsigned na[4], nb[4], ma[4], mb[4]; int s0n, s1n;
    { const int r0 = gw, r1 = gw + NGW, r2 = gw + 2 * NGW;
      const int a0 = F.toks[r0 * 2], a1 = F.toks[r0 * 2 + 1], b0 = F.toks[r1 * 2], b1 = F.toks[r1 * 2 + 1];
      const GAS u32x2* hp = (const GAS u32x2*)(F.H1B + (size_t)r0 * D) + F.lane; const GAS unsigned* y0 = (const GAS unsigned*)(F.YP + (size_t)a0 * D) + F.lane; const GAS unsigned* y1 = (const GAS unsigned*)(F.YP + (size_t)a1 * D) + F.lane;
      const GAS u32x2* hq = (const GAS u32x2*)(F.H1B + (size_t)r1 * D) + F.lane; const GAS unsigned* z0 = (const GAS unsigned*)(F.YP + (size_t)b0 * D) + F.lane; const GAS unsigned* z1 = (const GAS unsigned*)(F.YP + (size_t)b1 * D) + F.lane;
#pragma unroll
      for (int j = 0; j < 4; ++j) { nh[j] = hp[64 * j]; na[j] = y0[64 * j]; nb[j] = y1[64 * j]; mh[j] = hq[64 * j]; ma[j] = z0[64 * j]; mb[j] = z1[64 * j]; }
      s0n = F.toks[r2 * 2]; s1n = F.toks[r2 * 2 + 1]; }
    for (int row = gw; row < M; row += NGW) {
        u32x2 ch[4]; unsigned ca[4], cb[4];
#pragma unroll
        for (int j = 0; j < 4; ++j) { ch[j] = nh[j]; ca[j] = na[j]; cb[j] = nb[j]; nh[j] = mh[j]; na[j] = ma[j]; nb[j] = mb[j]; }
        if (row + 2 * NGW < M) { const int rn = row + 2 * NGW;
            const GAS u32x2* hp = (const GAS u32x2*)(F.H1B + (size_t)rn * D) + F.lane; const GAS unsigned* y0 = (const GAS unsigned*)(F.YP + (size_t)s0n * D) + F.lane; const GAS unsigned* y1 = (const GAS unsigned*)(F.YP + (size_t)s1n * D) + F.lane;
#pragma unroll
            for (int j = 0; j < 4; ++j) { mh[j] = hp[64 * j]; ma[j] = y0[64 * j]; mb[j] = y1[64 * j]; }
            const int r3 = rn + NGW < M ? rn + NGW : rn; s0n = F.toks[r3 * 2]; s1n = F.toks[r3 * 2 + 1]; }
        f32x4 v[4]; float s = 0.f;
#pragma unroll
        for (int j = 0; j < 4; ++j) { const u32x2 hb = ch[j];
            const f32x2 a0 = __builtin_amdgcn_cvt_pk_f32_fp8((int)ca[j], false), a1 = __builtin_amdgcn_cvt_pk_f32_fp8((int)ca[j], true);
            const f32x2 b0 = __builtin_amdgcn_cvt_pk_f32_fp8((int)cb[j], false), b1 = __builtin_amdgcn_cvt_pk_f32_fp8((int)cb[j], true);
            v[j].x = ALPHA * bflo(hb.x) + (a0.x + b0.x) * 0.015625f; v[j].y = ALPHA * bfhi(hb.x) + (a0.y + b0.y) * 0.015625f;
            v[j].z = ALPHA * bflo(hb.y) + (a1.x + b1.x) * 0.015625f; v[j].w = ALPHA * bfhi(hb.y) + (a1.y + b1.y) * 0.015625f;
            s += (v[j].x + v[j].y) + (v[j].z + v[j].w); }
        const float mean = wave_sum(s) * (1.f / D); float s2 = 0.f;
#pragma unroll
        for (int j = 0; j < 4; ++j) { v[j] = v[j] - mean; s2 += (v[j].x * v[j].x + v[j].y * v[j].y) + (v[j].z * v[j].z + v[j].w * v[j].w); }
        const float rstd = 1.f / sqrtf(wave_sum(s2) * (1.f / D) + LN_EPS);
        GAS f32x4* op = (GAS f32x4*)(F.out + (size_t)row * D) + F.lane;
#pragma unroll
        for (int j = 0; j < 4; ++j) op[64 * j] = v[j] * rstd * gv[j] + bv[j];
    }
}

struct Args { const float* in[20]; float* out; unsigned char* ws; int ph_lo, ph_hi; };
__global__ void __launch_bounds__(NWAVES * 64, 2) hrp_fwd(Args args) {
    extern __shared__ __attribute__((aligned(16))) unsigned char lds[];
    Frame F;
    F.lds = (LAS unsigned char*)lds;
    F.MISC = (volatile LAS unsigned*)(F.lds + MISC_OFF);
    F.tid = threadIdx.x; F.lane = F.tid & 63; F.wave = __builtin_amdgcn_readfirstlane(F.tid >> 6);
    F.G = gridDim.x; { const int bx = blockIdx.x; F.vcu = (F.G % 8 == 0) ? (bx % 8) * (F.G / 8) + bx / 8 : bx; }
    unsigned char* ws = args.ws;
    F.ctl = (gu32*)(ws + WS_CTL);
    F.x = args.in[0]; F.meta = args.in[1]; F.lne_g = args.in[2]; F.lne_b = args.in[3]; F.w_in = args.in[4]; F.pool_w = args.in[5]; F.pool_b = args.in[6]; F.pool_scale = args.in[7];
    F.w_out = args.in[8]; F.ln1_g = args.in[9]; F.ln1_b = args.in[10]; F.rg_w = args.in[11]; F.rg_b = args.in[12]; F.re_w = args.in[13]; F.re_b = args.in[14];
    F.w_gate = args.in[15]; F.w_up = args.in[16]; F.w_down = args.in[17]; F.ln2_g = args.in[18]; F.ln2_b = args.in[19]; F.out = args.out;
    F.Win_t = (bf16*)(ws + WS_WIN); F.Wout_t = (bf16*)(ws + WS_WOUT); F.Wpool_t = (bf16*)(ws + WS_WPOOL); F.Wgu8 = ws + WS_WGU; F.Wd8 = ws + WS_WD; F.H1F8 = ws + WS_H1F8;
    F.RW = (float*)(ws + WS_RW); F.metak = (float*)(ws + WS_METAK); F.metav = (float*)(ws + WS_METAV); F.metau = (float*)(ws + WS_METAU); F.rope = (float*)(ws + WS_ROPE);
    F.T1 = (bf16*)(ws + WS_T1); F.PW = (float*)(ws + WS_PW);
    F.toke = (unsigned*)(ws + WS_TOKE); F.tokl = (unsigned*)(ws + WS_TOKL); F.tokw = (f32x2*)(ws + WS_TOKW); F.toks = (int*)(ws + WS_TOKS); F.cnt = (int*)(ws + WS_CNT); F.stok = (int*)(ws + WS_STOK);
    F.ST = (bf16*)(ws + WS_ST); F.H0 = (bf16*)(ws + WS_H0); F.Qb = (bf16*)(ws + WS_Q); F.Kb = (bf16*)(ws + WS_K); F.Vb = (bf16*)(ws + WS_V); F.Gb = (bf16*)(ws + WS_GATE); F.Ub = (bf16*)(ws + WS_U);
    F.MIXIN = (bf16*)(ws + WS_MIXIN); F.H1B = (bf16*)(ws + WS_H1B); F.HID = ws + WS_HID; F.YP = (unsigned char*)(ws + WS_YP);
    for (int u = F.tid; u < (LDS_BYTES - LDSCTL_OFF) / 4; u += NWAVES * 64) ((LAS unsigned*)(F.lds + LDSCTL_OFF))[u] = 0u;
    __syncthreads();
    if (F.G != 256) return;
    XcdBarrier bar; bar.bar = (unsigned*)(F.ctl + CW_BAR); bar.x = 0; bar.st = nullptr;
    if (N_LAUNCHES != PER_PHASE) bar = xcd_barrier_post((unsigned*)(F.ctl + CW_BAR), F.MISC + 8);
#define GRID_BAR() do { if (N_LAUNCHES != PER_PHASE) xcd_barrier(bar); } while (0)
    const int lo = args.ph_lo, hi = args.ph_hi;
#define RELANE() do { int l_; asm volatile("v_mbcnt_lo_u32_b32 %0, -1, 0\n\tv_mbcnt_hi_u32_b32 %0, -1, %0" : "=v"(l_)); F.lane = l_; F.tid = F.wave * 64 + l_; } while (0)
#define IN(k) (lo <= (k) && (k) < hi)
#define BOTH(k) (IN(k) && IN((k) + 1))

    if (IN(0)) { RELANE(); p0_prologue(F); if (BOTH(0)) GRID_BAR(); }
    if (IN(1)) {
        pg8::Gemm g{F.H0, F.Win_t, M, NPROJ, D}; pg8::RotOrder S; S.init(M, NPROJ, F.G, (int)blockIdx.x);
        pg8::EpiProj E{F.Qb, F.Vb, F.rope};
        pg8::gemm_phase<pg8::EpiProj, pg8::RotOrder, true, true>(F.lds + RING_OFF, g, S, E, F.wave);
        if (BOTH(1)) GRID_BAR();
    }
    if (IN(2)) { RELANE(); p2_scan(F); if (BOTH(2)) GRID_BAR(); }
    if (IN(3)) { RELANE(); p3_mixer(F); VM_WAIT(); __syncthreads(); }
    if (IN(4)) {
        pg8::Gemm g{F.MIXIN, F.Wout_t, M, D, D}; pg8::OwnPanelOrder S{(int)blockIdx.x, 4};
        pg8::EpiMix E{F.T1};
        pg8::gemm_phase<pg8::EpiMix, pg8::OwnPanelOrder, true, true>(F.lds + RING_OFF, g, S, E, F.wave);
        VM_WAIT(); __syncthreads();
    }
    if (IN(5)) { RELANE(); p5_ln_router(F); if (BOTH(5)) GRID_BAR(); }
    if (IN(6)) { RELANE(); p6_assign(F); if (BOTH(6)) GRID_BAR(); }
    if (IN(7)) {
        if (!IN(6)) { RELANE(); moe_layout(F); }
        pg8::Gemm g{(const bf16*)F.H1F8, (const bf16*)F.Wgu8, SLOTS, 1024, D / 2, F.stok}; pg8::GroupedOrder S;     S.init((const LAS int*)(F.lds + PP_OFF), F.G, (int)blockIdx.x);
        pg8::EpiGateUp E{F.HID};
        pg8::gemm_phase<pg8::EpiGateUp, pg8::GroupedOrder, true, true, true, true>(F.lds + RING_OFF, g, S, E, F.wave);
        if (BOTH(7)) GRID_BAR();
    }
    if (IN(8)) {
        if (!IN(6)) { RELANE(); moe_layout(F); }
        pg8::Gemm g{(const bf16*)F.HID, (const bf16*)F.Wd8, SLOTS, 1024, DEXP / 2}; pg8::GroupedOrder S;     S.init((const LAS int*)(F.lds + PP_OFF), F.G, (int)blockIdx.x);
        pg8::EpiDown E{F.YP, F.PW};
        pg8::gemm_phase<pg8::EpiDown, pg8::GroupedOrder, true, true, false, true>(F.lds + RING_OFF, g, S, E, F.wave);
        if (BOTH(8)) GRID_BAR();
    }
    if (IN(9)) { RELANE(); p9_final(F); }
#undef IN
#undef BOTH
#undef GRID_BAR
#undef RELANE
}

extern "C" void kernel_launch(void* const* d_in, const int* in_sizes, int n_in, void* d_out, int out_size, void* d_ws, size_t ws_size, hipStream_t stream) {
    static int grid = 0;
    if (grid == 0) {
        if (n_in != 20 || in_sizes[0] != M * D || out_size != M * D || ws_size < WS_END) { fprintf(stderr, "kernel_launch: built for 20 inputs, x and out of %d floats, >= %zu bytes of workspace; got n_in %d, in0 %d, out %d, ws %zu; nothing launched\n", M * D, (size_t)WS_END, n_in, n_in > 0 ? in_sizes[0] : -1, out_size, ws_size); grid = -1; return; }
        int dev = 0, cus = 0, per_cu = 0;
        if (hipGetDevice(&dev) != hipSuccess || hipDeviceGetAttribute(&cus, hipDeviceAttributeMultiprocessorCount, dev) != hipSuccess) { fprintf(stderr, "kernel_launch: hipGetDevice / hipDeviceGetAttribute failed; nothing launched\n"); grid = -1; return; }
        if (hipFuncSetAttribute((const void*)hrp_fwd, hipFuncAttributeMaxDynamicSharedMemorySize, LDS_BYTES) != hipSuccess) { fprintf(stderr, "kernel_launch: hipFuncSetAttribute failed (%d bytes of dynamic LDS); nothing launched\n", LDS_BYTES); grid = -1; return; }
        if (hipOccupancyMaxActiveBlocksPerMultiprocessor(&per_cu, (const void*)hrp_fwd, NWAVES * 64, LDS_BYTES) != hipSuccess || per_cu < 1)
            fprintf(stderr, "kernel_launch: note: the occupancy query reports %d workgroups per CU; the launch goes ahead with one per CU\n", per_cu);
        (void)hipGetLastError();
        grid = cus;
        if (grid != 256) fprintf(stderr, "kernel_launch: %d CUs; this kernel is built for 256 and will leave the output unwritten\n", grid);
    }
    if (grid < 0) return;
    if (hipMemsetAsync((char*)d_ws + WS_CTL, 0, CTL_ZERO_BYTES, stream) != hipSuccess) { fprintf(stderr, "kernel_launch: hipMemsetAsync of the control words failed; nothing launched\n"); return; }
    Args a{};
    for (int i = 0; i < 20; ++i) a.in[i] = (const float*)d_in[i];
    a.out = (float*)d_out; a.ws = (unsigned char*)d_ws;
    for (int li = 0; li < N_LAUNCHES; ++li) {
        a.ph_lo = (N_LAUNCHES == PER_PHASE) ? li : 0; a.ph_hi = (N_LAUNCHES == PER_PHASE) ? li + 1 : PER_PHASE;
        hipLaunchKernelGGL(hrp_fwd, dim3(grid), dim3(NWAVES * 64), LDS_BYTES, stream, a);
        const hipError_t le = hipPeekAtLastError();
        if (le != hipSuccess) { fprintf(stderr, "kernel_launch: launch %d failed: %s\n", li, hipGetErrorName(le)); break; }
    }
}
```

```cpp
#include <hip/hip_runtime.h>
#include <cstdio>
#include <cstdint>
#ifndef MK_N_LAUNCHES
#define MK_N_LAUNCHES 1
#endif
namespace pg8 {
#define PG8_LAS __attribute__((address_space(3)))
typedef unsigned short bf16_t;
typedef short bf16x8 __attribute__((ext_vector_type(8)));
typedef float f32x4 __attribute__((ext_vector_type(4)));
typedef unsigned u32x4 __attribute__((ext_vector_type(4)));
constexpr int BM = 256, BK = 64, HALF = 128, HTB = HALF * BK * 2  , STAGE_BYTES = 8 * HTB, NXCD = 8, WGM = 8;

__host__ __device__ __forceinline__ int lds_byte(int r, int c) { const int st = (r >> 4) * 2 + (c >> 5), rr = r & 15, cc = c & 31, ob = rr * 64 + cc * 2; return st * 1024 + (ob ^ (((ob >> 9) & 1) << 5)); }
__host__ __device__ __forceinline__ void stage_rc(int b, int& R, int& C) { const int st = b / 1024, sb = b % 1024, swz = sb ^ (((sb >> 9) & 1) << 5); R = (st >> 1) * 16 + swz / 64; C = (st & 1) * 32 + (swz % 64) / 2; }
__host__ __device__ __forceinline__ int perm32(int rho) { const int n = rho >> 4, i = rho & 15; return 8 * (i >> 2) + 4 * n + (i & 3); }

struct Unit { int pm, pn; };
struct Gemm { const bf16_t* A; const bf16_t* Bt; int M, N, K; const int* gidx; };

struct StaticOrder {
    int nM, nN, nwg, G, c;
    __host__ __device__ void init(int M, int N, int G_, int c_) { nM = M / BM; nN = N / BM; nwg = nM * nN; G = G_; c = c_; }
    __host__ __device__ bool next(int i, Unit& u) const {
        const long L = (long)i * G + c; if (L >= nwg) return false;
        int wgid = (int)L; { const int q = nwg / NXCD, r = nwg % NXCD, xcd = wgid % NXCD, off = wgid / NXCD; wgid = (xcd < r ? xcd * (q + 1) : r * (q + 1) + (xcd - r) * q) + off; }
        const int nig = WGM * nN, gid = wgid / nig, fm = gid * WGM, gsz = (nM - fm) < WGM ? (nM - fm) : WGM;
        u.pm = fm + ((wgid % nig) % gsz); u.pn = (wgid % nig) / gsz; return true;
    }
    __device__ __forceinline__ void a_ready(const Unit&) const {}
    __device__ __forceinline__ void done(const Unit&) const {}
};

__device__ __forceinline__ unsigned cvt_pk_bf16(float lo, float hi) { unsigned r; asm volatile("v_cvt_pk_bf16_f32 %0, %1, %2" : "=v"(r) : "v"(lo), "v"(hi)); return r; }
__device__ __forceinline__ float bf_lo(unsigned w) { return __uint_as_float(w << 16); }
__device__ __forceinline__ float bf_hi(unsigned w) { return __uint_as_float(w & 0xffff0000u); }
__device__ __forceinline__ unsigned pk4_fp8(const f32x4 v) { int w = __builtin_amdgcn_cvt_pk_fp8_f32(v[0], v[1], 0, false); w = __builtin_amdgcn_cvt_pk_fp8_f32(v[2], v[3], w, true); return (unsigned)w; }

struct EpiProj {
    static constexpr bool PERM = true, AFTER_DRAIN = false;
    bf16_t *Q, *V; const float* rope; bf16_t* KZ;
    __device__ __forceinline__ void operator()(const f32x4 (&acc)[2][2][4][2], const Unit& u, int wr, int wc, int fr, int fq) const {
        const int row0 = u.pm * BM + wr * 64 + fr, lc0 = wc * 32 + 8 * fq;
        if (u.pn < 2) {
            bf16_t* base = Q + (size_t)u.pn * ((size_t)65536 * 256); const float sc = u.pn == 0 ? 1.0f : 0.125f;
            f32x4 tb[4][2][2]; u32x4 wv[4][2];
#pragma unroll
            for (int ai = 0; ai < 2; ++ai) {
#pragma unroll
                for (int m = 0; m < 4; ++m) { const int pos = 16 + ((row0 + ai * HALF + m * 16) & 4095);
#pragma unroll
                    for (int bj = 0; bj < 2; ++bj) { const f32x4* tp = (const f32x4*)(rope + ((size_t)pos * 32 + (((lc0 + bj * HALF) & 63) >> 1)) * 2); tb[m][bj][0] = tp[0]; tb[m][bj][1] = tp[1]; } }
                asm volatile("" ::: "memory");
                if (ai == 1) {
#pragma unroll
                    for (int m = 0; m < 4; ++m)
#pragma unroll
                        for (int bj = 0; bj < 2; ++bj) *(u32x4*)(base + (size_t)(row0 + m * 16) * 256 + lc0 + bj * HALF) = wv[m][bj];
                    asm volatile("" ::: "memory"); }
#pragma unroll
                for (int m = 0; m < 4; ++m)
#pragma unroll
                    for (int bj = 0; bj < 2; ++bj) { const f32x4 t0 = tb[m][bj][0], t1 = tb[m][bj][1]; const f32x4 v0 = acc[ai][bj][m][0], v1 = acc[ai][bj][m][1];
                        const float o0 = (v0[0] * t0[0] - v0[1] * t0[1]) * sc, o1 = (v0[0] * t0[1] + v0[1] * t0[0]) * sc;
                        const float o2 = (v0[2] * t0[2] - v0[3] * t0[3]) * sc, o3 = (v0[2] * t0[3] + v0[3] * t0[2]) * sc;
                        const float o4 = (v1[0] * t1[0] - v1[1] * t1[1]) * sc, o5 = (v1[0] * t1[1] + v1[1] * t1[0]) * sc;
                        const float o6 = (v1[2] * t1[2] - v1[3] * t1[3]) * sc, o7 = (v1[2] * t1[3] + v1[3] * t1[2]) * sc;
                        wv[m][bj].x = cvt_pk_bf16(o0, o1); wv[m][bj].y = cvt_pk_bf16(o2, o3); wv[m][bj].z = cvt_pk_bf16(o4, o5); wv[m][bj].w = cvt_pk_bf16(o6, o7);
                        if (u.pn == 1) {
                            const int row = row0 + ai * HALF + m * 16; const float lgh = __builtin_log2f(1.0f - __builtin_exp2f(-5.0f - (float)(2 * bj + (wc >> 1))));
                            const float z = __builtin_exp2f((float)(127 - (row & 127)) * lgh);
                            u32x4 wz; wz.x = cvt_pk_bf16(o0 * z, o1 * z); wz.y = cvt_pk_bf16(o2 * z, o3 * z); wz.z = cvt_pk_bf16(o4 * z, o5 * z); wz.w = cvt_pk_bf16(o6 * z, o7 * z);
                            *(u32x4*)(KZ + (size_t)row * 256 + lc0 + bj * HALF) = wz; } }
            }
#pragma unroll
            for (int m = 0; m < 4; ++m)
#pragma unroll
                for (int bj = 0; bj < 2; ++bj) *(u32x4*)(base + (size_t)(row0 + HALF + m * 16) * 256 + lc0 + bj * HALF) = wv[m][bj];
        } else {
            bf16_t* base = V + (size_t)((u.pn - 2) >> 1) * ((size_t)65536 * 512); const int colt = (u.pn & 1) * 256;
#pragma unroll
            for (int ai = 0; ai < 2; ++ai)
#pragma unroll
                for (int m = 0; m < 4; ++m) { bf16_t* rowp = base + (size_t)(row0 + ai * HALF + m * 16) * 512 + colt + lc0;
#pragma unroll
                    for (int bj = 0; bj < 2; ++bj) { const f32x4 v0 = acc[ai][bj][m][0], v1 = acc[ai][bj][m][1];
                        u32x4 w; w.x = cvt_pk_bf16(v0[0], v0[1]); w.y = cvt_pk_bf16(v0[2], v0[3]); w.z = cvt_pk_bf16(v1[0], v1[1]); w.w = cvt_pk_bf16(v1[2], v1[3]);
                        *(u32x4*)(rowp + bj * HALF) = w; } }
        }
    }
};
struct EpiMix {
    static constexpr bool PERM = true, AFTER_DRAIN = false;
    bf16_t* T;
    __device__ __forceinline__ void operator()(const f32x4 (&acc)[2][2][4][2], const Unit& u, int wr, int wc, int fr, int fq) const {
        const int row0 = u.pm * BM + wr * 64 + fr, col0 = u.pn * BM + wc * 32 + 8 * fq;
#pragma unroll
        for (int ai = 0; ai < 2; ++ai)
#pragma unroll
            for (int m = 0; m < 4; ++m) { bf16_t* rowp = T + (size_t)(row0 + ai * HALF + m * 16) * 1024 + col0;
#pragma unroll
                for (int bj = 0; bj < 2; ++bj) { const f32x4 v0 = acc[ai][bj][m][0], v1 = acc[ai][bj][m][1];
                    u32x4 w; w.x = cvt_pk_bf16(v0[0], v0[1]); w.y = cvt_pk_bf16(v0[2], v0[3]); w.z = cvt_pk_bf16(v1[0], v1[1]); w.w = cvt_pk_bf16(v1[2], v1[3]);
                    *(u32x4*)(rowp + bj * HALF) = w; } }
    }
};
struct EpiGateUp {
    static constexpr bool PERM = true, AFTER_DRAIN = false;
    unsigned char* HID;
    __device__ __forceinline__ void operator()(const f32x4 (&acc)[2][2][4][2], const Unit& u, int wr, int wc, int fr, int fq) const {
        const int row0 = u.pm * BM + wr * 64 + fr, hc = (u.pn & 3) * 128 + wc * 32 + 8 * fq;
#pragma unroll
        for (int ai = 0; ai < 2; ++ai)
#pragma unroll
            for (int m = 0; m < 4; ++m) { float h[8];
#pragma unroll
                for (int n = 0; n < 2; ++n)
#pragma unroll
                    for (int j = 0; j < 4; ++j) { const float g = acc[ai][0][m][n][j] * 0.03125f, up = acc[ai][1][m][n][j] * 0.03125f; h[4 * n + j] = g * up * __builtin_amdgcn_rcpf(1.0f + __expf(-g)); }
                typedef unsigned u32x2e __attribute__((ext_vector_type(2))); u32x2e w; w.x = pk4_fp8((f32x4){h[0], h[1], h[2], h[3]}); w.y = pk4_fp8((f32x4){h[4], h[5], h[6], h[7]});
                *(u32x2e*)(HID + (size_t)(row0 + ai * HALF + m * 16) * 512 + hc) = w; }
    }
};
struct EpiDown {
    static constexpr bool PERM = true, AFTER_DRAIN = false;
    unsigned char* YP; const float* PW;
    __device__ __forceinline__ void operator()(const f32x4 (&acc)[2][2][4][2], const Unit& u, int wr, int wc, int fr, int fq) const {
        const int row0 = u.pm * BM + wr * 64 + fr, col0 = (u.pn & 3) * BM + wc * 64 + 16 * fq;
        float pwv[8];
#pragma unroll
        for (int i = 0; i < 8; ++i) pwv[i] = PW[row0 + (i >> 2) * HALF + (i & 3) * 16];
        asm volatile("" ::: "memory");
#pragma unroll
        for (int ai = 0; ai < 2; ++ai)
#pragma unroll
            for (int m = 0; m < 4; ++m) { const int row = row0 + ai * HALF + m * 16; const float sc = pwv[ai * 4 + m] * 2.0f;
                u32x4 w; w.x = pk4_fp8(acc[ai][0][m][0] * sc); w.y = pk4_fp8(acc[ai][0][m][1] * sc); w.z = pk4_fp8(acc[ai][1][m][0] * sc); w.w = pk4_fp8(acc[ai][1][m][1] * sc);
                *(u32x4*)(YP + (size_t)row * 1024 + col0) = w; }
    }
};
struct RotOrder : StaticOrder {
    __device__ __forceinline__ bool next(int i, Unit& u) const { if (!StaticOrder::next(i, u)) return false; u.pn = (u.pn + (i >> 1)) % nN; return true; }
};
struct OwnPanelOrder {
    int c, ntn;
    __device__ __forceinline__ bool next(int i, Unit& u) const { if (i >= ntn) return false; u.pm = c; u.pn = i; return true; }
    __device__ __forceinline__ void a_ready(const Unit&) const {}
    __device__ __forceinline__ void done(const Unit&) const {}
};
struct GroupedOrder {
    const PG8_LAS int* pp; int nwg, G, c;
    __device__ __forceinline__ void init(const PG8_LAS int* pp_, int G_, int c_) { pp = pp_; nwg = pp_[32] * 4; G = G_; c = c_; }
    __device__ __forceinline__ bool next(int i, Unit& u) const {
        const long L = (long)i * G + c; if (L >= nwg) return false;
        int wgid = (int)L; { const int q = nwg / NXCD, r = nwg % NXCD, xcd = wgid % NXCD, off = wgid / NXCD; wgid = (xcd < r ? xcd * (q + 1) : r * (q + 1) + (xcd - r) * q) + off; }
        const int panel = wgid >> 2; int e = 0;
#pragma unroll
        for (int k = 1; k < 32; ++k) e += (pp[k] <= panel) ? 1 : 0;
        u.pm = panel; u.pn = e * 4 + (wgid & 3); return true;
    }
    __device__ __forceinline__ void a_ready(const Unit&) const {}
    __device__ __forceinline__ void done(const Unit&) const {}
};
__device__ __forceinline__ void gather_off(const int* gidx, int pm, int K, int tid, unsigned (&v0)[2], unsigned (&v1)[2]) {
#pragma unroll
    for (int i = 0; i < 2; ++i) { int R, C; stage_rc(tid * 16 + i * 8192, R, C); v0[i] = (unsigned)(gidx[pm * 256 + R] * K + C) * 2u; v1[i] = (unsigned)(gidx[pm * 256 + 128 + R] * K + C) * 2u; }
}
typedef int v8i32 __attribute__((ext_vector_type(8))); typedef int v4i32 __attribute__((ext_vector_type(4)));
__device__ __forceinline__ v8i32 cat16(const bf16x8 lo, const bf16x8 hi) { return __builtin_shufflevector(__builtin_bit_cast(v4i32, lo), __builtin_bit_cast(v4i32, hi), 0, 1, 2, 3, 4, 5, 6, 7); }
template <class Epi, class Sched, bool ALIGN_EPI = false, bool SP2 = false, bool GATHER = false, bool FP8 = false>
__device__ __forceinline__ void gemm_phase(PG8_LAS unsigned char* lds, const Gemm g, const Sched& S, const Epi& E, const int wid) {
    int lane; asm volatile("v_mbcnt_lo_u32_b32 %0, -1, 0\n\tv_mbcnt_hi_u32_b32 %0, -1, %0" : "=v"(lane));
    const int tid = wid * 64 + lane, wr = wid >> 2, wc = wid & 3, fr = lane & 15, fq = lane >> 4;
    const int K = g.K, nt = K / BK;
    unsigned voffA[2], voffB[2];
#pragma unroll
    for (int i = 0; i < 2; ++i) { int R, C; stage_rc(tid * 16 + i * 8192, R, C); const int Rb = Epi::PERM ? ((R & ~31) + perm32(R & 31)) : R;
        voffA[i] = (unsigned)(R * K + C) * 2u; voffB[i] = (unsigned)(Rb * K + C) * 2u; }
    static_assert(SP2 || !GATHER, "GATHER is written for the SP2 loop");
    unsigned cv0[2] = {0u, 0u}, cv1[2] = {0u, 0u}, nv0[2] = {0u, 0u}, nv1[2] = {0u, 0u};
    const size_t kstep = (size_t)(BK * 2);
    const size_t hstep = (size_t)HALF * K * 2;
    const size_t tstep = 2 * hstep;
    const unsigned ldsw = (unsigned)wid * 1024u;
    const int aoff = lds_byte(wr * 64 + fr, fq * 8), boff = lds_byte(wc * 32 + fr, fq * 8);
#define PG8_SA(b, h) (((b) * 2 + (h)) * HTB)
#define PG8_SB(b, h) ((4 + (b) * 2 + (h)) * HTB)
#define PG8_STAGE(bufoff, gbase, voff) do { _Pragma("unroll") for (int _i = 0; _i < 2; ++_i) \
        __builtin_amdgcn_global_load_lds((const unsigned*)((const char*)(gbase) + (voff)[_i]), (PG8_LAS unsigned*)(lds + (bufoff) + ldsw + _i * 8192), 16, 0, 0); } while (0)
#define PG8_STAGE_A0C(bufoff, gb) do { if constexpr (GATHER) PG8_STAGE(bufoff, gb, cv0); else PG8_STAGE(bufoff, gb, voffA); } while (0)
#define PG8_STAGE_A1C(bufoff, gb) do { if constexpr (GATHER) PG8_STAGE(bufoff, gb, cv1); else PG8_STAGE(bufoff, (gb) + hstep, voffA); } while (0)
#define PG8_STAGE_A0X(bufoff, gb) do { if constexpr (GATHER) PG8_STAGE(bufoff, gb, sv0); else PG8_STAGE(bufoff, gb, voffA); } while (0)
#define PG8_STAGE_A1X(bufoff, gb) do { if constexpr (GATHER) PG8_STAGE(bufoff, gb, sv1); else PG8_STAGE(bufoff, (gb) + hstep, voffA); } while (0)
#define PG8_LDA(dst, b, h) do { _Pragma("unroll") for (int m = 0; m < 4; ++m) _Pragma("unroll") for (int k = 0; k < 2; ++k) dst[m][k] = *(const PG8_LAS bf16x8*)(lds + PG8_SA(b, h) + aoff + m * 2048 + k * 1024); } while (0)
#define PG8_LDB(dst, b, h) do { _Pragma("unroll") for (int n = 0; n < 2; ++n) _Pragma("unroll") for (int k = 0; k < 2; ++k) dst[n][k] = *(const PG8_LAS bf16x8*)(lds + PG8_SB(b, h) + boff + n * 2048 + k * 1024); } while (0)
#define PG8_MMA(ai, bj, At, Bt) do { __builtin_amdgcn_s_setprio(1); if constexpr (FP8) { _Pragma("unroll") for (int m = 0; m < 4; ++m) _Pragma("unroll") for (int n = 0; n < 2; ++n) \
        { const v8i32 a8_ = cat16(Bt[n][0], Bt[n][1]), b8_ = cat16(At[m][0], At[m][1]); asm volatile("v_mfma_scale_f32_16x16x128_f8f6f4 %0, %1, %2, %0, %3, %3 op_sel_hi:[0,0,0]" : "+v"(acc[ai][bj][m][n]) : "v"(a8_), "v"(b8_), "v"(mx_unit)); } } else { \
        _Pragma("unroll") for (int m = 0; m < 4; ++m) _Pragma("unroll") for (int n = 0; n < 2; ++n) _Pragma("unroll") for (int k = 0; k < 2; ++k) \
        acc[ai][bj][m][n] = __builtin_amdgcn_mfma_f32_16x16x32_bf16(Bt[n][k], At[m][k], acc[ai][bj][m][n], 0, 0, 0); } __builtin_amdgcn_s_setprio(0); } while (0)
#define PG8_WAIT_V(n) asm volatile("s_waitcnt vmcnt(" #n ")" ::: "memory")
#define PG8_WAIT_L(n) asm volatile("s_waitcnt lgkmcnt(" #n ")" ::: "memory")
#define PG8_BAR __builtin_amdgcn_s_barrier()
#define PG8_SCHED __builtin_amdgcn_sched_barrier(0)
    const int mx_unit = 0x7f7f7f7f;
    Unit cur, nxt; int ui = 0;
    if (!S.next(0, cur)) return;
    f32x4 acc[2][2][4][2];
#pragma unroll
    for (int a = 0; a < 2; ++a)
#pragma unroll
        for (int b = 0; b < 2; ++b)
#pragma unroll
            for (int m = 0; m < 4; ++m)
#pragma unroll
                for (int n = 0; n < 2; ++n) acc[a][b][m][n] = (f32x4){0.f, 0.f, 0.f, 0.f};
    bf16x8 At[4][2], B0[2][2], B1[2][2];
    const char* cA = (const char*)g.A + (GATHER ? (size_t)0 : (size_t)cur.pm * tstep); const char* cB = (const char*)g.Bt + (size_t)cur.pn * tstep;
    if constexpr (GATHER) gather_off(g.gidx, cur.pm, K, tid, cv0, cv1);
    S.a_ready(cur);
    if constexpr (SP2) {
        PG8_STAGE(PG8_SB(0, 0), cB, voffB); PG8_STAGE(PG8_SB(0, 1), cB + hstep, voffB); PG8_STAGE_A0C(PG8_SA(0, 0), cA); PG8_STAGE_A1C(PG8_SA(0, 1), cA);
        if (wr == 1) PG8_BAR;
        PG8_WAIT_V(2); PG8_BAR;
        PG8_STAGE(PG8_SB(1, 0), cB + kstep, voffB); PG8_STAGE_A0C(PG8_SA(1, 0), cA + kstep); PG8_STAGE(PG8_SB(1, 1), cB + hstep + kstep, voffB);
        PG8_WAIT_V(6); PG8_BAR;
    } else {
        PG8_STAGE(PG8_SB(0, 0), cB, voffB); PG8_STAGE(PG8_SA(0, 0), cA, voffA); PG8_STAGE(PG8_SB(0, 1), cB + hstep, voffB); PG8_STAGE(PG8_SA(0, 1), cA + hstep, voffA);
        if (wr == 1) PG8_BAR;
        PG8_WAIT_V(4); PG8_BAR;
        PG8_STAGE(PG8_SB(1, 0), cB + kstep, voffB); PG8_STAGE(PG8_SA(1, 0), cA + kstep, voffA); PG8_STAGE(PG8_SB(1, 1), cB + hstep + kstep, voffB);
        PG8_WAIT_V(6); PG8_BAR;
    }
    for (;;) {
        const bool has_next = S.next(ui + 1, nxt);
        if constexpr (GATHER) { if (has_next) gather_off(g.gidx, nxt.pm, K, tid, nv0, nv1); else { nv0[0] = cv0[0]; nv0[1] = cv0[1]; nv1[0] = cv1[0]; nv1[1] = cv1[1]; } }
        const char* nA = GATHER ? cA : (has_next ? (const char*)g.A + (size_t)nxt.pm * tstep : cA); const char* nB = has_next ? (const char*)g.Bt + (size_t)nxt.pn * tstep : cB;
#pragma unroll 1
        for (int t = 0; t < nt; t += 2) {
            const bool last = (t == nt - 2);
            const char* a1 = cA + (size_t)(t + 1) * kstep;
            const char* a2 = last ? nA : cA + (size_t)(t + 2) * kstep; const char* b2 = last ? nB : cB + (size_t)(t + 2) * kstep;
            const char* a3 = a2 + kstep; const char* b3 = b2 + kstep;
            if (last && has_next) S.a_ready(nxt);
            unsigned sv0[2], sv1[2]; sv0[0] = last ? nv0[0] : cv0[0]; sv0[1] = last ? nv0[1] : cv0[1]; sv1[0] = last ? nv1[0] : cv1[0]; sv1[1] = last ? nv1[1] : cv1[1];
            if constexpr (SP2) {
            PG8_LDB(B0, 0, 0); PG8_LDB(B1, 0, 1); PG8_SCHED; PG8_LDA(At, 0, 0); PG8_STAGE_A1C(PG8_SA(1, 1), a1);
            PG8_WAIT_V(8); PG8_WAIT_L(0); PG8_BAR; PG8_MMA(0, 0, At, B0); PG8_MMA(0, 1, At, B1); PG8_BAR; PG8_SCHED;
            PG8_LDA(At, 0, 1); PG8_STAGE(PG8_SB(0, 0), b2, voffB); PG8_STAGE(PG8_SB(0, 1), b2 + hstep, voffB); PG8_STAGE_A0X(PG8_SA(0, 0), a2);
            PG8_WAIT_V(8); PG8_WAIT_L(0); PG8_BAR; PG8_MMA(1, 0, At, B0); PG8_MMA(1, 1, At, B1); PG8_BAR; PG8_SCHED;
            PG8_LDB(B0, 1, 0); PG8_LDB(B1, 1, 1); PG8_SCHED; PG8_LDA(At, 1, 0); PG8_STAGE_A1X(PG8_SA(0, 1), a2);
            PG8_WAIT_V(8); PG8_WAIT_L(0); PG8_BAR; PG8_MMA(0, 0, At, B0); PG8_MMA(0, 1, At, B1); PG8_BAR; PG8_SCHED;
            PG8_LDA(At, 1, 1); PG8_STAGE(PG8_SB(1, 0), b3, voffB); PG8_STAGE(PG8_SB(1, 1), b3 + hstep, voffB); PG8_STAGE_A0X(PG8_SA(1, 0), a3);
            PG8_WAIT_V(8); PG8_WAIT_L(0); PG8_BAR; PG8_MMA(1, 0, At, B0); PG8_MMA(1, 1, At, B1); PG8_BAR; PG8_SCHED;
            } else {
            PG8_LDB(B0, 0, 0); PG8_SCHED; PG8_LDA(At, 0, 0); PG8_STAGE(PG8_SA(1, 1), a1 + hstep, voffA);
            PG8_WAIT_L(8); PG8_BAR; PG8_WAIT_L(0); PG8_MMA(0, 0, At, B0); PG8_BAR; PG8_SCHED;
            PG8_LDB(B1, 0, 1); PG8_STAGE(PG8_SB(0, 0), b2, voffB);
            PG8_BAR; PG8_WAIT_L(0); PG8_MMA(0, 1, At, B1); PG8_BAR;
            PG8_LDA(At, 0, 1); PG8_STAGE(PG8_SA(0, 0), a2, voffA);
            PG8_BAR; PG8_WAIT_L(0); PG8_MMA(1, 0, At, B0); PG8_BAR; PG8_SCHED;
            PG8_STAGE(PG8_SB(0, 1), b2 + hstep, voffB);
            PG8_WAIT_V(6); PG8_BAR; PG8_MMA(1, 1, At, B1); PG8_BAR;
            PG8_LDB(B0, 1, 0); PG8_SCHED; PG8_LDA(At, 1, 0); PG8_STAGE(PG8_SA(0, 1), a2 + hstep, voffA);
            PG8_WAIT_L(8); PG8_BAR; PG8_WAIT_L(0); PG8_MMA(0, 0, At, B0); PG8_BAR; PG8_SCHED;
            PG8_LDB(B1, 1, 1); PG8_STAGE(PG8_SB(1, 0), b3, voffB);
            PG8_BAR; PG8_WAIT_L(0); PG8_MMA(0, 1, At, B1); PG8_BAR;
            PG8_LDA(At, 1, 1); PG8_STAGE(PG8_SA(1, 0), a3, voffA);
            PG8_BAR; PG8_WAIT_L(0); PG8_MMA(1, 0, At, B0); PG8_BAR; PG8_SCHED;
            PG8_STAGE(PG8_SB(1, 1), b3 + hstep, voffB);
            PG8_WAIT_V(6); PG8_BAR; PG8_MMA(1, 1, At, B1); PG8_BAR;
            }
        }
        if constexpr (ALIGN_EPI) { if (wr == 0) PG8_BAR; }
        if constexpr (FP8) asm volatile("s_nop 15\n\ts_nop 15" ::: "memory");
        if constexpr (!Epi::AFTER_DRAIN) { E(acc, cur, wr, wc, fr, fq); S.done(cur); }
        if (!has_next) break;
#pragma unroll
        for (int a = 0; a < 2; ++a)
#pragma unroll
            for (int b = 0; b < 2; ++b)
#pragma unroll
                for (int m = 0; m < 4; ++m)
#pragma unroll
                    for (int n = 0; n < 2; ++n) acc[a][b][m][n] = (f32x4){0.f, 0.f, 0.f, 0.f};
        cur = nxt; cA = nA; cB = nB; ++ui;
        if constexpr (GATHER) { cv0[0] = nv0[0]; cv0[1] = nv0[1]; cv1[0] = nv1[0]; cv1[1] = nv1[1]; }
        if constexpr (ALIGN_EPI) { if (wr == 1) PG8_BAR; }
    }
    PG8_WAIT_V(0);
    if constexpr (!ALIGN_EPI) { if (wr == 0) PG8_BAR; }
    PG8_BAR;
    if constexpr (Epi::AFTER_DRAIN) { E.fused(acc, cur, wr, wc, fr, fq, lds, wid, lane); S.done(cur); }
#undef PG8_SA
#undef PG8_SB
#undef PG8_STAGE
#undef PG8_LDA
#undef PG8_STAGE_A0C
#undef PG8_STAGE_A1C
#undef PG8_STAGE_A0X
#undef PG8_STAGE_A1X
#undef PG8_LDB
#undef PG8_MMA
#undef PG8_WAIT_V
#undef PG8_WAIT_L
#undef PG8_BAR
#undef PG8_SCHED
}
}

constexpr int NWAVES = 8;
constexpr int N_LAUNCHES = MK_N_LAUNCHES;
constexpr int PER_PHASE = 10;

constexpr int BATCH = 16, SEQ = 4096, D = 1024, NMETA = 16;
constexpr int M = BATCH * SEQ;
constexpr int NPROJ = 2048, NEXP = 32, DEXP = 512;
constexpr int NPANEL_MAX = 544, SLOTS = NPANEL_MAX * 256;
constexpr float LN_EPS = 1e-5f, GN_EPS = 1e-6f;
constexpr float ALPHA = 1.189207115002721f;

constexpr size_t MiB = 1u << 20;
constexpr size_t WS_CTL = 0, CTL_ZERO_BYTES = 1 * MiB;
constexpr size_t WS_WIN = 2 * MiB;
constexpr size_t WS_WOUT = 6 * MiB;
constexpr size_t WS_WPOOL = 8 * MiB;
constexpr size_t WS_RW = 8 * MiB + 256 * 1024;
constexpr size_t WS_METAK = 8 * MiB + 512 * 1024;
constexpr size_t WS_METAV = WS_METAK + 16 * 256 * 4;
constexpr size_t WS_METAU = WS_METAV + 16 * 512 * 4;
constexpr size_t WS_ROPE = 9 * MiB;
constexpr size_t WS_TOKE = 12 * MiB;
constexpr size_t WS_TOKL = WS_TOKE + (size_t)M * 4;
constexpr size_t WS_TOKW = WS_TOKL + (size_t)M * 4;
constexpr size_t WS_TOKS = WS_TOKW + (size_t)M * 8;
constexpr size_t WS_CNT = 14 * MiB;
constexpr size_t WS_PW = 15 * MiB;
constexpr size_t WS_STOK = 16 * MiB;
constexpr size_t WS_WGU = 32 * MiB;
constexpr size_t WS_WD = 96 * MiB;
constexpr size_t WS_ST = 128 * MiB;
constexpr size_t WS_H0 = 160 * MiB;
constexpr size_t WS_Q = 288 * MiB, WS_K = 320 * MiB;
constexpr size_t WS_V = 352 * MiB, WS_GATE = 416 * MiB, WS_U = 480 * MiB;
constexpr size_t WS_MIXIN = 544 * MiB;
constexpr size_t WS_KZ = 672 * MiB;
constexpr size_t WS_T1 = 672 * MiB;
constexpr size_t WS_H1B = 288 * MiB;
constexpr size_t WS_HID = 688 * MiB;
constexpr size_t WS_H1F8 = 928 * MiB;
constexpr size_t WS_YP = 416 * MiB;
constexpr size_t WS_END = 992 * MiB;
static_assert(WS_ROPE + (size_t)4112 * 32 * 8 <= WS_TOKE && WS_TOKS + (size_t)M * 8 <= WS_CNT && WS_PW + (size_t)SLOTS * 4 <= WS_WGU, "small tables");
static_assert(WS_K == WS_Q + (size_t)M * 256 * 2 && WS_GATE == WS_V + (size_t)M * 512 * 2 && WS_U == WS_GATE + (size_t)M * 512 * 2, "EpiProj addresses K, gate, u relative to Q, V");
static_assert(WS_STOK + (size_t)SLOTS * 4 <= WS_WGU && WS_YP + (size_t)SLOTS * 1024 <= WS_HID && WS_HID + (size_t)SLOTS * 512 <= WS_H1F8 && WS_H1F8 + (size_t)M * 1024 <= WS_END && WS_WGU + (size_t)32 * 1024 * 1024 <= WS_WD && WS_WD + (size_t)32 * 1024 * 512 <= WS_ST && WS_T1 + (size_t)M * 1024 * 2 <= WS_END, "d_ws map");
constexpr int CW_BAR = 4096;

constexpr int RING_OFF = 0, RING_BYTES = 131072;
constexpr int LDSCTL_OFF = RING_BYTES;
constexpr int PP_OFF = LDSCTL_OFF, TOT_OFF = LDSCTL_OFF + 192, BEF_OFF = LDSCTL_OFF + 320, BASE_OFF = LDSCTL_OFF + 448, LCNT_OFF = LDSCTL_OFF + 576, MISC_OFF = LDSCTL_OFF + 768;
constexpr int LDS_BYTES = 147456;
static_assert(MISC_OFF + 128 <= LDS_BYTES, "LDS map");
#define GAS __attribute__((address_space(1)))
#define LAS __attribute__((address_space(3)))
typedef unsigned short bf16;
typedef unsigned v4u __attribute__((ext_vector_type(4)));
typedef float f32x4 __attribute__((ext_vector_type(4)));
typedef short bf16x8 __attribute__((ext_vector_type(8)));
typedef GAS unsigned gu32;
typedef GAS unsigned long long gu64;
#define RLX_AGENT __ATOMIC_RELAXED, __HIP_MEMORY_SCOPE_AGENT
#define LDS_WAIT() asm volatile("s_waitcnt lgkmcnt(0)" ::: "memory")
#define VM_WAIT() asm volatile("s_waitcnt vmcnt(0)" ::: "memory")
__device__ __forceinline__ unsigned long long rt() { return __builtin_amdgcn_s_memrealtime(); }
__device__ __forceinline__ unsigned f2bf(float f) { unsigned u = __builtin_bit_cast(unsigned, f); return (u + 0x7fffu + ((u >> 16) & 1u)) >> 16; }
__device__ __forceinline__ unsigned pk2(float lo, float hi) { return f2bf(lo) | (f2bf(hi) << 16); }

#define XB_TMO      128
#define XB_XCNT(j)  (256  + 64 * (j))
#define XB_XSUB(j)  (1280 + 64 * (j))
#define XB_XGEN(j)  (2304 + 64 * (j))
#define XB_TOP      3328
#define XB_TOPGEN   3392
#define XCD_BAR_WORDS 3456
#define XB_SPIN_CAP (1u << 18)

__device__ __forceinline__ unsigned xb_ld(unsigned* p)              { return __hip_atomic_load(p, __ATOMIC_RELAXED, __HIP_MEMORY_SCOPE_AGENT); }
__device__ __forceinline__ unsigned xb_add(unsigned* p, unsigned v) { return __hip_atomic_fetch_add(p, v, __ATOMIC_RELAXED, __HIP_MEMORY_SCOPE_AGENT); }
__device__ __forceinline__ unsigned xb_xcc_id() { return (unsigned)__builtin_amdgcn_s_getreg((3 << 11) | 20) & 0xFu; }
#define XB_SPIN(cond, bar) do { unsigned _sp = 0; while (cond) { __builtin_amdgcn_s_sleep(1); \
    if ((++_sp & 255u) == 0u) { if (xb_ld(&(bar)[XB_TMO])) break; if (_sp > XB_SPIN_CAP) { atomicAdd(&(bar)[XB_TMO], 1u); break; } } } } while (0)

struct XcdBarrier {
    unsigned* bar; unsigned x;
    volatile LAS unsigned* st;
};

__device__ __forceinline__ XcdBarrier xcd_barrier_post(unsigned* bar, volatile LAS unsigned* st) {
    XcdBarrier b; b.bar = bar; b.x = xb_xcc_id(); b.st = st;
    if (threadIdx.x == 0) (void)xb_add(&bar[XB_XCNT(b.x)], 1u);
    return b;
}
__device__ __forceinline__ void xcd_barrier_complete(unsigned* bar, unsigned x, unsigned& nloc, unsigned& nx) {
    const unsigned G = gridDim.x * gridDim.y * gridDim.z;
    unsigned sum, cnt, mine, sp = 0u;
    for (;;) {
        sum = 0u; cnt = 0u; mine = 0u;
#pragma unroll
        for (unsigned j = 0; j < 16; ++j) { const unsigned c = xb_ld(&bar[XB_XCNT(j)]); sum += c; cnt += (c > 0u) ? 1u : 0u; mine = (j == x) ? c : mine; }
        if (sum == G) break;
        __builtin_amdgcn_s_sleep(1);
        if ((++sp & 255u) == 0u) { if (xb_ld(&bar[XB_TMO])) break; if (sp > XB_SPIN_CAP) { atomicAdd(&bar[XB_TMO], 1u); break; } }
    }
    nloc = mine > 0u ? mine : 1u; nx = cnt > 0u ? cnt : 1u;
}

__device__ __forceinline__ void xcd_barrier(const XcdBarrier& b) {
    asm volatile("s_waitcnt vmcnt(0)" ::: "memory");
    __syncthreads();
    if (threadIdx.x == 0) {
        unsigned* bar = b.bar;
        __builtin_amdgcn_s_waitcnt(0);
        unsigned nloc = b.st[0], nx = b.st[1];
        if (nloc == 0u) { xcd_barrier_complete(bar, b.x, nloc, nx); b.st[0] = nloc; b.st[1] = nx; }
        const unsigned old = xb_add(&bar[XB_XSUB(b.x)], 1u);
        const unsigned gen = old / nloc;
        if (old + 1u == (gen + 1u) * nloc) {
            __builtin_amdgcn_fence(__ATOMIC_RELEASE, "agent");
            asm volatile("s_waitcnt vmcnt(0)" ::: "memory");
            const unsigned og = xb_add(&bar[XB_TOP], 1u);
            const unsigned tg = og / nx;
            if (og + 1u == (tg + 1u) * nx) xb_add(&bar[XB_TOPGEN], 1u);
            else XB_SPIN(xb_ld(&bar[XB_TOPGEN]) == tg, bar);
            __builtin_amdgcn_fence(__ATOMIC_ACQUIRE, "agent");
            xb_add(&bar[XB_XGEN(b.x)], 1u);
            asm volatile("s_waitcnt vmcnt(0)" ::: "memory");
        } else {
            XB_SPIN(xb_ld(&bar[XB_XGEN(b.x)]) == gen, bar);
            __builtin_amdgcn_fence(__ATOMIC_ACQUIRE, "agent");
            asm volatile("s_waitcnt vmcnt(0)" ::: "memory");
        }
    }
    __syncthreads();
}

#define DI __device__ __forceinline__
typedef short v4i16_t __attribute__((ext_vector_type(4)));
typedef unsigned u32x2 __attribute__((ext_vector_type(2)));
typedef float f32x2 __attribute__((ext_vector_type(2)));
struct Frame {
    LAS unsigned char* lds;
    volatile LAS unsigned* MISC;
    gu32* ctl;
    int tid, lane, wave;
    int vcu, G;
    const float *x, *meta, *lne_g, *lne_b, *w_in, *pool_w, *pool_b, *pool_scale, *w_out, *ln1_g, *ln1_b, *rg_w, *rg_b, *re_w, *re_b, *w_gate, *w_up, *w_down, *ln2_g, *ln2_b;
    float* out;
    bf16 *Win_t, *Wout_t, *Wpool_t;
    unsigned char *Wgu8, *Wd8, *H1F8, *HID;
    float *RW, *metak, *metav, *metau, *rope, *PW; bf16* T1;
    unsigned *toke, *tokl; f32x2* tokw; int* toks; int* cnt; int* stok;
    bf16 *ST, *H0, *Qb, *Kb, *Vb, *Gb, *Ub, *KZ, *MIXIN, *H1B; unsigned char* YP;
};
DI float wave_sum(float v) {
#pragma unroll
    for (int o = 1; o < 64; o <<= 1) v += __shfl_xor(v, o);
    return v;
}
DI float bf2f(bf16 v) { return __uint_as_float(((unsigned)v) << 16); }
DI float bflo(unsigned w) { return __uint_as_float(w << 16); }
DI float bfhi(unsigned w) { return __uint_as_float(w & 0xffff0000u); }
DI unsigned cvtpk(float lo, float hi) { return pg8::cvt_pk_bf16(lo, hi); }
DI unsigned pk4f8(float a, float b, float c, float d) { int w = __builtin_amdgcn_cvt_pk_fp8_f32(a, b, 0, false); w = __builtin_amdgcn_cvt_pk_fp8_f32(c, d, w, true); return (unsigned)w; }

template <int MODE> DI int rowmap(int n) {
    if (MODE == 1) { if (n < 512) { const int i = n & 63; return (n & ~63) + (i < 32 ? 2 * i : 2 * (i - 32) + 1); } return n; }
    if (MODE == 2) return 256 * (n >> 7) + (n & 127);
    if (MODE == 3) return 256 * (n >> 7) + 128 + (n & 127);
    if (MODE == 4) { const int o = n & 255; return (n & ~255) + 128 * ((o >> 3) & 1) + 32 * (o >> 6) + 8 * ((o >> 4) & 3) + (o & 7); }
    return n;
}
template <int MODE, bool F8 = false> DI void p0_transpose_item(const float* W, int K, int N, void* WTv, LAS float* scr, int item, int lane) {
    const int nblk = N / 32, kb = item / nblk, nb = item % nblk, k0 = 64 * kb, n0 = 32 * nb;
    f32x4 tv[8];
#pragma unroll
    for (int i = 0; i < 8; ++i) tv[i] = *(const GAS f32x4*)(W + (size_t)(k0 + i * 8 + (lane >> 3)) * N + n0 + 4 * (lane & 7));
#pragma unroll
    for (int i = 0; i < 8; ++i) { LAS float* d = scr + (i * 8 + (lane >> 3)) * 33 + 4 * (lane & 7); d[0] = tv[i].x; d[1] = tv[i].y; d[2] = tv[i].z; d[3] = tv[i].w; }
    LDS_WAIT(); asm volatile("" ::: "memory");
    const int c = lane & 7;
#pragma unroll
    for (int j = 0; j < 4; ++j) { const int n = (lane >> 3) + 8 * j; const LAS float* s = scr + (8 * c) * 33 + n;
        if constexpr (F8) { u32x2 o; o.x = pk4f8(32.f * s[0 * 33], 32.f * s[1 * 33], 32.f * s[2 * 33], 32.f * s[3 * 33]); o.y = pk4f8(32.f * s[4 * 33], 32.f * s[5 * 33], 32.f * s[6 * 33], 32.f * s[7 * 33]);
            *(GAS u32x2*)((unsigned char*)WTv + (size_t)rowmap<MODE>(n0 + n) * K + k0 + 8 * c) = o; }
        else { bf16* WT = (bf16*)WTv; v4u o; o.x = pk2(s[0 * 33], s[1 * 33]); o.y = pk2(s[2 * 33], s[3 * 33]); o.z = pk2(s[4 * 33], s[5 * 33]); o.w = pk2(s[6 * 33], s[7 * 33]);
            *(GAS v4u*)(WT + (size_t)rowmap<MODE>(n0 + n) * K + k0 + 8 * c) = o; } }
    LDS_WAIT(); asm volatile("" ::: "memory");
}
DI void ld_row(const float* xrow, f32x4 (&v)[4], int lane) {
    const GAS f32x4* xr = (const GAS f32x4*)xrow + lane;
#pragma unroll
    for (int j = 0; j < 4; ++j) v[j] = xr[64 * j];
}
DI void ln_regs(const f32x4 (&gv)[4], const f32x4 (&bv)[4], f32x4 (&v)[4], float eps) {
    float s = 0.f;
#pragma unroll
    for (int j = 0; j < 4; ++j) s += (v[j].x + v[j].y) + (v[j].z + v[j].w);
    const float mean = wave_sum(s) * (1.f / D); float s2 = 0.f;
#pragma unroll
    for (int j = 0; j < 4; ++j) { v[j] = v[j] - mean; s2 += (v[j].x * v[j].x + v[j].y * v[j].y) + (v[j].z * v[j].z + v[j].w * v[j].w); }
    const float rstd = 1.f / sqrtf(wave_sum(s2) * (1.f / D) + eps);
#pragma unroll
    for (int j = 0; j < 4; ++j) v[j] = v[j] * rstd * gv[j] + bv[j];
}
DI void ln_row(const float* xrow, const f32x4 (&gv)[4], const f32x4 (&bv)[4], f32x4 (&v)[4], int lane, float eps) { ld_row(xrow, v, lane); ln_regs(gv, bv, v, eps); }
DI void store_row_bf16(bf16* orow, const f32x4 (&v)[4], int lane) {
    GAS unsigned long long* o8 = (GAS unsigned long long*)orow + lane;
#pragma unroll
    for (int j = 0; j < 4; ++j) o8[64 * j] = (unsigned long long)pk2(v[j].x, v[j].y) | ((unsigned long long)pk2(v[j].z, v[j].w) << 32);
}
DI void p0_prologue(Frame& F) {
    LAS float* scr = (LAS float*)(F.lds + RING_OFF + F.wave * 16384);
    const int gw = F.vcu * NWAVES + F.wave, NGW = F.G * NWAVES;
    constexpr int I_IN = 16 * 64, I_OUT = 16 * 32, I_POOL = 4 * 8, I_G = 32 * 256, I_U = 32 * 256, I_D = 32 * 256;
    constexpr int NITEMS = I_IN + I_OUT + I_POOL + I_G + I_U + I_D;
    for (int it = gw; it < NITEMS; it += NGW) {
        int r = it;
        if (r < I_IN) { p0_transpose_item<1>(F.w_in, 1024, 2048, F.Win_t, scr, r, F.lane); continue; } r -= I_IN;
        if (r < I_OUT) { p0_transpose_item<0>(F.w_out, 1024, 1024, F.Wout_t, scr, r, F.lane); continue; } r -= I_OUT;
        if (r < I_POOL) { const int g = r >> 3; p0_transpose_item<0>(F.pool_w + g * 16384, 128, 128, F.Wpool_t + g * 16384, scr, r & 7, F.lane); continue; } r -= I_POOL;
        if (r < I_G) { const int e = r >> 8; p0_transpose_item<2, true>(F.w_gate + (size_t)e * 524288, 1024, 512, F.Wgu8 + (size_t)e * 1048576, scr, r & 255, F.lane); continue; } r -= I_G;
        if (r < I_U) { const int e = r >> 8; p0_transpose_item<3, true>(F.w_up + (size_t)e * 524288, 1024, 512, F.Wgu8 + (size_t)e * 1048576, scr, r & 255, F.lane); continue; } r -= I_U;
        { const int e = r >> 8; p0_transpose_item<4, true>(F.w_down + (size_t)e * 524288, 512, 1024, F.Wd8 + (size_t)e * 524288, scr, r & 255, F.lane); }
    }
    { f32x4 gv[4], bv[4];
#pragma unroll
      for (int j = 0; j < 4; ++j) { gv[j] = *(const f32x4*)(F.lne_g + 4 * F.lane + 256 * j); bv[j] = *(const f32x4*)(F.lne_b + 4 * F.lane + 256 * j); }
      constexpr int META_SKIP = 8;
      const bool metawg = blockIdx.x < 20;
      const int nrows = metawg ? 32 - META_SKIP : 32;
      int extra = -1, extra2 = -1;
      if (!metawg) { const int nw = ((int)blockIdx.x - 20) * NWAVES + F.wave, NOTHER = 236 * NWAVES;
#pragma unroll
          for (int q = 0; q < 2; ++q) { const int r = nw + q * NOTHER;
              if (r < 20 * NWAVES * META_SKIP) { const int mw = r / META_SKIP, bx = mw / NWAVES, wv = mw % NWAVES; const int vcu2 = (bx % 8) * (F.G / 8) + bx / 8;
                  const int row = vcu2 * NWAVES + wv + NGW * (32 - META_SKIP + r % META_SKIP); if (q == 0) extra = row; else extra2 = row; } } }
      f32x4 nx[4], ny[4]; ld_row(F.x + (size_t)gw * D, nx, F.lane); ld_row(F.x + (size_t)(gw + NGW) * D, ny, F.lane);
      for (int i = 0; i < nrows; ++i) { const int m = gw + NGW * i; f32x4 v[4];
#pragma unroll
          for (int j = 0; j < 4; ++j) { v[j] = nx[j]; nx[j] = ny[j]; }
          if (i + 2 < nrows) ld_row(F.x + (size_t)(m + 2 * NGW) * D, ny, F.lane);
          else if (i + 2 == nrows && extra >= 0) ld_row(F.x + (size_t)extra * D, ny, F.lane);
          ln_regs(gv, bv, v, LN_EPS); store_row_bf16(F.H0 + (size_t)m * D, v, F.lane); }
      if (extra >= 0) { f32x4 v[4];
#pragma unroll
          for (int j = 0; j < 4; ++j) v[j] = nx[j];
          if (extra2 >= 0) ld_row(F.x + (size_t)extra2 * D, nx, F.lane);
          ln_regs(gv, bv, v, LN_EPS); store_row_bf16(F.H0 + (size_t)extra * D, v, F.lane);
          if (extra2 >= 0) {
#pragma unroll
              for (int j = 0; j < 4; ++j) v[j] = nx[j];
              ln_regs(gv, bv, v, LN_EPS); store_row_bf16(F.H0 + (size_t)extra2 * D, v, F.lane); } }
    }
    { const int gt = gw * 64 + F.lane, NT = NGW * 64;
      for (int idx = gt; idx < 4112 * 32; idx += NT) { const int pos = idx >> 5, i = idx & 31;
          const float inv = exp2f(-(float)i * 0.415241011860920f);
          const float ang = (float)pos * inv;
          const double a = (double)ang; const double k = __builtin_rint(a * 0.15915494309189535); const float rr = (float)__builtin_fma(-k, 6.283185307179586, a);
          F.rope[(size_t)idx * 2] = cosf(rr); F.rope[(size_t)idx * 2 + 1] = sinf(rr); }
      for (int idx = gt; idx < 36 * 1024; idx += NT) { const int c = idx >> 10, k = idx & 1023; F.RW[idx] = c < 4 ? F.rg_w[k * 4 + c] : F.re_w[k * 32 + (c - 4)]; }
    }
    if (blockIdx.x < 20) {
        __syncthreads();
        LAS float* ML = (LAS float*)(F.lds);
        LAS float* RED = (LAS float*)(F.lds + 65536);
        LAS float* OUTM = (LAS float*)(F.lds + 98304);
        { f32x4 gv[4], bv[4];
#pragma unroll
          for (int j = 0; j < 4; ++j) { gv[j] = *(const f32x4*)(F.lne_g + 4 * F.lane + 256 * j); bv[j] = *(const f32x4*)(F.lne_b + 4 * F.lane + 256 * j); }
          for (int rr = 0; rr < 2; ++rr) { const int m = F.wave * 2 + rr; f32x4 v[4]; ln_row(F.meta + (size_t)m * D, gv, bv, v, F.lane, LN_EPS);
#pragma unroll
              for (int j = 0; j < 4; ++j) *(LAS f32x4*)(ML + m * 1024 + 4 * F.lane + 256 * j) = v[j]; } }
        __syncthreads();
        const int item = blockIdx.x;
        const int col0 = item < 4 ? 256 + 64 * item : (item < 12 ? 512 + 64 * (item - 4) : 1536 + 64 * (item - 12));
        float acc[16];
#pragma unroll
        for (int m = 0; m < 16; ++m) acc[m] = 0.f;
        for (int kb = 0; kb < 128; kb += 32) {
            float wv[32];
#pragma unroll
            for (int j = 0; j < 32; ++j) wv[j] = F.w_in[(size_t)(F.wave * 128 + kb + j) * 2048 + col0 + F.lane];
#pragma unroll
            for (int j = 0; j < 32; ++j) { const int k = F.wave * 128 + kb + j;
#pragma unroll
                for (int m = 0; m < 16; ++m) acc[m] += ML[m * 1024 + k] * wv[j]; } }
#pragma unroll
        for (int m = 0; m < 16; ++m) RED[(F.wave * 16 + m) * 64 + F.lane] = acc[m];
        __syncthreads();
        for (int o = F.tid; o < 1024; o += 512) { float s = 0.f;
#pragma unroll
            for (int w = 0; w < 8; ++w) s += RED[w * 1024 + o];
            OUTM[o] = s; }
        __syncthreads();
        for (int o = F.tid; o < 1024; o += 512) { const int m = o >> 6, ii = o & 63;
            if (item < 4) {
                const int i = ii >> 1; const float x1 = OUTM[m * 64 + i], x2 = OUTM[m * 64 + 32 + i];
                const float inv = exp2f(-(float)i * 0.415241011860920f); const float ang = (float)m * inv;
                const double a = (double)ang; const double kq = __builtin_rint(a * 0.15915494309189535); const float rr = (float)__builtin_fma(-kq, 6.283185307179586, a);
                const float cs = cosf(rr), sn = sinf(rr);
                F.metak[m * 256 + item * 64 + ii] = ((ii & 1) ? (x1 * sn + x2 * cs) : (x1 * cs - x2 * sn)) * 0.125f;
            } else if (item < 12) F.metav[m * 512 + (item - 4) * 64 + ii] = OUTM[o];
            else F.metau[m * 512 + (item - 12) * 64 + ii] = OUTM[o];
        }
        __syncthreads();
    }
}

DI f32x4 mma(bf16x8 xf, bf16x8 yf, f32x4 acc) { return __builtin_amdgcn_mfma_f32_16x16x32_bf16(xf, yf, acc, 0, 0, 0); }
DI bf16x8 frag_row(const LAS unsigned char* base, int stride, int row0, int k0, int lane) {
    return *(const LAS bf16x8*)(base + (row0 + (lane & 15)) * stride + (k0 + 8 * (lane >> 4)) * 2);
}
DI bf16x8 frag_tr(const LAS unsigned char* base, int stride, int k0, int x0, int lane) {
    const int g = lane >> 4, q = (lane & 15) >> 2, p = lane & 3;
    const LAS unsigned char* a = base + (k0 + 8 * g + q) * stride + (x0 + 4 * p) * 2;
    const v4i16_t lo = __builtin_amdgcn_ds_read_tr16_b64_v4i16((LAS v4i16_t*)a);
    const v4i16_t hi = __builtin_amdgcn_ds_read_tr16_b64_v4i16((LAS v4i16_t*)(a + 4 * stride));
    return __builtin_shufflevector(lo, hi, 0, 1, 2, 3, 4, 5, 6, 7);
}
constexpr int SQ = 144, SV = 272;
DI void p2_scan(Frame& F) {
    constexpr int KBY = 16384, VBY = 8192, SLOT = KBY + VBY;
    const int w = F.wave, lane = F.lane, fr = lane & 15, fq = lane >> 4, dt = w >> 1, vt = w & 1;
    for (int unit = blockIdx.x; unit < 256; unit += F.G) {
        const int bh = (unit & 7) * 8 + (unit >> 5), b = bh >> 2, h = bh & 3, vs = (unit >> 3) & 3;
        const float lg = log2f(1.0f - exp2f(-5.0f - (float)h));
        const float cd = exp2f(128.0f * lg);
        const int d0 = 16 * dt + 4 * fq, vcol = vs * 32 + 16 * vt + fr;
        f32x4 st = {0.f, 0.f, 0.f, 0.f};
        { float mv[16]; f32x4 mk[16];
#pragma unroll
          for (int m = 0; m < 16; ++m) { mv[m] = F.metav[m * 512 + h * 128 + vcol]; mk[m] = *(const f32x4*)(F.metak + m * 256 + h * 64 + d0); }
#pragma unroll
          for (int m = 0; m < 16; ++m) st = st + mk[m] * (exp2f((float)(15 - m) * lg) * mv[m]); }
        bf16* STb = F.ST + (size_t)((b * 4 + h) * 32) * 8192 + vcol * 64 + d0;
        const unsigned ldsb_ = (unsigned)(size_t)F.lds;
        const unsigned kaddr = ldsb_ + (unsigned)((8 * fq + ((lane & 15) >> 2)) * 128 + (16 * dt + 4 * (lane & 3)) * 2);
        const unsigned vaddr = ldsb_ + (unsigned)(KBY + (8 * fq + ((lane & 15) >> 2)) * 64 + (16 * vt + 4 * (lane & 3)) * 2);
        const bf16* kz0 = F.KZ + ((size_t)b * 4096 + 16 * w + (lane >> 3)) * 256 + h * 64 + (lane & 7) * 8;
        const bf16* vv0 = F.Vb + ((size_t)b * 4096 + 16 * w + (lane >> 2)) * 512 + h * 128 + vs * 32 + (lane & 3) * 8;
#define P2_DMA(chunk, slot) do { const size_t cc_ = (size_t)((chunk) < 31 ? (chunk) : 30) * 128; LAS unsigned char* sb_ = F.lds + (slot) * SLOT; \
            __builtin_amdgcn_global_load_lds((const unsigned*)(kz0 + cc_ * 256), (LAS unsigned*)(sb_ + (2 * w) * 1024), 16, 0, 0); \
            __builtin_amdgcn_global_load_lds((const unsigned*)(kz0 + (cc_ + 8) * 256), (LAS unsigned*)(sb_ + (2 * w + 1) * 1024), 16, 0, 0); \
            __builtin_amdgcn_global_load_lds((const unsigned*)(vv0 + cc_ * 512), (LAS unsigned*)(sb_ + KBY + w * 1024), 16, 0, 0); } while (0)
#define P2_STORE(n) do { u32x2 pk_; pk_.x = cvtpk(st[0], st[1]); pk_.y = cvtpk(st[2], st[3]); *(GAS u32x2*)(STb + (size_t)(n) * 8192) = pk_; } while (0)
        asm volatile("s_waitcnt vmcnt(0)" ::: "memory"); __syncthreads();
        P2_STORE(0); P2_DMA(0, 0); P2_STORE(0); P2_DMA(1, 1); P2_STORE(0); P2_DMA(2, 2); P2_STORE(0); P2_DMA(3, 3); P2_STORE(0);
        for (int n = 0; n < 31; ++n) {
            asm volatile("s_waitcnt vmcnt(13)" ::: "memory");
            __builtin_amdgcn_s_barrier(); asm volatile("" ::: "memory");
            P2_DMA(n + 4, (n + 4) % 5);
            const unsigned slot_ = (unsigned)(n % 5) * SLOT;
            v4i16_t k0l, k0h, k1l, k1h, k2l, k2h, k3l, k3h, v0l, v0h, v1l, v1h, v2l, v2h, v3l, v3h;
            asm volatile("ds_read_b64_tr_b16 %0, %16\n\tds_read_b64_tr_b16 %1, %16 offset:512\n\tds_read_b64_tr_b16 %2, %16 offset:4096\n\tds_read_b64_tr_b16 %3, %16 offset:4608\n\t"
                         "ds_read_b64_tr_b16 %4, %16 offset:8192\n\tds_read_b64_tr_b16 %5, %16 offset:8704\n\tds_read_b64_tr_b16 %6, %16 offset:12288\n\tds_read_b64_tr_b16 %7, %16 offset:12800\n\t"
                         "ds_read_b64_tr_b16 %8, %17\n\tds_read_b64_tr_b16 %9, %17 offset:256\n\tds_read_b64_tr_b16 %10, %17 offset:2048\n\tds_read_b64_tr_b16 %11, %17 offset:2304\n\t"
                         "ds_read_b64_tr_b16 %12, %17 offset:4096\n\tds_read_b64_tr_b16 %13, %17 offset:4352\n\tds_read_b64_tr_b16 %14, %17 offset:6144\n\tds_read_b64_tr_b16 %15, %17 offset:6400\n\t"
                         "s_waitcnt lgkmcnt(0)"
                         : "=&v"(k0l), "=&v"(k0h), "=&v"(k1l), "=&v"(k1h), "=&v"(k2l), "=&v"(k2h), "=&v"(k3l), "=&v"(k3h), "=&v"(v0l), "=&v"(v0h), "=&v"(v1l), "=&v"(v1h), "=&v"(v2l), "=&v"(v2h), "=&v"(v3l), "=&v"(v3h)
                         : "v"(kaddr + slot_), "v"(vaddr + slot_) : "memory");
            f32x4 a = {0.f, 0.f, 0.f, 0.f};
            a = mma(__builtin_shufflevector(k0l, k0h, 0, 1, 2, 3, 4, 5, 6, 7), __builtin_shufflevector(v0l, v0h, 0, 1, 2, 3, 4, 5, 6, 7), a);
            a = mma(__builtin_shufflevector(k1l, k1h, 0, 1, 2, 3, 4, 5, 6, 7), __builtin_shufflevector(v1l, v1h, 0, 1, 2, 3, 4, 5, 6, 7), a);
            a = mma(__builtin_shufflevector(k2l, k2h, 0, 1, 2, 3, 4, 5, 6, 7), __builtin_shufflevector(v2l, v2h, 0, 1, 2, 3, 4, 5, 6, 7), a);
            a = mma(__builtin_shufflevector(k3l, k3h, 0, 1, 2, 3, 4, 5, 6, 7), __builtin_shufflevector(v3l, v3h, 0, 1, 2, 3, 4, 5, 6, 7), a);
            st = st * cd + a;
            P2_STORE(n + 1);
        }
        asm volatile("s_waitcnt vmcnt(0)" ::: "memory");
#undef P2_DMA
#undef P2_STORE
    }
    __syncthreads();
}

struct RetRegs { v4u q[2], k[2], s[2], v[4]; u32x2 g[8]; };
DI void ret_fetch(const Frame& F, RetRegs& r, int b, int h, int nn) {
    const size_t R0 = (size_t)b * 4096 + (size_t)nn * 128;
#pragma unroll
    for (int i = 0; i < 2; ++i) { const int ch = F.tid + 512 * i, rw = ch >> 3, c8 = ch & 7;
        r.q[i] = *(const GAS v4u*)(F.Qb + (R0 + rw) * 256 + h * 64 + c8 * 8); r.k[i] = *(const GAS v4u*)(F.Kb + (R0 + rw) * 256 + h * 64 + c8 * 8);
        r.s[i] = *(const GAS v4u*)(F.ST + (size_t)((b * 4 + h) * 32 + nn) * 8192 + rw * 64 + c8 * 8); }
#pragma unroll
    for (int i = 0; i < 4; ++i) { const int ch = F.tid + 512 * i, rw = ch >> 4, c16 = ch & 15; r.v[i] = *(const GAS v4u*)(F.Vb + (R0 + rw) * 512 + h * 128 + c16 * 8); }
    { const bf16* grow = F.Gb + (R0 + 16 * F.wave + (F.lane & 15)) * 512 + h * 128 + 4 * (F.lane >> 4);
#pragma unroll
      for (int vt = 0; vt < 8; ++vt) r.g[vt] = *(const GAS u32x2*)(grow + 16 * vt); }
}
DI void ret_compute(Frame& F, int b, int h, int nn, float lg, const u32x2 (&gb)[8]) {
    LAS unsigned char* QS = F.lds; LAS unsigned char* KS = F.lds + 18432; LAS unsigned char* VS = F.lds + 36864; LAS unsigned char* SS = F.lds + 71680; LAS unsigned char* CS = F.lds + 90112;
    const size_t R0 = (size_t)b * 4096 + (size_t)nn * 128;
    const int w = F.wave, lane = F.lane, fr = lane & 15, fq = lane >> 4;
    const int il = 16 * w + fr;
    const bf16x8 qf0 = frag_row(QS, SQ, 16 * w, 0, lane), qf1 = frag_row(QS, SQ, 16 * w, 32, lane);
    const int jtmax = w | 1;
    for (int jt = 0; jt <= jtmax; ++jt) {
        f32x4 a = {0.f, 0.f, 0.f, 0.f};
        a = mma(frag_row(KS, SQ, 16 * jt, 0, lane), qf0, a); a = mma(frag_row(KS, SQ, 16 * jt, 32, lane), qf1, a);
        float o[4];
#pragma unroll
        for (int r = 0; r < 4; ++r) { const int dl = il - (16 * jt + 4 * fq + r); o[r] = dl >= 0 ? a[r] * exp2f((float)dl * lg) : 0.f; }
        u32x2 pk; pk.x = cvtpk(o[0], o[1]); pk.y = cvtpk(o[2], o[3]);
        *(LAS u32x2*)(CS + il * SV + (16 * jt + 4 * fq) * 2) = pk;
    }
    asm volatile("s_waitcnt lgkmcnt(0)" ::: "memory");
    f32x4 accI[8], accC[8];
#pragma unroll
    for (int vt = 0; vt < 8; ++vt) { accI[vt] = (f32x4){0.f, 0.f, 0.f, 0.f}; accC[vt] = (f32x4){0.f, 0.f, 0.f, 0.f}; }
    const int kkmax = w >> 1;
    for (int kk = 0; kk <= kkmax; ++kk) { const bf16x8 cf = frag_row(CS, SV, 16 * w, 32 * kk, lane);
#pragma unroll
        for (int vt = 0; vt < 8; ++vt) accI[vt] = mma(frag_tr(VS, SV, 32 * kk, 16 * vt, lane), cf, accI[vt]); }
#pragma unroll
    for (int vt = 0; vt < 8; ++vt) { accC[vt] = mma(frag_row(SS, SQ, 16 * vt, 0, lane), qf0, accC[vt]); accC[vt] = mma(frag_row(SS, SQ, 16 * vt, 32, lane), qf1, accC[vt]); }
    const float xi = exp2f((float)(il + 1) * lg);
    float s = 0.f;
#pragma unroll
    for (int vt = 0; vt < 8; ++vt) { accI[vt] = accI[vt] + accC[vt] * xi; s += (accI[vt][0] + accI[vt][1]) + (accI[vt][2] + accI[vt][3]); }
    s += __shfl_xor(s, 16); s += __shfl_xor(s, 32);
    const float mean = s * (1.0f / 128.0f); float q = 0.f;
#pragma unroll
    for (int vt = 0; vt < 8; ++vt) { accI[vt] = accI[vt] - mean; q += (accI[vt][0] * accI[vt][0] + accI[vt][1] * accI[vt][1]) + (accI[vt][2] * accI[vt][2] + accI[vt][3] * accI[vt][3]); }
    q += __shfl_xor(q, 16); q += __shfl_xor(q, 32);
    const float rstd = 1.0f / sqrtf(q * (1.0f / 128.0f) + GN_EPS);
    bf16* orow = F.MIXIN + (R0 + il) * 1024 + h * 128 + 4 * fq;
#pragma unroll
    for (int vt = 0; vt < 8; ++vt) {
        const float g0 = bflo(gb[vt].x), g1 = bfhi(gb[vt].x), g2 = bflo(gb[vt].y), g3 = bfhi(gb[vt].y);
        const float y0 = accI[vt][0] * rstd * g0 / (1.0f + __expf(-g0)), y1 = accI[vt][1] * rstd * g1 / (1.0f + __expf(-g1));
        const float y2 = accI[vt][2] * rstd * g2 / (1.0f + __expf(-g2)), y3 = accI[vt][3] * rstd * g3 / (1.0f + __expf(-g3));
        u32x2 pk; pk.x = cvtpk(y0, y1); pk.y = cvtpk(y2, y3); *(GAS u32x2*)(orow + 16 * vt) = pk; }
}
DI void pool_fetch(const Frame& F, v4u (&ru)[5], int b, int g, int nn) {
#pragma unroll
    for (int i = 0; i < 5; ++i) { const int ch = F.tid + 512 * i; ru[i] = (v4u){0u, 0u, 0u, 0u};
        if (ch < 144 * 16) { const int rr = ch >> 4, c16 = ch & 15, t = nn * 128 - 16 + rr;
            if (t >= 0) ru[i] = *(const GAS v4u*)(F.Ub + ((size_t)b * 4096 + t) * 512 + g * 128 + c16 * 8);
            else { const float* mu = F.metau + (16 + t) * 512 + g * 128 + c16 * 8; ru[i].x = pk2(mu[0], mu[1]); ru[i].y = pk2(mu[2], mu[3]); ru[i].z = pk2(mu[4], mu[5]); ru[i].w = pk2(mu[6], mu[7]); } } }
}
DI void p3_mixer(Frame& F) {
    const int c = blockIdx.x;
    {
        LAS unsigned char* QS = F.lds; LAS unsigned char* KS = F.lds + 18432; LAS unsigned char* VS = F.lds + 36864; LAS unsigned char* SS = F.lds + 71680;
        RetRegs rg; { const int tile = 2 * c; ret_fetch(F, rg, tile >> 5, 0, tile & 31); }
        for (int i = 0; i < 8; ++i) {
            const int tile = 2 * c + (i >> 2), hg = i & 3, b = tile >> 5, nn = tile & 31;
            const float lg = log2f(1.0f - exp2f(-5.0f - (float)hg));
            __syncthreads();
#pragma unroll
            for (int k = 0; k < 2; ++k) { const int ch = F.tid + 512 * k, rw = ch >> 3, c8 = ch & 7;
                *(LAS v4u*)(QS + rw * SQ + c8 * 16) = rg.q[k]; *(LAS v4u*)(KS + rw * SQ + c8 * 16) = rg.k[k]; *(LAS v4u*)(SS + rw * SQ + c8 * 16) = rg.s[k]; }
#pragma unroll
            for (int k = 0; k < 4; ++k) { const int ch = F.tid + 512 * k, rw = ch >> 4, c16 = ch & 15; *(LAS v4u*)(VS + rw * SV + c16 * 16) = rg.v[k]; }
            __syncthreads();
            u32x2 gcur[8];
#pragma unroll
            for (int vt = 0; vt < 8; ++vt) gcur[vt] = rg.g[vt];
            if (i < 7) { const int t2 = 2 * c + ((i + 1) >> 2); ret_fetch(F, rg, t2 >> 5, (i + 1) & 3, t2 & 31); }
            ret_compute(F, b, hg, nn, lg, gcur);
        }
    }
    {
        LAS unsigned char* US = F.lds; LAS unsigned char* PS = F.lds + 40960; LAS unsigned char* WSM = F.lds + 77824;
        const int w = F.wave, lane = F.lane, fr = lane & 15, fq = lane >> 4;
        f32x4 pb[8], psc[8]; v4u wreg[4];
        v4u ru[5]; { const int tile = 2 * c; pool_fetch(F, ru, tile >> 5, 0, tile & 31); }
#pragma unroll
        for (int k = 0; k < 4; ++k) { const int ch = F.tid + 512 * k; wreg[k] = *(const GAS v4u*)(F.Wpool_t + (ch >> 4) * 128 + (ch & 15) * 8); }
        for (int i = 0; i < 8; ++i) {
            const int g = i >> 1, tile = 2 * c + (i & 1), b = tile >> 5, nn = tile & 31, win = 2 << g; const float invw = 1.0f / (float)win;
            const size_t R0 = (size_t)b * 4096 + (size_t)nn * 128;
            __syncthreads();
            if ((i & 1) == 0) {
#pragma unroll
                for (int k = 0; k < 4; ++k) { const int ch = F.tid + 512 * k; *(LAS v4u*)(WSM + (ch >> 4) * SV + (ch & 15) * 16) = wreg[k]; }
#pragma unroll
                for (int dt = 0; dt < 8; ++dt) { pb[dt] = *(const f32x4*)(F.pool_b + g * 128 + 16 * dt + 4 * fq); psc[dt] = *(const f32x4*)(F.pool_scale + g * 128 + 16 * dt + 4 * fq); } }
#pragma unroll
            for (int k = 0; k < 5; ++k) { const int ch = F.tid + 512 * k; if (ch < 144 * 16) *(LAS v4u*)(US + (ch >> 4) * SV + (ch & 15) * 16) = ru[k]; }
            __syncthreads();
            if (i < 7) { const int t2 = 2 * c + ((i + 1) & 1), g2 = (i + 1) >> 1; pool_fetch(F, ru, t2 >> 5, g2, t2 & 31);
                if ((i & 1) == 1) {
#pragma unroll
                    for (int k = 0; k < 4; ++k) { const int ch = F.tid + 512 * k; wreg[k] = *(const GAS v4u*)(F.Wpool_t + g2 * 16384 + (ch >> 4) * 128 + (ch & 15) * 8); } } }
            { const int c2 = F.tid & 63, ib = F.tid >> 6; float run0 = 0.f, run1 = 0.f;
              for (int sI = 0; sI < win; ++sI) { const unsigned xw = *(const LAS unsigned*)(US + (16 + 16 * ib - sI) * SV + c2 * 4); run0 += bflo(xw); run1 += bfhi(xw); }
              for (int ii = 0; ii < 16; ++ii) { const int ir = 16 * ib + ii; const unsigned cur = *(const LAS unsigned*)(US + (16 + ir) * SV + c2 * 4);
                  if (ii > 0) { const unsigned old = *(const LAS unsigned*)(US + (16 + ir - win) * SV + c2 * 4); run0 += bflo(cur) - bflo(old); run1 += bfhi(cur) - bfhi(old); }
                  *(LAS unsigned*)(PS + ir * SV + c2 * 4) = cvtpk(run0 * invw - bflo(cur), run1 * invw - bfhi(cur)); } }
            __syncthreads();
            bf16x8 pf[4];
#pragma unroll
            for (int kk = 0; kk < 4; ++kk) pf[kk] = frag_row(PS, SV, 16 * w, 32 * kk, lane);
            bf16* orow = F.MIXIN + (R0 + 16 * w + fr) * 1024 + 512 + g * 128 + 4 * fq;
#pragma unroll
            for (int dt = 0; dt < 8; ++dt) { f32x4 a = {0.f, 0.f, 0.f, 0.f};
#pragma unroll
                for (int kk = 0; kk < 4; ++kk) a = mma(frag_row(WSM, SV, 16 * dt, 32 * kk, lane), pf[kk], a);
                a = (a + pb[dt]) * psc[dt];
                u32x2 pk; pk.x = cvtpk(a[0], a[1]); pk.y = cvtpk(a[2], a[3]); *(GAS u32x2*)(orow + 16 * dt) = pk; }
        }
    }
    __syncthreads();
}

DI void split8(const float (&h)[8], bf16x8& hi, bf16x8& lo) {
    v4u a, b;
#pragma unroll
    for (int p = 0; p < 4; ++p) { const unsigned wd = cvtpk(h[2 * p], h[2 * p + 1]); a[p] = wd; b[p] = cvtpk(h[2 * p] - bflo(wd), h[2 * p + 1] - bfhi(wd)); }
    hi = __builtin_bit_cast(bf16x8, a); lo = __builtin_bit_cast(bf16x8, b);
}
DI void p5_ln_router(Frame& F) {
    LAS int* LCNT = (LAS int*)(F.lds + LCNT_OFF);
    LAS f32x2* SP = (LAS f32x2*)(F.lds);
    LAS float* LP = (LAS float*)(F.lds + 1024);
    LAS float* LG = (LAS float*)(F.lds + 1024 + 24576);
    LAS float* GB = (LAS float*)(F.lds + 32768);
    for (int i = F.tid; i < 256; i += 512) { *(LAS f32x4*)(GB + 4 * i) = *(const f32x4*)(F.ln1_g + 4 * i); *(LAS f32x4*)(GB + 1024 + 4 * i) = *(const f32x4*)(F.ln1_b + 4 * i); }
    if (F.tid < 32) LCNT[F.tid] = 0;
    const int w = F.wave, lane = F.lane, fr = lane & 15, fq = lane >> 4;
    const int kb = 128 * w + 8 * fq;
    bf16x8 wh[3][4], wl[3][4];
#pragma unroll
    for (int ct = 0; ct < 3; ++ct)
#pragma unroll
        for (int ks = 0; ks < 4; ++ks) { const int cc = 16 * ct + fr; float f[8];
            if (cc < 36) { const f32x4 a = *(const f32x4*)(F.RW + cc * 1024 + kb + 32 * ks), b = *(const f32x4*)(F.RW + cc * 1024 + kb + 32 * ks + 4);
                f[0] = a[0]; f[1] = a[1]; f[2] = a[2]; f[3] = a[3]; f[4] = b[0]; f[5] = b[1]; f[6] = b[2]; f[7] = b[3]; }
            else {
#pragma unroll
                for (int j = 0; j < 8; ++j) f[j] = 0.f; }
            split8(f, wh[ct][ks], wl[ct][ks]); }
    const int c = blockIdx.x;
    const float rbias = lane < 4 ? F.rg_b[lane] : (lane < 36 ? F.re_b[lane - 4] : 0.f);
    const bf16* tbase = F.T1 + (size_t)(c * 256 + fr) * D + kb;
    const bf16* hbase = F.H0 + (size_t)(c * 256 + fr) * D + kb;
    v4u tn[4], hn[4];
#pragma unroll
    for (int ks = 0; ks < 4; ++ks) { tn[ks] = *(const GAS v4u*)(tbase + 32 * ks); hn[ks] = *(const GAS v4u*)(hbase + 32 * ks); }
    __syncthreads();
    for (int grp = 0; grp < 16; ++grp) {
        f32x4 t[8];
#pragma unroll
        for (int i = 0; i < 4; ++i) {
            t[2 * i] = (f32x4){ALPHA * bflo(hn[i].x) + bflo(tn[i].x), ALPHA * bfhi(hn[i].x) + bfhi(tn[i].x), ALPHA * bflo(hn[i].y) + bflo(tn[i].y), ALPHA * bfhi(hn[i].y) + bfhi(tn[i].y)};
            t[2 * i + 1] = (f32x4){ALPHA * bflo(hn[i].z) + bflo(tn[i].z), ALPHA * bfhi(hn[i].z) + bfhi(tn[i].z), ALPHA * bflo(hn[i].w) + bflo(tn[i].w), ALPHA * bfhi(hn[i].w) + bfhi(tn[i].w)}; }
        if (grp < 15) { const bf16* nb = tbase + (size_t)(grp + 1) * 16 * D; const bf16* nh = hbase + (size_t)(grp + 1) * 16 * D;
#pragma unroll
            for (int ks = 0; ks < 4; ++ks) { tn[ks] = *(const GAS v4u*)(nb + 32 * ks); hn[ks] = *(const GAS v4u*)(nh + 32 * ks); } }
        float s = 0.f, s2 = 0.f;
#pragma unroll
        for (int i = 0; i < 8; ++i) { s += (t[i][0] + t[i][1]) + (t[i][2] + t[i][3]); s2 += (t[i][0] * t[i][0] + t[i][1] * t[i][1]) + (t[i][2] * t[i][2] + t[i][3] * t[i][3]); }
        s += __shfl_xor(s, 16); s += __shfl_xor(s, 32); s2 += __shfl_xor(s2, 16); s2 += __shfl_xor(s2, 32);
        if (fq == 0) SP[fr * 8 + w] = (f32x2){s, s2};
        __syncthreads();
        float ts = 0.f, ts2 = 0.f;
#pragma unroll
        for (int k = 0; k < 8; ++k) { const f32x2 p = SP[fr * 8 + k]; ts += p.x; ts2 += p.y; }
        const float mean = ts * (1.f / D); const float rstd = 1.f / sqrtf(ts2 * (1.f / D) - mean * mean + LN_EPS);
        f32x4 acc[3];
#pragma unroll
        for (int ct = 0; ct < 3; ++ct) acc[ct] = (f32x4){0.f, 0.f, 0.f, 0.f};
        bf16* hrow = F.H1B + (size_t)(c * 256 + grp * 16 + fr) * D + kb; unsigned char* frow = F.H1F8 + (size_t)(c * 256 + grp * 16 + fr) * D + kb;
#pragma unroll
        for (int ks = 0; ks < 4; ++ks) { const int col = kb + 32 * ks;
            const f32x4 g0 = *(const LAS f32x4*)(GB + col), g1 = *(const LAS f32x4*)(GB + col + 4), b0 = *(const LAS f32x4*)(GB + 1024 + col), b1 = *(const LAS f32x4*)(GB + 1024 + col + 4);
            const f32x4 h0 = (t[2 * ks] - mean) * rstd * g0 + b0, h1 = (t[2 * ks + 1] - mean) * rstd * g1 + b1;
            const float h[8] = {h0[0], h0[1], h0[2], h0[3], h1[0], h1[1], h1[2], h1[3]};
            bf16x8 hh, hl; split8(h, hh, hl);
            *(GAS bf16x8*)(hrow + 32 * ks) = hh;
            { u32x2 f8; f8.x = pk4f8(h[0], h[1], h[2], h[3]); f8.y = pk4f8(h[4], h[5], h[6], h[7]); *(GAS u32x2*)(frow + 32 * ks) = f8; }
#pragma unroll
            for (int ct = 0; ct < 3; ++ct) { acc[ct] = mma(wh[ct][ks], hh, acc[ct]); acc[ct] = mma(wh[ct][ks], hl, acc[ct]); acc[ct] = mma(wl[ct][ks], hh, acc[ct]); } }
#pragma unroll
        for (int ct = 0; ct < 3; ++ct) *(LAS f32x4*)(LP + ((w * 16 + fr) * 48 + 16 * ct + 4 * fq)) = acc[ct];
        __syncthreads();
#pragma unroll
        for (int rr = 0; rr < 2; ++rr) { const int rl = 2 * w + rr;
            if (lane < 36) { float sg = 0.f;
#pragma unroll
                for (int k = 0; k < 8; ++k) sg += LP[(k * 16 + rl) * 48 + lane];
                LG[rl * 40 + lane] = sg + rbias; } }
        asm volatile("s_waitcnt lgkmcnt(0)" ::: "memory");
        if (lane < 2) { const int rl = 2 * w + lane, row = c * 256 + grp * 16 + rl; const LAS float* lg = LG + rl * 40;
            const float l0 = lg[0], l1 = lg[1], l2 = lg[2], l3 = lg[3];
            const float gmax = fmaxf(fmaxf(l0, l1), fmaxf(l2, l3));
            const int gi = l0 == gmax ? 0 : (l1 == gmax ? 1 : (l2 == gmax ? 2 : 3));
            const float gp = 1.0f / ((expf(l0 - gmax) + expf(l1 - gmax)) + (expf(l2 - gmax) + expf(l3 - gmax)));
            float sel[8];
#pragma unroll
            for (int k = 0; k < 8; ++k) sel[k] = lg[4 + gi * 8 + k];
            float m1 = sel[0];
#pragma unroll
            for (int k = 1; k < 8; ++k) m1 = fmaxf(m1, sel[k]);
            int i1 = 7;
#pragma unroll
            for (int k = 6; k >= 0; --k) i1 = sel[k] == m1 ? k : i1;
            float m2 = -3.0e38f;
#pragma unroll
            for (int k = 0; k < 8; ++k) m2 = (k != i1) ? fmaxf(m2, sel[k]) : m2;
            int i2 = -1;
#pragma unroll
            for (int k = 7; k >= 0; --k) i2 = (k != i1 && sel[k] == m2) ? k : i2;
            const float tt = expf(m2 - m1); const float w0 = gp / (1.0f + tt), w1 = gp * tt / (1.0f + tt);
            const int e0 = gi * 8 + i1, e1 = gi * 8 + i2;
            const int li0 = __hip_atomic_fetch_add(LCNT + e0, 1, __ATOMIC_RELAXED, __HIP_MEMORY_SCOPE_WORKGROUP), li1 = __hip_atomic_fetch_add(LCNT + e1, 1, __ATOMIC_RELAXED, __HIP_MEMORY_SCOPE_WORKGROUP);
            F.toke[row] = (unsigned)e0 | ((unsigned)e1 << 8); F.tokl[row] = (unsigned)li0 | ((unsigned)li1 << 16); F.tokw[row] = (f32x2){w0, w1}; }
    }
    __syncthreads();
    if (F.tid < 32) F.cnt[c * 32 + F.tid] = LCNT[F.tid];
}
DI void moe_layout(Frame& F) {
    LAS int* red = (LAS int*)(F.lds);
    LAS int* PP = (LAS int*)(F.lds + PP_OFF); LAS int* TOT = (LAS int*)(F.lds + TOT_OFF); LAS int* BEF = (LAS int*)(F.lds + BEF_OFF); LAS int* BASE = (LAS int*)(F.lds + BASE_OFF);
    __syncthreads();
    { const int e = F.tid & 31, part = F.tid >> 5; int tot = 0, bef = 0;
      for (int k = 0; k < 16; ++k) { const int c2 = part * 16 + k; const int v = F.cnt[c2 * 32 + e]; tot += v; bef += (c2 < (int)blockIdx.x) ? v : 0; }
      red[(part * 32 + e) * 2] = tot; red[(part * 32 + e) * 2 + 1] = bef; }
    __syncthreads();
    if (F.tid < 32) { int t = 0, bf = 0;
        for (int p = 0; p < 16; ++p) { t += red[(p * 32 + F.tid) * 2]; bf += red[(p * 32 + F.tid) * 2 + 1]; }
        TOT[F.tid] = t; BEF[F.tid] = bf; }
    __syncthreads();
    if (F.tid == 0) { int acc = 0; for (int e = 0; e < 32; ++e) { PP[e] = acc; acc += (TOT[e] + 255) >> 8; } PP[32] = acc; }
    __syncthreads();
    if (F.tid < 32) BASE[F.tid] = PP[F.tid] * 256 + BEF[F.tid];
    __syncthreads();
}
DI void p6_assign(Frame& F) {
    moe_layout(F);
    const LAS int* BASE = (const LAS int*)(F.lds + BASE_OFF); const LAS int* PP = (const LAS int*)(F.lds + PP_OFF); const LAS int* TOT = (const LAS int*)(F.lds + TOT_OFF);
    const int c = blockIdx.x;
    if (F.tid < 256) { const int row = c * 256 + F.tid; const unsigned te = F.toke[row], tl = F.tokl[row];
        const int s0 = BASE[te & 255u] + (int)(tl & 0xffffu), s1 = BASE[(te >> 8) & 255u] + (int)(tl >> 16);
        F.stok[s0] = row; F.stok[s1] = row; F.toks[row * 2] = s0; F.toks[row * 2 + 1] = s1; const f32x2 wv = F.tokw[row]; F.PW[s0] = wv.x; F.PW[s1] = wv.y; }
    if (c < 32) { const int lo = PP[c] * 256 + TOT[c], hi = PP[c + 1] * 256; for (int sl = lo + F.tid; sl < hi; sl += 512) { F.stok[sl] = 0; F.PW[sl] = 0.f; } }
}
DI void p9_final(Frame& F) {
    const int gw = F.vcu * NWAVES + F.wave, NGW = F.G * NWAVES;
    f32x4 gv[4], bv[4];
#pragma unroll
    for (int j = 0; j < 4; ++j) { gv[j] = *(const f32x4*)(F.ln2_g + 4 * F.lane + 256 * j); bv[j] = *(const f32x4*)(F.ln2_b + 4 * F.lane + 256 * j); }
    u32x2 nh[4], mh[4]; unsigned na[4], nb[4], ma[4], mb[4]; int s0n, s1n;
    { const int r0 = gw, r1 = gw + NGW, r2 = gw + 2 * NGW;
      const int a0 = F.toks[r0 * 2], a1 = F.toks[r0 * 2 + 1], b0 = F.toks[r1 * 2], b1 = F.toks[r1 * 2 + 1];
      const GAS u32x2* hp = (const GAS u32x2*)(F.H1B + (size_t)r0 * D) + F.lane; const GAS unsigned* y0 = (const GAS unsigned*)(F.YP + (size_t)a0 * D) + F.lane; const GAS unsigned* y1 = (const GAS unsigned*)(F.YP + (size_t)a1 * D) + F.lane;
      const GAS u32x2* hq = (const GAS u32x2*)(F.H1B + (size_t)r1 * D) + F.lane; const GAS unsigned* z0 = (const GAS unsigned*)(F.YP + (size_t)b0 * D) + F.lane; const GAS unsigned* z1 = (const GAS unsigned*)(F.YP + (size_t)b1 * D) + F.lane;
#pragma unroll
      for (int j = 0; j < 4; ++j) { nh[j] = hp[64 * j]; na[j] = y0[64 * j]; nb[j] = y1[64 * j]; mh[j] = hq[64 * j]; ma[j] = z0[64 * j]; mb[j] = z1[64 * j]; }
      s0n = F.toks[r2 * 2]; s1n = F.toks[r2 * 2 + 1]; }
    for (int row = gw; row < M; row += NGW) {
        u32x2 ch[4]; unsigned ca[4], cb[4];
#pragma unroll
        for (int j = 0; j < 4; ++j) { ch[j] = nh[j]; ca[j] = na[j]; cb[j] = nb[j]; nh[j] = mh[j]; na[j] = ma[j]; nb[j] = mb[j]; }
        if (row + 2 * NGW < M) { const int rn = row + 2 * NGW;
            const GAS u32x2* hp = (const GAS u32x2*)(F.H1B + (size_t)rn * D) + F.lane; const GAS unsigned* y0 = (const GAS unsigned*)(F.YP + (size_t)s0n * D) + F.lane; const GAS unsigned* y1 = (const GAS unsigned*)(F.YP + (size_t)s1n * D) + F.lane;
#pragma unroll
            for (int j = 0; j < 4; ++j) { mh[j] = hp[64 * j]; ma[j] = y0[64 * j]; mb[j] = y1[64 * j]; }
            const int r3 = rn + NGW < M ? rn + NGW : rn; s0n = F.toks[r3 * 2]; s1n = F.toks[r3 * 2 + 1]; }
        f32x4 v[4]; float s = 0.f;
#pragma unroll
        for (int j = 0; j < 4; ++j) { const u32x2 hb = ch[j];
            const f32x2 a0 = __builtin_amdgcn_cvt_pk_f32_fp8((int)ca[j], false), a1 = __builtin_amdgcn_cvt_pk_f32_fp8((int)ca[j], true);
            const f32x2 b0 = __builtin_amdgcn_cvt_pk_f32_fp8((int)cb[j], false), b1 = __builtin_amdgcn_cvt_pk_f32_fp8((int)cb[j], true);
            v[j].x = ALPHA * bflo(hb.x) + (a0.x + b0.x) * 0.015625f; v[j].y = ALPHA * bfhi(hb.x) + (a0.y + b0.y) * 0.015625f;
            v[j].z = ALPHA * bflo(hb.y) + (a1.x + b1.x) * 0.015625f; v[j].w = ALPHA * bfhi(hb.y) + (a1.y + b1.y) * 0.015625f;
            s += (v[j].x + v[j].y) + (v[j].z + v[j].w); }
        const float mean = wave_sum(s) * (1.f / D); float s2 = 0.f;
#pragma unroll
        for (int j = 0; j < 4; ++j) { v[j] = v[j] - mean; s2 += (v[j].x * v[j].x + v[j].y * v[j].y) + (v[j].z * v[j].z + v[j].w * v[j].w); }
        const float rstd = 1.f / sqrtf(wave_sum(s2) * (1.f / D) + LN_EPS);
        GAS f32x4* op = (GAS f32x4*)(F.out + (size_t)row * D) + F.lane;
#pragma unroll
        for (int j = 0; j < 4; ++j) op[64 * j] = v[j] * rstd * gv[j] + bv[j];
    }
}

struct Args { const float* in[20]; float* out; unsigned char* ws; int ph_lo, ph_hi; };
__global__ void __launch_bounds__(NWAVES * 64, 2) hrp_fwd(Args args) {
    extern __shared__ __attribute__((aligned(16))) unsigned char lds[];
    Frame F;
    F.lds = (LAS unsigned char*)lds;
    F.MISC = (volatile LAS unsigned*)(F.lds + MISC_OFF);
    F.tid = threadIdx.x; F.lane = F.tid & 63; F.wave = __builtin_amdgcn_readfirstlane(F.tid >> 6);
    F.G = gridDim.x; { const int bx = blockIdx.x; F.vcu = (F.G % 8 == 0) ? (bx % 8) * (F.G / 8) + bx / 8 : bx; }
    unsigned char* ws = args.ws;
    F.ctl = (gu32*)(ws + WS_CTL);
    F.x = args.in[0]; F.meta = args.in[1]; F.lne_g = args.in[2]; F.lne_b = args.in[3]; F.w_in = args.in[4]; F.pool_w = args.in[5]; F.pool_b = args.in[6]; F.pool_scale = args.in[7];
    F.w_out = args.in[8]; F.ln1_g = args.in[9]; F.ln1_b = args.in[10]; F.rg_w = args.in[11]; F.rg_b = args.in[12]; F.re_w = args.in[13]; F.re_b = args.in[14];
    F.w_gate = args.in[15]; F.w_up = args.in[16]; F.w_down = args.in[17]; F.ln2_g = args.in[18]; F.ln2_b = args.in[19]; F.out = args.out;
    F.Win_t = (bf16*)(ws + WS_WIN); F.Wout_t = (bf16*)(ws + WS_WOUT); F.Wpool_t = (bf16*)(ws + WS_WPOOL); F.Wgu8 = ws + WS_WGU; F.Wd8 = ws + WS_WD; F.H1F8 = ws + WS_H1F8;
    F.RW = (float*)(ws + WS_RW); F.metak = (float*)(ws + WS_METAK); F.metav = (float*)(ws + WS_METAV); F.metau = (float*)(ws + WS_METAU); F.rope = (float*)(ws + WS_ROPE);
    F.T1 = (bf16*)(ws + WS_T1); F.PW = (float*)(ws + WS_PW);
    F.toke = (unsigned*)(ws + WS_TOKE); F.tokl = (unsigned*)(ws + WS_TOKL); F.tokw = (f32x2*)(ws + WS_TOKW); F.toks = (int*)(ws + WS_TOKS); F.cnt = (int*)(ws + WS_CNT); F.stok = (int*)(ws + WS_STOK);
    F.ST = (bf16*)(ws + WS_ST); F.H0 = (bf16*)(ws + WS_H0); F.Qb = (bf16*)(ws + WS_Q); F.Kb = (bf16*)(ws + WS_K); F.Vb = (bf16*)(ws + WS_V); F.Gb = (bf16*)(ws + WS_GATE); F.Ub = (bf16*)(ws + WS_U); F.KZ = (bf16*)(ws + WS_KZ);
    F.MIXIN = (bf16*)(ws + WS_MIXIN); F.H1B = (bf16*)(ws + WS_H1B); F.HID = ws + WS_HID; F.YP = (unsigned char*)(ws + WS_YP);
    for (int u = F.tid; u < (LDS_BYTES - LDSCTL_OFF) / 4; u += NWAVES * 64) ((LAS unsigned*)(F.lds + LDSCTL_OFF))[u] = 0u;
    __syncthreads();
    if (F.G != 256) return;
    XcdBarrier bar; bar.bar = (unsigned*)(F.ctl + CW_BAR); bar.x = 0; bar.st = nullptr;
    if (N_LAUNCHES != PER_PHASE) bar = xcd_barrier_post((unsigned*)(F.ctl + CW_BAR), F.MISC + 8);
#define GRID_BAR() do { if (N_LAUNCHES != PER_PHASE) xcd_barrier(bar); } while (0)
    const int lo = args.ph_lo, hi = args.ph_hi;
#define RELANE() do { int l_; asm volatile("v_mbcnt_lo_u32_b32 %0, -1, 0\n\tv_mbcnt_hi_u32_b32 %0, -1, %0" : "=v"(l_)); F.lane = l_; F.tid = F.wave * 64 + l_; } while (0)
#define IN(k) (lo <= (k) && (k) < hi)
#define BOTH(k) (IN(k) && IN((k) + 1))

    if (IN(0)) { RELANE(); p0_prologue(F); if (BOTH(0)) GRID_BAR(); }
    if (IN(1)) {
        pg8::Gemm g{F.H0, F.Win_t, M, NPROJ, D}; pg8::RotOrder S; S.init(M, NPROJ, F.G, (int)blockIdx.x);
        pg8::EpiProj E{F.Qb, F.Vb, F.rope, F.KZ};
        pg8::gemm_phase<pg8::EpiProj, pg8::RotOrder, true, true>(F.lds + RING_OFF, g, S, E, F.wave);
        if (BOTH(1)) GRID_BAR();
    }
    if (IN(2)) { RELANE(); p2_scan(F); if (BOTH(2)) GRID_BAR(); }
    if (IN(3)) { RELANE(); p3_mixer(F); VM_WAIT(); __syncthreads(); }
    if (IN(4)) {
        pg8::Gemm g{F.MIXIN, F.Wout_t, M, D, D}; pg8::OwnPanelOrder S{(int)blockIdx.x, 4};
        pg8::EpiMix E{F.T1};
        pg8::gemm_phase<pg8::EpiMix, pg8::OwnPanelOrder, true, true>(F.lds + RING_OFF, g, S, E, F.wave);
        VM_WAIT(); __syncthreads();
    }
    if (IN(5)) { RELANE(); p5_ln_router(F); if (BOTH(5)) GRID_BAR(); }
    if (IN(6)) { RELANE(); p6_assign(F); if (BOTH(6)) GRID_BAR(); }
    if (IN(7)) {
        if (!IN(6)) { RELANE(); moe_layout(F); }
        pg8::Gemm g{(const bf16*)F.H1F8, (const bf16*)F.Wgu8, SLOTS, 1024, D / 2, F.stok}; pg8::GroupedOrder S;     S.init((const LAS int*)(F.lds + PP_OFF), F.G, (int)blockIdx.x);
        pg8::EpiGateUp E{F.HID};
        pg8::gemm_phase<pg8::EpiGateUp, pg8::GroupedOrder, true, true, true, true>(F.lds + RING_OFF, g, S, E, F.wave);
        if (BOTH(7)) GRID_BAR();
    }
    if (IN(8)) {
        if (!IN(6)) { RELANE(); moe_layout(F); }
        pg8::Gemm g{(const bf16*)F.HID, (const bf16*)F.Wd8, SLOTS, 1024, DEXP / 2}; pg8::GroupedOrder S;     S.init((const LAS int*)(F.lds + PP_OFF), F.G, (int)blockIdx.x);
        pg8::EpiDown E{F.YP, F.PW};
        pg8::gemm_phase<pg8::EpiDown, pg8::GroupedOrder, true, true, false, true>(F.lds + RING_OFF, g, S, E, F.wave);
        if (BOTH(8)) GRID_BAR();
    }
    if (IN(9)) { RELANE(); p9_final(F); }
#undef IN
#undef BOTH
#undef GRID_BAR
#undef RELANE
}

extern "C" void kernel_launch(void* const* d_in, const int* in_sizes, int n_in, void* d_out, int out_size, void* d_ws, size_t ws_size, hipStream_t stream) {
    static int grid = 0;
    if (grid == 0) {
        if (n_in != 20 || in_sizes[0] != M * D || out_size != M * D || ws_size < WS_END) { fprintf(stderr, "kernel_launch: built for 20 inputs, x and out of %d floats, >= %zu bytes of workspace; got n_in %d, in0 %d, out %d, ws %zu; nothing launched\n", M * D, (size_t)WS_END, n_in, n_in > 0 ? in_sizes[0] : -1, out_size, ws_size); grid = -1; return; }
        int dev = 0, cus = 0, per_cu = 0;
        if (hipGetDevice(&dev) != hipSuccess || hipDeviceGetAttribute(&cus, hipDeviceAttributeMultiprocessorCount, dev) != hipSuccess) { fprintf(stderr, "kernel_launch: hipGetDevice / hipDeviceGetAttribute failed; nothing launched\n"); grid = -1; return; }
        if (hipFuncSetAttribute((const void*)hrp_fwd, hipFuncAttributeMaxDynamicSharedMemorySize, LDS_BYTES) != hipSuccess) { fprintf(stderr, "kernel_launch: hipFuncSetAttribute failed (%d bytes of dynamic LDS); nothing launched\n", LDS_BYTES); grid = -1; return; }
        if (hipOccupancyMaxActiveBlocksPerMultiprocessor(&per_cu, (const void*)hrp_fwd, NWAVES * 64, LDS_BYTES) != hipSuccess || per_cu < 1)
            fprintf(stderr, "kernel_launch: note: the occupancy query reports %d workgroups per CU; the launch goes ahead with one per CU\n", per_cu);
        (void)hipGetLastError();
        grid = cus;
        if (grid != 256) fprintf(stderr, "kernel_launch: %d CUs; this kernel is built for 256 and will leave the output unwritten\n", grid);
    }
    if (grid < 0) return;
    if (hipMemsetAsync((char*)d_ws + WS_CTL, 0, CTL_ZERO_BYTES, stream) != hipSuccess) { fprintf(stderr, "kernel_launch: hipMemsetAsync of the control words failed; nothing launched\n"); return; }
    Args a{};
    for (int i = 0; i < 20; ++i) a.in[i] = (const float*)d_in[i];
    a.out = (float*)d_out; a.ws = (unsigned char*)d_ws;
    for (int li = 0; li < N_LAUNCHES; ++li) {
        a.ph_lo = (N_LAUNCHES == PER_PHASE) ? li : 0; a.ph_hi = (N_LAUNCHES == PER_PHASE) ? li + 1 : PER_PHASE;
        hipLaunchKernelGGL(hrp_fwd, dim3(grid), dim3(NWAVES * 64), LDS_BYTES, stream, a);
        const hipError_t le = hipPeekAtLastError();
        if (le != hipSuccess) { fprintf(stderr, "kernel_launch: launch %d failed: %s\n", li, hipGetErrorName(le)); break; }
    }
}
```
